# Optimizing an MI355X kernel written in HIP

```python
import jax
import jax.numpy as jnp
from jax import lax
import numpy as np

D_MODEL = 1024
BATCH = 4
SEQ = 8192
DEPTH = 4

GRID_W = 64
CTX_LEN = 256
N_MIXERS = 2
N_HEADS = 16
N_KV_HEADS = 4
HEAD_DIM = 64
GROUP = N_HEADS // N_KV_HEADS
Q_DIM = N_HEADS * HEAD_DIM
KV_DIM = N_KV_HEADS * HEAD_DIM
WINDOW = 128
BLOCK = 128
ROPE_BASE = 10000.0
ROPE_HALF = HEAD_DIM // 4
POOL_WINDOWS = (2, 4, 8, 16)
N_POOL_GROUPS = len(POOL_WINDOWS)
POOL_GROUP_DIM = D_MODEL // N_POOL_GROUPS
D_FF = 2816
N_EXPERTS = 8
TOP_K = 2
D_FF_EXPERT = 3584
NORM_EPS = 1e-6
NEG_INF = -1e30
N_ATTN_LAYERS = (DEPTH + 1) // 2
N_POOL_LAYERS = DEPTH // 2

kernel_name = 'hybrid_swa_pool_moe_dit'


def rmsnorm(x, g):
    xf = x.astype(jnp.float32)
    y = xf * lax.rsqrt(jnp.mean(xf * xf, axis=-1, keepdims=True) + NORM_EPS)
    return (y * g.astype(jnp.float32)).astype(x.dtype)


def ada_mod(cond, w, b):
    m = jax.nn.silu(cond) @ w + b
    return jnp.split(m[..., None, :], 6, axis=-1)


def modulate(h, shift, scale):
    return h * (1 + scale) + shift


def axial_rope_tables(n_tokens):
    rows = n_tokens // GRID_W
    row = jnp.broadcast_to(jnp.arange(rows)[:, None], (rows, GRID_W)).reshape(-1).astype(jnp.float32)
    col = jnp.broadcast_to(jnp.arange(GRID_W)[None, :], (rows, GRID_W)).reshape(-1).astype(jnp.float32)
    inv_freq = ROPE_BASE ** (-jnp.arange(ROPE_HALF, dtype=jnp.float32) / ROPE_HALF)
    ang_r = row[:, None] * inv_freq
    ang_c = col[:, None] * inv_freq
    return (jnp.cos(ang_r), jnp.sin(ang_r), jnp.cos(ang_c), jnp.sin(ang_c))


def _rotate(v, cos, sin):
    v1, v2 = v[..., :ROPE_HALF], v[..., ROPE_HALF:]
    return jnp.concatenate([v1 * cos - v2 * sin, v2 * cos + v1 * sin], axis=-1)


def apply_axial_rope(t, tables):
    bshape = (t.shape[1],) + (1,) * (t.ndim - 3) + (ROPE_HALF,)
    cos_r, sin_r, cos_c, sin_c = [a.reshape(bshape) for a in tables]
    tf = t.astype(jnp.float32)
    half = HEAD_DIM // 2
    out = jnp.concatenate([_rotate(tf[..., :half], cos_r, sin_r),
                           _rotate(tf[..., half:], cos_c, sin_c)], axis=-1)
    return out.astype(t.dtype)


def q_proj(h, w_qkv):
    B, T = h.shape[:2]
    return (h @ w_qkv[:, :Q_DIM]).reshape(B, T, N_KV_HEADS, GROUP, HEAD_DIM)


def kv_proj(h, w_qkv):
    B, T = h.shape[:2]
    k, v = jnp.split(h @ w_qkv[:, Q_DIM:], 2, axis=-1)
    return k.reshape(B, T, N_KV_HEADS, HEAD_DIM), v.reshape(B, T, N_KV_HEADS, HEAD_DIM)


def sink_softmax(scores, sink):
    m = sink
    for s in scores:
        m = jnp.maximum(m, jnp.max(s, axis=-1, keepdims=True))
    probs = [jnp.exp(s - m) for s in scores]
    denom = jnp.exp(sink - m)
    for p in probs:
        denom = denom + jnp.sum(p, axis=-1, keepdims=True)
    return [p / denom for p in probs]


def latent_window_attention(q, k, v, k_ctx, v_ctx, sink):
    B, L = q.shape[:2]
    nb = L // BLOCK
    scale = HEAD_DIM ** -0.5
    qb = q.reshape(B, nb, BLOCK, N_KV_HEADS, GROUP, HEAD_DIM)

    def band(t):
        tp = jnp.pad(t, ((0, 0), (BLOCK, BLOCK), (0, 0), (0, 0))).reshape(B, nb + 2, BLOCK, N_KV_HEADS, HEAD_DIM)
        return jnp.concatenate([tp[:, :-2], tp[:, 1:-1], tp[:, 2:]], axis=2)

    kb, vb = band(k), band(v)
    s_loc = jnp.einsum('bnqhgd,bnkhd->bnhgqk', qb, kb, preferred_element_type=jnp.float32) * scale
    q_pos = jnp.arange(nb)[:, None] * BLOCK + jnp.arange(BLOCK)[None, :]
    k_pos = (jnp.arange(nb)[:, None] - 1) * BLOCK + jnp.arange(3 * BLOCK)[None, :]
    rel = k_pos[:, None, :] - q_pos[:, :, None]
    valid = (jnp.abs(rel) <= WINDOW) & (k_pos[:, None, :] >= 0) & (k_pos[:, None, :] < L)
    s_loc = jnp.where(valid[None, :, None, None, :, :], s_loc, NEG_INF)
    s_ctx = jnp.einsum('bnqhgd,bchd->bnhgqc', qb, k_ctx, preferred_element_type=jnp.float32) * scale
    p_loc, p_ctx = sink_softmax([s_loc, s_ctx], sink)
    o = (jnp.einsum('bnhgqk,bnkhd->bnqhgd', p_loc.astype(vb.dtype), vb)
         + jnp.einsum('bnhgqc,bchd->bnqhgd', p_ctx.astype(v_ctx.dtype), v_ctx))
    return o.reshape(B, L, Q_DIM)


def context_attention(q, k, v, sink):
    B, C = q.shape[:2]
    s = jnp.einsum('bqhgd,bkhd->bhgqk', q, k, preferred_element_type=jnp.float32) * HEAD_DIM ** -0.5
    (p,) = sink_softmax([s], sink)
    o = jnp.einsum('bhgqk,bkhd->bqhgd', p.astype(v.dtype), v)
    return o.reshape(B, C, Q_DIM)


def window_mean(h, w):
    T = h.shape[1]
    cs = jnp.pad(jnp.cumsum(h.astype(jnp.float32), axis=1), ((0, 0), (1, 0), (0, 0)))
    t = jnp.arange(T)
    lo = jnp.clip(t - w // 2, 0, T)
    hi = jnp.clip(t - w // 2 + w, 0, T)
    total = jnp.take(cs, hi, axis=1) - jnp.take(cs, lo, axis=1)
    return total / (hi - lo).astype(jnp.float32)[None, :, None]


def pool_mixer(h, pool_w, pool_b, pool_scale):
    B, T, _ = h.shape
    groups = jnp.split(h, N_POOL_GROUPS, axis=-1)
    d = jnp.stack([window_mean(g, w) - g.astype(jnp.float32) for g, w in zip(groups, POOL_WINDOWS)], axis=2)
    y = jnp.einsum('btgc,gcd->btgd', d.astype(h.dtype), pool_w) + pool_b.reshape(N_POOL_GROUPS, POOL_GROUP_DIM)
    return y.reshape(B, T, D_MODEL) * pool_scale


def swiglu(h, w_gu, w_down):
    g, u = jnp.split(h @ w_gu, 2, axis=-1)
    return (jax.nn.silu(g) * u) @ w_down


def moe_swiglu(h, router_w, router_b, w_gu, w_down):
    logits = (h @ router_w).astype(jnp.float32) + router_b.astype(jnp.float32)
    top_v, top_i = lax.top_k(logits, TOP_K)
    gates = jax.nn.softmax(top_v, axis=-1)
    combine = jnp.einsum('btk,btke->bte', gates, jax.nn.one_hot(top_i, N_EXPERTS, dtype=jnp.float32))
    y = jnp.zeros(h.shape, jnp.float32)
    for e in range(N_EXPERTS):
        y = y + combine[..., e:e + 1] * swiglu(h, w_gu[e], w_down[e]).astype(jnp.float32)
    return y.astype(h.dtype)


def setup_inputs(seed: int = 0) -> dict:
    key = jax.random.key(seed)
    ks = jax.random.split(key, 20)
    f32 = jnp.float32

    def dense(k, shape, fan_in):
        return jax.random.normal(k, shape, f32) * fan_in ** -0.5

    return {
        'x': jax.random.normal(ks[0], (BATCH, SEQ, D_MODEL), f32),
        'c': jax.random.normal(ks[1], (BATCH, D_MODEL), f32),
        'ctx': jax.random.normal(ks[2], (BATCH, CTX_LEN, D_MODEL), f32),
        'c_ctx': jax.random.normal(ks[3], (D_MODEL,), f32),
        'ada_w': 0.5 * dense(ks[4], (DEPTH, D_MODEL, 6 * D_MODEL), D_MODEL),
        'ada_b': 0.02 * jax.random.normal(ks[5], (DEPTH, 6 * D_MODEL), f32),
        'norm_g': 1.0 + 0.1 * jax.random.normal(ks[6], (DEPTH, 4, D_MODEL), f32),
        'attn_w_qkv': dense(ks[7], (N_ATTN_LAYERS, D_MODEL, Q_DIM + 2 * KV_DIM), D_MODEL),
        'attn_w_o': dense(ks[8], (N_ATTN_LAYERS, Q_DIM, D_MODEL), Q_DIM),
        'attn_sink': jax.random.normal(ks[9], (N_ATTN_LAYERS, N_HEADS), f32),
        'pool_w': dense(ks[10], (N_POOL_LAYERS, N_POOL_GROUPS, POOL_GROUP_DIM, POOL_GROUP_DIM), POOL_GROUP_DIM),
        'pool_b': 0.02 * jax.random.normal(ks[11], (N_POOL_LAYERS, D_MODEL), f32),
        'pool_scale': 1.0 + 0.1 * jax.random.normal(ks[12], (N_POOL_LAYERS, D_MODEL), f32),
        'ffn_w_gu': dense(ks[13], (N_ATTN_LAYERS, D_MODEL, 2 * D_FF), D_MODEL),
        'ffn_w_down': dense(ks[14], (N_ATTN_LAYERS, D_FF, D_MODEL), D_FF),
        'router_w': dense(ks[15], (N_POOL_LAYERS, D_MODEL, N_EXPERTS), D_MODEL),
        'router_b': 0.01 * jax.random.normal(ks[16], (N_POOL_LAYERS, N_EXPERTS), f32),
        'moe_w_gu': dense(ks[17], (N_POOL_LAYERS, N_EXPERTS, D_MODEL, 2 * D_FF_EXPERT), D_MODEL),
        'moe_w_down': dense(ks[18], (N_POOL_LAYERS, N_EXPERTS, D_FF_EXPERT, D_MODEL), D_FF_EXPERT),
    }


def reference(x, c, ctx, c_ctx, ada_w, ada_b, norm_g, attn_w_qkv, attn_w_o, attn_sink,
              pool_w, pool_b, pool_scale, ffn_w_gu, ffn_w_down, router_w, router_b,
              moe_w_gu, moe_w_down):
    rope = axial_rope_tables(x.shape[1])
    is_attn = [i % N_MIXERS == 0 for i in range(DEPTH)]
    for i in range(DEPTH):
        slot = i // N_MIXERS
        ctx_needed_later = any(is_attn[i + 1:])
        ctx_needed_now = is_attn[i] or ctx_needed_later
        sh_m, sc_m, gt_m, sh_f, sc_f, gt_f = ada_mod(c, ada_w[i], ada_b[i])
        g_pre_mix, g_post_mix, g_pre_ffn, g_post_ffn = norm_g[i]

        h = modulate(rmsnorm(x, g_pre_mix), sh_m, sc_m)
        if ctx_needed_now:
            csh_m, csc_m, cgt_m, csh_f, csc_f, cgt_f = ada_mod(c_ctx, ada_w[i], ada_b[i])
            hc = modulate(rmsnorm(ctx, g_pre_mix), csh_m, csc_m)
        if is_attn[i]:
            w_qkv = attn_w_qkv[slot]
            sink = attn_sink[slot].astype(jnp.float32).reshape(N_KV_HEADS, GROUP, 1, 1)
            q = apply_axial_rope(q_proj(h, w_qkv), rope)
            k, v = kv_proj(h, w_qkv)
            k = apply_axial_rope(k, rope)
            k_c, v_c = kv_proj(hc, w_qkv)
            y = latent_window_attention(q, k, v, k_c, v_c, sink) @ attn_w_o[slot]
            if ctx_needed_later:
                yc = context_attention(q_proj(hc, w_qkv), k_c, v_c, sink) @ attn_w_o[slot]
        else:
            y = pool_mixer(h, pool_w[slot], pool_b[slot], pool_scale[slot])
            if ctx_needed_later:
                yc = pool_mixer(hc, pool_w[slot], pool_b[slot], pool_scale[slot])
        x = x + gt_m * rmsnorm(y, g_post_mix)

        h = modulate(rmsnorm(x, g_pre_ffn), sh_f, sc_f)
        if i % 2 == 0:
            f = swiglu(h, ffn_w_gu[slot], ffn_w_down[slot])
        else:
            f = moe_swiglu(h, router_w[slot], router_b[slot], moe_w_gu[slot], moe_w_down[slot])
        x = x + gt_f * rmsnorm(f, g_post_ffn)

        if ctx_needed_later:
            ctx = ctx + cgt_m * rmsnorm(yc, g_post_mix)
            hc = modulate(rmsnorm(ctx, g_pre_ffn), csh_f, csc_f)
            if i % 2 == 0:
                fc = swiglu(hc, ffn_w_gu[slot], ffn_w_down[slot])
            else:
                fc = moe_swiglu(hc, router_w[slot], router_b[slot], moe_w_gu[slot], moe_w_down[slot])
            ctx = ctx + cgt_f * rmsnorm(fc, g_post_ffn)
    return x
```

```cpp
#include <hip/hip_runtime.h>
#include <cstdio>

#define GAS __attribute__((address_space(1)))
#define LAS __attribute__((address_space(3)))
typedef unsigned short bf16_t;
typedef short bf16x8 __attribute__((ext_vector_type(8)));
typedef float f32x4 __attribute__((ext_vector_type(4)));
typedef float f32x16 __attribute__((ext_vector_type(16)));
typedef unsigned u32x4 __attribute__((ext_vector_type(4)));
typedef unsigned u32x2 __attribute__((ext_vector_type(2)));
typedef int i32x4 __attribute__((ext_vector_type(4)));
typedef int i32x2 __attribute__((ext_vector_type(2)));
typedef int i32x8 __attribute__((ext_vector_type(8)));
template <bool I8> struct AccSel { typedef f32x4 T; };
template <> struct AccSel<true> { typedef i32x4 T; };

constexpr int D = 1024, NBATCH = 4, SEQ = 8192, CTXL = 256;
constexpr int ML = NBATCH * SEQ;
constexpr int MC = NBATCH * CTXL;
constexpr int MT = ML + MC;
constexpr int NQKV = 1536, KVD = 256;
constexpr int DFF = 2816, NE = 8, DFE = 3584;
constexpr int SLOTS = 69632;
constexpr int SWQ_OFF = 2 * 2 * 2816 + 16 * 2 * 3584;
constexpr int KP = 8;
constexpr float LOG2E = 1.4426950408889634f;
constexpr float NORM_EPS = 1e-6f;

constexpr size_t MiB = 1u << 20;
constexpr size_t WS_CTL = 0, CTL_ZERO_BYTES = 1 * MiB;
constexpr size_t WS_MODP = 1 * MiB;
constexpr size_t WS_ROPE = 5 * MiB;
constexpr size_t WS_MOD = 5 * MiB + 65536;
constexpr size_t WS_MOE = 6 * MiB;
constexpr size_t WS_XC = 8 * MiB;
constexpr size_t WS_WQKV = 12 * MiB;
constexpr size_t WS_WO = 18 * MiB;
constexpr size_t WS_WPOOL = 22 * MiB;
constexpr size_t WS_WFGU = 23 * MiB;
constexpr size_t WS_WFDN = 45 * MiB;
constexpr size_t WS_WMGU = 56 * MiB;
constexpr size_t WS_WMDN = 280 * MiB;
constexpr size_t WS_H = 392 * MiB;
constexpr size_t WS_Q = 458 * MiB;
constexpr size_t WS_K = 524 * MiB;
constexpr size_t WS_V = 541 * MiB;
constexpr size_t WS_Y = 558 * MiB;
constexpr size_t WS_ACT = 694 * MiB;
constexpr size_t WS_SA = 1170 * MiB;
constexpr size_t WS_SAS = 1170 * MiB + 512 * 1024;
constexpr size_t WS_SDN = 1170 * MiB + 800 * 1024;
constexpr size_t CTL_COLMAX = 128 * 1024;
constexpr size_t WS_XB = 1204 * MiB;
constexpr size_t WS_HQ = 1171 * MiB;
constexpr size_t WS_SW = 7 * MiB + 512 * 1024;
constexpr size_t WS_END = 1270 * MiB;
constexpr size_t MO_INFO = 0;
constexpr size_t MO_SLOT = 640 * 1024;
constexpr size_t MO_ROWIDX = 1024 * 1024;
constexpr size_t MO_WGCNT = 1024 * 1024 + 320 * 1024;
constexpr size_t MO_TAB = 1024 * 1024 + 384 * 1024;
constexpr int CW_BAR = 4096;
constexpr int CW_QITEM = 16384;

constexpr int RING_BYTES = 131072;
constexpr int LDSCTL_OFF = RING_BYTES;
constexpr int EPI_SCR_OFF = LDSCTL_OFF + 256;
constexpr int IDX_SCR_OFF = EPI_SCR_OFF + 4096;
constexpr int LDS_BYTES = 147456;

__device__ __forceinline__ unsigned cvt_pk_bf16(float lo, float hi) { unsigned r; asm("v_cvt_pk_bf16_f32 %0, %1, %2" : "=v"(r) : "v"(lo), "v"(hi)); return r; }
__device__ __forceinline__ float bf_lo(unsigned w) { return __uint_as_float(w << 16); }
__device__ __forceinline__ float bf_hi(unsigned w) { return __uint_as_float(w & 0xffff0000u); }
__device__ __forceinline__ float wave_sum(float v) {
#pragma unroll
    for (int o = 1; o < 64; o <<= 1) v += __shfl_xor(v, o);
    return v;
}
__device__ __forceinline__ float fast_exp2(float x) { return __builtin_amdgcn_exp2f(x); }
__device__ __forceinline__ float fast_rcp(float x) { return __builtin_amdgcn_rcpf(x); }
__device__ __forceinline__ float clamp448(float x) { return __builtin_amdgcn_fmed3f(x, -448.0f, 448.0f); }
__device__ __forceinline__ unsigned pk4_fp8(float a, float b, float c, float d) {
    unsigned w = 0u; w = (unsigned)__builtin_amdgcn_cvt_pk_fp8_f32(clamp448(a), clamp448(b), (int)w, false); w = (unsigned)__builtin_amdgcn_cvt_pk_fp8_f32(clamp448(c), clamp448(d), (int)w, true); return w; }

__device__ __forceinline__ unsigned pk4_fp8_sat(float a, float b, float c, float d) {
    unsigned w = 0u; w = (unsigned)__builtin_amdgcn_cvt_pk_fp8_f32(a, b, (int)w, false); w = (unsigned)__builtin_amdgcn_cvt_pk_fp8_f32(c, d, (int)w, true); return w; }
#define XB_TMO      128
#define XB_XCNT(j)  (256  + 64 * (j))
#define XB_XSUB(j)  (1280 + 64 * (j))
#define XB_XGEN(j)  (2304 + 64 * (j))
#define XB_FLAG     3328
#define XCD_BAR_WORDS 3456
#define XB_SPIN_CAP (1u << 18)
__device__ __forceinline__ unsigned xb_ld(unsigned* p)              { return __hip_atomic_load(p, __ATOMIC_RELAXED, __HIP_MEMORY_SCOPE_AGENT); }
__device__ __forceinline__ unsigned xb_add(unsigned* p, unsigned v) { return __hip_atomic_fetch_add(p, v, __ATOMIC_RELAXED, __HIP_MEMORY_SCOPE_AGENT); }
__device__ __forceinline__ unsigned xb_xcc_id() { return (unsigned)__builtin_amdgcn_s_getreg((3 << 11) | 20) & 0xFu; }
#define XB_SPIN(cond, bar) do { unsigned _sp = 0; while (cond) { __builtin_amdgcn_s_sleep(1); \
    if ((++_sp & 255u) == 0u) { if (xb_ld(&(bar)[XB_TMO])) break; if (_sp > XB_SPIN_CAP) { atomicAdd(&(bar)[XB_TMO], 1u); break; } } } } while (0)
struct XcdBarrier { unsigned* bar; unsigned x; volatile LAS unsigned* st; };
__device__ __forceinline__ XcdBarrier xcd_barrier_post(unsigned* bar, volatile LAS unsigned* st) {
    XcdBarrier b; b.bar = bar; b.x = xb_xcc_id(); b.st = st;
    if (threadIdx.x == 0) (void)xb_add(&bar[XB_XCNT(b.x)], 1u);
    return b;
}
__device__ __forceinline__ void xcd_barrier_complete(unsigned* bar, unsigned x, unsigned& nloc, unsigned& mask) {
    const unsigned G = gridDim.x * gridDim.y * gridDim.z;
    unsigned sum, msk, mine, sp = 0u;
    for (;;) {
        sum = 0u; msk = 0u; mine = 0u;
#pragma unroll
        for (unsigned j = 0; j < 16; ++j) { const unsigned c = xb_ld(&bar[XB_XCNT(j)]); sum += c; msk |= (c > 0u) ? (1u << j) : 0u; mine = (j == x) ? c : mine; }
        if (sum == G) break;
        __builtin_amdgcn_s_sleep(1);
        if ((++sp & 255u) == 0u) { if (xb_ld(&bar[XB_TMO])) break; if (sp > XB_SPIN_CAP) { atomicAdd(&bar[XB_TMO], 1u); break; } }
    }
    nloc = mine > 0u ? mine : 1u; mask = msk;
}
__device__ __forceinline__ u32x4 xb_ld4(const unsigned* p) { u32x4 v; asm volatile("global_load_dwordx4 %0, %1, off sc1\n\ts_waitcnt vmcnt(0)" : "=v"(v) : "v"(p) : "memory"); return v; }
__device__ __forceinline__ void xcd_barrier(const XcdBarrier& b) {
    asm volatile("s_waitcnt vmcnt(0)" ::: "memory");
    __syncthreads();
    if (threadIdx.x == 0) {
        unsigned* bar = b.bar;
        __builtin_amdgcn_s_waitcnt(0);
        unsigned nloc = b.st[0], mask = b.st[1];
        if (nloc == 0u) { xcd_barrier_complete(bar, b.x, nloc, mask); b.st[0] = nloc; b.st[1] = mask; }
        const unsigned old = xb_add(&bar[XB_XSUB(b.x)], 1u);
        const unsigned gen = old / nloc, tgt = gen + 1u;
        if (old + 1u == tgt * nloc) {
            __builtin_amdgcn_fence(__ATOMIC_RELEASE, "agent");
            asm volatile("s_waitcnt vmcnt(0)" ::: "memory");
            __hip_atomic_store(&bar[XB_FLAG + b.x], tgt, __ATOMIC_RELAXED, __HIP_MEMORY_SCOPE_AGENT);
        }
        unsigned sp = 0u;
        for (;;) {
            unsigned late = 0u;
#pragma unroll
            for (unsigned q = 0; q < 4; ++q) { const u32x4 v = xb_ld4(&bar[XB_FLAG + 4 * q]);
#pragma unroll
                for (unsigned j = 0; j < 4; ++j) late |= ((int)(v[j] - tgt) < 0) ? (1u << (4 * q + j)) : 0u; }
            if ((late & mask) == 0u) break;
            __builtin_amdgcn_s_sleep(1);
            if ((++sp & 255u) == 0u) { if (xb_ld(&bar[XB_TMO])) break; if (sp > XB_SPIN_CAP) { atomicAdd(&bar[XB_TMO], 1u); break; } }
        }
        __builtin_amdgcn_fence(__ATOMIC_ACQUIRE, "agent");
        asm volatile("s_waitcnt vmcnt(0)" ::: "memory");
    }
    __syncthreads();
}

namespace pg8 {
constexpr int BM = 256, BK = 64, HALF = 128, HTB = HALF * BK * 2, STAGE_BYTES = 8 * HTB, NXCD = 8, WGM = 8;
__device__ __forceinline__ int lds_byte(int r, int c) { const int st = (r >> 4) * 2 + (c >> 5), rr = r & 15, cc = c & 31, ob = rr * 64 + cc * 2; return st * 1024 + (ob ^ (((ob >> 9) & 1) << 5)); }
__device__ __forceinline__ void stage_rc(int b, int& R, int& C) { const int st = b / 1024, sb = b % 1024, swz = sb ^ (((sb >> 9) & 1) << 5); R = (st >> 1) * 16 + swz / 64; C = (st & 1) * 32 + (swz % 64) / 2; }
__device__ __forceinline__ int perm32(int rho) { const int n = rho >> 4, i = rho & 15; return 8 * (i >> 2) + 4 * n + (i & 3); }

struct Unit { int pm, pn, e, r0, nai; const char* a; const char* b; };
__device__ __forceinline__ f32x4 mma16(bf16x8 a, bf16x8 b, f32x4 c) { return __builtin_amdgcn_mfma_f32_16x16x32_bf16(a, b, c, 0, 0, 0); }
struct Frag16 { bf16x8 k[2]; };
struct Frag32 { i32x8 v; };
template <int MODE> struct FragSel { typedef Frag16 T; };
template <> struct FragSel<2> { typedef Frag32 T; };
__device__ __forceinline__ void load_frag(Frag16& f, const LAS unsigned char* p) { f.k[0] = *(const LAS bf16x8*)p; f.k[1] = *(const LAS bf16x8*)(p + 1024); }
__device__ __forceinline__ void load_frag(Frag32& f, const LAS unsigned char* p) { const i32x4 lo = *(const LAS i32x4*)p, hi = *(const LAS i32x4*)(p + 1024); f.v = __builtin_shufflevector(lo, hi, 0, 1, 2, 3, 4, 5, 6, 7); }
__device__ __forceinline__ f32x4 mma_frag(const Frag32& a, const Frag32& b, f32x4 c) {
    asm("v_mfma_f32_16x16x128_f8f6f4 %0, %1, %2, %0" : "+v"(c) : "v"(a.v), "v"(b.v));
    return c; }
__device__ __forceinline__ i32x4 mma16(bf16x8 a, bf16x8 b, i32x4 c) { return __builtin_amdgcn_mfma_i32_16x16x64_i8(__builtin_bit_cast(i32x4, a), __builtin_bit_cast(i32x4, b), c, 0, 0, 0); }
__device__ __forceinline__ f32x4 mma_frag_z(const Frag32& a, const Frag32& b, f32x4) {
    f32x4 c;
    asm("v_mfma_f32_16x16x128_f8f6f4 %0, %1, %2, 0" : "=&v"(c) : "v"(a.v), "v"(b.v));
    return c; }
__device__ __forceinline__ f32x4 mma_frag_z(const Frag16& a, const Frag16& b, f32x4) { const f32x4 c = mma16(a.k[0], b.k[0], (f32x4){0.f, 0.f, 0.f, 0.f}); return mma16(a.k[1], b.k[1], c); }
__device__ __forceinline__ i32x4 mma_frag_z(const Frag16& a, const Frag16& b, i32x4) { i32x4 c; asm("v_mfma_i32_16x16x64_i8 %0, %1, %2, 0" : "=&v"(c) : "v"(a.k[0]), "v"(b.k[0])); return mma16(a.k[1], b.k[1], c); }
__device__ __forceinline__ f32x4 mma_frag(const Frag16& a, const Frag16& b, f32x4 c) { c = mma16(a.k[0], b.k[0], c); return mma16(a.k[1], b.k[1], c); }
__device__ __forceinline__ i32x4 mma_frag(const Frag16& a, const Frag16& b, i32x4 c) { c = mma16(a.k[0], b.k[0], c); return mma16(a.k[1], b.k[1], c); }
struct Gemm { int lda, ldb, K; };

template <class Epi, class Sched, bool GATHER, int MODE = 0>
__device__ __forceinline__ void gemm_phase(LAS unsigned char* lds, const Gemm g, const Sched& S, const Epi& E, int tid) {
    const int wid = __builtin_amdgcn_readfirstlane(tid >> 6), lane = tid & 63, wr = wid >> 2, wc = wid & 3, fr = lane & 15, fq = lane >> 4;
    const int K = g.K, nt = K / BK;
    LAS unsigned char* const lds_ctl = lds;
    int R0, C0; stage_rc(tid * 16, R0, C0);
    const int Rb0 = (R0 & ~31) + perm32(R0 & 31);
    const unsigned voffA = (unsigned)(R0 * g.lda + C0) * 2u, voffB = (unsigned)(Rb0 * g.ldb + C0) * 2u;
    const unsigned dA64 = (unsigned)(64 * g.lda) * 2u, dB64 = (unsigned)(64 * g.ldb) * 2u;
    const size_t kstep = (size_t)(BK * 2);
    const size_t hstepA = (size_t)HALF * g.lda * 2, hstepB = (size_t)HALF * g.ldb * 2;
    const unsigned ldsw = (unsigned)wid * 1024u;
    const int aoff = lds_byte(wr * 64 + fr, fq * 8), boff = lds_byte(wc * 32 + fr, fq * 8);
    unsigned vo[4];
#define PG8_SA(b, h) (((b) * 2 + (h)) * HTB)
#define PG8_SB(b, h) ((4 + (b) * 2 + (h)) * HTB)
    const __amdgpu_buffer_rsrc_t rsA = __builtin_amdgcn_make_buffer_rsrc((void*)S.A, 0, -1, 0x00020000), rsB = __builtin_amdgcn_make_buffer_rsrc((void*)S.B, 0, -1, 0x00020000);
#define PG8_STAGE2(bufoff, rs_, base_, gbase, v0_, v1_, d1_) do { const unsigned so_ = (unsigned)((const char*)(gbase) - (const char*)(base_)); \
        __builtin_amdgcn_raw_ptr_buffer_load_lds(rs_, (LAS void*)(lds + (bufoff) + ldsw), 16, (int)(v0_), (int)so_, 0, 0); \
        __builtin_amdgcn_raw_ptr_buffer_load_lds(rs_, (LAS void*)(lds + (bufoff) + ldsw + 8192), 16, (int)(v1_), (int)(so_ + (unsigned)(d1_)), 0, 0); } while (0)
#define PG8_STAGE(bufoff, gbase, voff) PG8_STAGE2(bufoff, rsB, S.B, gbase, voffB, voffB, dB64)
#define PG8_STGA(bufoff, ptr, h, nx) do { if constexpr (GATHER) { PG8_STAGE2(bufoff, rsA, S.A, ptr, vo[2 * (h)], vo[2 * (h) + 1], 0u); } \
        else { PG8_STAGE2(bufoff, rsA, S.A, (ptr) + (h) * hstepA, voffA, voffA, dA64); } } while (0)
#define PG8_LDA(dst, b, h) do { _Pragma("unroll") for (int m = 0; m < 4; ++m) load_frag(dst[m], lds + PG8_SA(b, h) + aoff + m * 2048); } while (0)
#define PG8_LDB(dst, b, h) do { _Pragma("unroll") for (int n = 0; n < 2; ++n) load_frag(dst[n], lds + PG8_SB(b, h) + boff + n * 2048); } while (0)
#define PG8_MMA(ai, bj, At, Bt) do { __builtin_amdgcn_s_setprio(1); _Pragma("unroll") for (int m = 0; m < 4; ++m) _Pragma("unroll") for (int n = 0; n < 2; ++n) \
        acc[ai][bj][m][n] = mma_frag(Bt[n], At[m], acc[ai][bj][m][n]); __builtin_amdgcn_s_setprio(0); } while (0)
#define PG8_MMAZ(ai, bj, At, Bt) do { __builtin_amdgcn_s_setprio(1); _Pragma("unroll") for (int m = 0; m < 4; ++m) _Pragma("unroll") for (int n = 0; n < 2; ++n) \
        acc[ai][bj][m][n] = mma_frag_z(Bt[n], At[m], acc[ai][bj][m][n]); __builtin_amdgcn_s_setprio(0); } while (0)
#define PG8_WAIT_V(n) asm volatile("s_waitcnt vmcnt(" #n ")" ::: "memory")
#define PG8_WAIT_L(n) asm volatile("s_waitcnt lgkmcnt(" #n ")" ::: "memory")
#define PG8_BAR __builtin_amdgcn_s_barrier()
#define PG8_SCHED __builtin_amdgcn_sched_barrier(0)
    Unit cur, nxt; int ui = 0;
    if (!S.next(0, cur)) return;
#define PG8_PREF(u_, ui_) do { if constexpr (Epi::PREF) { const float* _pp = E.pref_ptr(u_, wid, lane); \
        if (_pp) __builtin_amdgcn_global_load_lds((const unsigned*)_pp, (LAS unsigned*)(lds_ctl + EPI_SCR_OFF + ((ui_) & 1) * 2048 + wid * 256), 4, 0, 0); } } while (0)
    PG8_PREF(cur, 0);
    if constexpr (GATHER) {
#pragma unroll
        for (int h = 0; h < 2; ++h) { vo[2 * h] = ((unsigned)S.row(cur, h * HALF + R0) * (unsigned)g.lda + (unsigned)C0) * 2u; vo[2 * h + 1] = ((unsigned)S.row(cur, h * HALF + R0 + 64) * (unsigned)g.lda + (unsigned)C0) * 2u; }
    }
    typedef typename AccSel<MODE == 1>::T AccT;
    AccT acc[2][2][4][2];
#define PG8_ZERO() do { if constexpr (false) { _Pragma("unroll") for (int a = 0; a < 2; ++a) _Pragma("unroll") for (int b = 0; b < 2; ++b) _Pragma("unroll") for (int m = 0; m < 4; ++m) _Pragma("unroll") for (int n = 0; n < 2; ++n) acc[a][b][m][n] = (AccT){0, 0, 0, 0}; } } while (0)
    PG8_ZERO();
    typedef typename FragSel<MODE>::T FragT;
    FragT At[4], B0[2], B1[2];
    const char* cA = cur.a; const char* cB = cur.b;
    PG8_STAGE(PG8_SB(0, 0), cB, voffB); PG8_STAGE(PG8_SB(0, 1), cB + hstepB, voffB); PG8_STGA(PG8_SA(0, 0), cA, 0, false); PG8_STGA(PG8_SA(0, 1), cA, 1, false);
    if (wr == 1) PG8_BAR;
    PG8_WAIT_V(2); PG8_BAR;
    PG8_STAGE(PG8_SB(1, 0), cB + kstep, voffB); PG8_STGA(PG8_SA(1, 0), cA + kstep, 0, false); PG8_STAGE(PG8_SB(1, 1), cB + hstepB + kstep, voffB);
    PG8_WAIT_V(6); PG8_BAR;
    for (;;) {
        const bool has_next = S.next(ui + 1, nxt);
        if constexpr (GATHER) {
            if (has_next) { if (wid < 4) __builtin_amdgcn_global_load_lds((const unsigned*)S.row_ptr(nxt, wid * 64 + lane), (LAS unsigned*)(lds_ctl + IDX_SCR_OFF + ((ui + 1) & 1) * 1024 + wid * 256), 4, 0, 0); }
        }
        const char* nA = has_next ? nxt.a : cA; const char* nB = has_next ? nxt.b : cB;
        for (int t = 0; t < nt; t += 2) {
            const bool last = (t == nt - 2);
            const char* a1 = cA + (size_t)(t + 1) * kstep;
            const char* a2 = last ? nA : cA + (size_t)(t + 2) * kstep; const char* b2 = last ? nB : cB + (size_t)(t + 2) * kstep;
            const char* a3 = a2 + kstep; const char* b3 = b2 + kstep;
            PG8_LDB(B0, 0, 0); PG8_LDB(B1, 0, 1); PG8_SCHED; PG8_LDA(At, 0, 0); PG8_STGA(PG8_SA(1, 1), a1, 1, false);
            if constexpr (GATHER) { if (last && has_next) {
                const LAS unsigned* it_ = (const LAS unsigned*)(lds_ctl + IDX_SCR_OFF + ((ui + 1) & 1) * 1024);
#pragma unroll
                for (int h = 0; h < 2; ++h) { vo[2 * h] = (it_[h * HALF + R0] * (unsigned)g.lda + (unsigned)C0) * 2u; vo[2 * h + 1] = (it_[h * HALF + R0 + 64] * (unsigned)g.lda + (unsigned)C0) * 2u; } } }
            PG8_WAIT_V(8); PG8_WAIT_L(0); PG8_BAR; if (t == 0) { PG8_MMAZ(0, 0, At, B0); PG8_MMAZ(0, 1, At, B1); } else { PG8_MMA(0, 0, At, B0); PG8_MMA(0, 1, At, B1); } PG8_BAR; PG8_SCHED;
            PG8_LDA(At, 0, 1); PG8_STAGE(PG8_SB(0, 0), b2, voffB); PG8_STAGE(PG8_SB(0, 1), b2 + hstepB, voffB); PG8_STGA(PG8_SA(0, 0), a2, 0, last);
            PG8_WAIT_V(8); PG8_WAIT_L(0); PG8_BAR; if (GATHER || cur.nai == 2) { if (t == 0) { PG8_MMAZ(1, 0, At, B0); PG8_MMAZ(1, 1, At, B1); } else { PG8_MMA(1, 0, At, B0); PG8_MMA(1, 1, At, B1); } } PG8_BAR; PG8_SCHED;
            PG8_LDB(B0, 1, 0); PG8_LDB(B1, 1, 1); PG8_SCHED; PG8_LDA(At, 1, 0); PG8_STGA(PG8_SA(0, 1), a2, 1, last);
            PG8_WAIT_V(8); PG8_WAIT_L(0); PG8_BAR; PG8_MMA(0, 0, At, B0); PG8_MMA(0, 1, At, B1); PG8_BAR; PG8_SCHED;
            PG8_LDA(At, 1, 1); PG8_STAGE(PG8_SB(1, 0), b3, voffB); PG8_STAGE(PG8_SB(1, 1), b3 + hstepB, voffB); PG8_STGA(PG8_SA(1, 0), a3, 0, last);
            PG8_WAIT_V(8); PG8_WAIT_L(0); PG8_BAR; if (GATHER || cur.nai == 2) { PG8_MMA(1, 0, At, B0); PG8_MMA(1, 1, At, B1); } PG8_BAR; PG8_SCHED;
        }
        if (wr == 0) PG8_BAR;
        if constexpr (MODE == 2) asm volatile("s_nop 15\n\ts_nop 7" ::: "memory");
        if constexpr (Epi::PREF) E(acc, cur, wr, wc, fr, fq, (const LAS float*)(lds_ctl + EPI_SCR_OFF + (ui & 1) * 2048));
        else E(acc, cur, wr, wc, fr, fq);
        if (!has_next) break;
        PG8_ZERO();
        cur = nxt; cA = nA; cB = nB; ++ui;
        PG8_PREF(cur, ui);
        if (wr == 1) PG8_BAR;
    }
    PG8_WAIT_V(0);
    PG8_BAR;
#undef PG8_PREF
#undef PG8_SA
#undef PG8_SB
#undef PG8_STAGE
#undef PG8_STAGE2
#undef PG8_STGA
#undef PG8_LDA
#undef PG8_LDB
#undef PG8_MMA
#undef PG8_MMAZ
#undef PG8_ZERO
#undef PG8_WAIT_V
#undef PG8_WAIT_L
#undef PG8_BAR
#undef PG8_SCHED
}

struct DenseOrder {
    int nM, nN, nwg, G, c; const char* A; const char* B; unsigned tstepA, tstepB, acolstep;
    __device__ __forceinline__ void init(int nM_, int nN_, int G_, int c_, const void* A_, const void* B_, int lda, int ldb, size_t acolstep_) {
        nM = nM_; nN = nN_; nwg = nM * nN; G = G_; c = c_; A = (const char*)A_; B = (const char*)B_; tstepA = (unsigned)(BM * lda * 2); tstepB = (unsigned)(BM * ldb * 2); acolstep = (unsigned)acolstep_; }
    __device__ __forceinline__ bool next(int i, Unit& u) const {
        const int nfull = (nwg / G) * G, R = nwg - nfull; const bool hs = R > 0 && 2 * R <= G;
        const long L = (long)i * G + c; if (L >= (hs ? nfull + 2 * R : nwg)) return false;
        int wgid = (int)L, sub = 0; u.nai = 2;
        if (hs && wgid >= nfull) { const int j = wgid - nfull; wgid = nfull + (j >> 1); sub = j & 1; u.nai = 1; }
        { const int q = nwg / NXCD, r = nwg % NXCD, xcd = wgid % NXCD, off = wgid / NXCD; wgid = (xcd < r ? xcd * (q + 1) : r * (q + 1) + (xcd - r) * q) + off; }
        const int nig = WGM * nN, gid = wgid / nig, fm = gid * WGM, gsz = (nM - fm) < WGM ? (nM - fm) : WGM;
        u.pm = fm + ((wgid % nig) % gsz); u.pn = (wgid % nig) / gsz; u.r0 = u.pm * BM + sub * HALF;
        u.e = 0; u.a = A + (size_t)u.pm * tstepA + (size_t)sub * (tstepA >> 1) + (size_t)u.pn * acolstep; u.b = B + (size_t)u.pn * tstepB; return true;
    }
    __device__ __forceinline__ int row(const Unit&, int) const { return 0; }
    __device__ __forceinline__ const int* row_ptr(const Unit&, int) const { return nullptr; }
};
struct MoeOrder {
    int nM, nN, nwg, G, c; const char* A; const char* B; unsigned tstepA, tstepB, estride; const int* rowidx; int gather;
    int t1, t2, t3, t4, t5, t6, t7;
    __device__ __forceinline__ bool next(int i, Unit& u) const {
        const int nfull = (nwg / G) * G, R = nwg - nfull; const bool hs = !gather && R > 0 && 2 * R <= G;
        const long L = (long)i * G + c; if (L >= (hs ? nfull + 2 * R : nwg)) return false;
        int wgid = (int)L, sub = 0; u.nai = 2;
        if (hs && wgid >= nfull) { const int j = wgid - nfull; wgid = nfull + (j >> 1); sub = j & 1; u.nai = 1; }
        { const int q = nwg / NXCD, r = nwg % NXCD, xcd = wgid % NXCD, off = wgid / NXCD; wgid = (xcd < r ? xcd * (q + 1) : r * (q + 1) + (xcd - r) * q) + off; }
        const int nig = WGM * nN, gid = wgid / nig, fm = gid * WGM, gsz = (nM - fm) < WGM ? (nM - fm) : WGM;
        u.pm = fm + ((wgid % nig) % gsz); u.pn = (wgid % nig) / gsz; u.r0 = u.pm * BM + sub * HALF;
        const int pm = u.pm;
        const int e = (pm >= t1) + (pm >= t2) + (pm >= t3) + (pm >= t4) + (pm >= t5) + (pm >= t6) + (pm >= t7);
        u.e = e; u.a = gather ? A : A + (size_t)pm * tstepA + (size_t)sub * (tstepA >> 1); u.b = B + (size_t)e * estride + (size_t)u.pn * tstepB; return true;
    }
    __device__ __forceinline__ int row(const Unit& u, int r) const { return rowidx[u.pm * BM + r]; }
    __device__ __forceinline__ const int* row_ptr(const Unit& u, int r) const { return rowidx + u.pm * BM + r; }
};

typedef const f32x4 (&AccRef)[2][2][4][2];
struct EpiPlain {
    static constexpr bool PREF = false;
    bf16_t* O; int ldc;
    __device__ __forceinline__ void operator()(AccRef acc, const Unit& u, int wr, int wc, int fr, int fq) const {
        const int row0 = u.r0 + wr * 64 + fr, col0 = u.pn * BM + wc * 32 + 8 * fq;
#pragma unroll
        for (int ai = 0; ai < 2; ++ai) if (ai < u.nai)
#pragma unroll
            for (int m = 0; m < 4; ++m) { bf16_t* rowp = O + (size_t)(row0 + ai * HALF + m * 16) * ldc + col0;
#pragma unroll
                for (int bj = 0; bj < 2; ++bj) { const f32x4 v0 = acc[ai][bj][m][0], v1 = acc[ai][bj][m][1];
                    u32x4 w; w.x = cvt_pk_bf16(v0[0], v0[1]); w.y = cvt_pk_bf16(v0[2], v0[3]); w.z = cvt_pk_bf16(v1[0], v1[1]); w.w = cvt_pk_bf16(v1[2], v1[3]);
                    *(u32x4*)(rowp + bj * HALF) = w; } }
    }
};
struct EpiPool {
    static constexpr bool PREF = true;
    bf16_t* O; const float* bias; const float* scale;
    __device__ __forceinline__ const float* pref_ptr(const Unit& u, int wid, int lane) const {
        return wid < 4 ? bias + u.pn * BM + wid * 64 + lane : scale + u.pn * BM + (wid - 4) * 64 + lane; }
    __device__ __forceinline__ void operator()(AccRef acc, const Unit& u, int wr, int wc, int fr, int fq, const LAS float* scr) const {
        const int row0 = u.r0 + wr * 64 + fr, col0 = u.pn * BM + wc * 32 + 8 * fq;
        const LAS float* cp = scr + wc * 32 + 8 * fq;
#pragma unroll
        for (int bj = 0; bj < 2; ++bj) {
            const f32x4 b0 = *(const LAS f32x4*)(cp + bj * HALF), b1 = *(const LAS f32x4*)(cp + bj * HALF + 4);
            const f32x4 s0 = *(const LAS f32x4*)(cp + 256 + bj * HALF), s1 = *(const LAS f32x4*)(cp + 256 + bj * HALF + 4);
#pragma unroll
            for (int ai = 0; ai < 2; ++ai) if (ai < u.nai)
#pragma unroll
                for (int m = 0; m < 4; ++m) { bf16_t* rowp = O + (size_t)(row0 + ai * HALF + m * 16) * D + col0;
                    const f32x4 v0 = (acc[ai][bj][m][0] + b0) * s0, v1 = (acc[ai][bj][m][1] + b1) * s1;
                    u32x4 w; w.x = cvt_pk_bf16(v0[0], v0[1]); w.y = cvt_pk_bf16(v0[2], v0[3]); w.z = cvt_pk_bf16(v1[0], v1[1]); w.w = cvt_pk_bf16(v1[2], v1[3]);
                    *(u32x4*)(rowp + bj * HALF) = w; }
        }
    }
};
struct EpiSwiglu {
    static constexpr bool PREF = false;
    bf16_t* O; int ldc;
    __device__ __forceinline__ void operator()(AccRef acc, const Unit& u, int wr, int wc, int fr, int fq) const {
        const int row0 = u.r0 + wr * 64 + fr, col0 = u.pn * HALF + wc * 32 + 8 * fq;
#pragma unroll
        for (int ai = 0; ai < 2; ++ai) if (ai < u.nai)
#pragma unroll
            for (int m = 0; m < 4; ++m) { bf16_t* rowp = O + (size_t)(row0 + ai * HALF + m * 16) * ldc + col0;
                float o[8];
#pragma unroll
                for (int n = 0; n < 2; ++n)
#pragma unroll
                    for (int j = 0; j < 4; ++j) { const float gv = acc[ai][0][m][n][j], uv = acc[ai][1][m][n][j];
                        o[4 * n + j] = gv * fast_rcp(1.0f + fast_exp2(-gv * LOG2E)) * uv; }
                u32x4 w; w.x = cvt_pk_bf16(o[0], o[1]); w.y = cvt_pk_bf16(o[2], o[3]); w.z = cvt_pk_bf16(o[4], o[5]); w.w = cvt_pk_bf16(o[6], o[7]);
                *(u32x4*)rowp = w; }
    }
};
typedef const i32x4 (&AccRefI)[2][2][4][2];
struct EpiSwigluQ {
    static constexpr bool PREF = true;
    unsigned char* O; int ldc; const float* sa; const float* sw; int swe;
    __device__ __forceinline__ const float* pref_ptr(const Unit& u, int wid, int lane) const {
        return wid < 4 ? sa + (size_t)u.r0 + wid * 64 + lane : sw + (size_t)u.e * swe + u.pn * BM + (wid - 4) * 64 + lane; }
    __device__ __forceinline__ void operator()(AccRefI acc, const Unit& u, int wr, int wc, int fr, int fq, const LAS float* scr) const {
        typedef float f32x2 __attribute__((ext_vector_type(2)));
        const int row0 = u.r0 + wr * 64 + fr, col0 = u.pn * HALF + wc * 32 + 8 * fq;
        const LAS float* swp = scr + 256 + wc * 32 + 8 * fq;
        f32x2 wl[4], wp[4];
#pragma unroll
        for (int q = 0; q < 4; ++q) { const f32x2 g2 = *(const LAS f32x2*)(swp + 2 * q), u2 = *(const LAS f32x2*)(swp + HALF + 2 * q); wl[q] = g2 * (-LOG2E); wp[q] = g2 * u2; }
#pragma unroll
        for (int ai = 0; ai < 2; ++ai) if (ai < u.nai)
#pragma unroll
            for (int m = 0; m < 4; ++m) { const int row = row0 + ai * HALF + m * 16; unsigned char* rowp = O + (size_t)row * ldc + col0;
                const float sr = scr[ai * HALF + wr * 64 + m * 16 + fr], sr2 = sr * sr;
                f32x2 o2[4];
#pragma unroll
                for (int q = 0; q < 4; ++q) { const int n = q >> 1, j = 2 * (q & 1);
                    const f32x2 G2 = {(float)acc[ai][0][m][n][j], (float)acc[ai][0][m][n][j + 1]}, U2 = {(float)acc[ai][1][m][n][j], (float)acc[ai][1][m][n][j + 1]};
                    const f32x2 t2 = (G2 * wl[q]) * sr;
                    f32x2 d2; d2.x = fast_exp2(t2.x); d2.y = fast_exp2(t2.y); d2 = d2 + 1.0f;
                    f32x2 r2; r2.x = fast_rcp(d2.x); r2.y = fast_rcp(d2.y);
                    o2[q] = ((G2 * U2) * wp[q]) * (r2 * sr2); }
                u32x2 w; w.x = pk4_fp8_sat(o2[0].x, o2[0].y, o2[1].x, o2[1].y); w.y = pk4_fp8_sat(o2[2].x, o2[2].y, o2[3].x, o2[3].y);
                *(u32x2*)rowp = w; }
    }
};
struct EpiPlainS {
    static constexpr bool PREF = true;
    bf16_t* O; int ldc; const float* cs; int cse;
    __device__ __forceinline__ const float* pref_ptr(const Unit& u, int wid, int lane) const {
        return wid < 4 ? (const float*)nullptr : cs + (size_t)u.e * cse + u.pn * BM + (wid - 4) * 64 + lane; }
    __device__ __forceinline__ void operator()(AccRef acc, const Unit& u, int wr, int wc, int fr, int fq, const LAS float* scr) const {
        const int row0 = u.r0 + wr * 64 + fr, col0 = u.pn * BM + wc * 32 + 8 * fq;
        const LAS float* cp = scr + 256 + wc * 32 + 8 * fq;
#pragma unroll
        for (int bj = 0; bj < 2; ++bj) {
            const f32x4 s0 = *(const LAS f32x4*)(cp + bj * HALF), s1 = *(const LAS f32x4*)(cp + bj * HALF + 4);
#pragma unroll
            for (int ai = 0; ai < 2; ++ai) if (ai < u.nai)
#pragma unroll
                for (int m = 0; m < 4; ++m) { bf16_t* rowp = O + (size_t)(row0 + ai * HALF + m * 16) * ldc + col0;
                    const f32x4 v0 = acc[ai][bj][m][0] * s0, v1 = acc[ai][bj][m][1] * s1;
                    u32x4 w; w.x = cvt_pk_bf16(v0[0], v0[1]); w.y = cvt_pk_bf16(v0[2], v0[3]); w.z = cvt_pk_bf16(v1[0], v1[1]); w.w = cvt_pk_bf16(v1[2], v1[3]);
                    *(u32x4*)(rowp + bj * HALF) = w; }
        }
    }
};
struct EpiQKVQ {
    static constexpr bool PREF = true;
    bf16_t *Q, *Kb, *V; const float* rope; const float* sa; const float* sw;
    __device__ __forceinline__ const float* pref_ptr(const Unit& u, int wid, int lane) const {
        return wid < 4 ? sa + (size_t)u.r0 + wid * 64 + lane : sw + u.pn * BM + (wid - 4) * 64 + lane; }
    __device__ __forceinline__ void operator()(AccRefI acc, const Unit& u, int wr, int wc, int fr, int fq, const LAS float* scr) const {
        const int row0 = u.r0 + wr * 64 + fr, pn = u.pn;
        bf16_t* base; int ldc, colt;
        if (pn < 4) { base = Q; ldc = D; colt = pn * BM; } else if (pn == 4) { base = Kb; ldc = KVD; colt = 0; } else { base = V; ldc = KVD; colt = 0; }
        const bool rope_on = (pn < 5) && (u.pm < ML / BM);
        const float qs = (pn < 4) ? 0.125f * LOG2E : 1.0f;
        const int axis = wc & 1, col0 = colt + wc * 32 + 8 * fq;
        const LAS float* cp = scr + 256 + wc * 32 + 8 * fq;
        const f32x4 wv[2][2] = {{*(const LAS f32x4*)cp, *(const LAS f32x4*)(cp + 4)}, {*(const LAS f32x4*)(cp + HALF), *(const LAS f32x4*)(cp + HALF + 4)}};
#pragma unroll
        for (int ai = 0; ai < 2; ++ai) if (ai < u.nai) {
            f32x4 c4[4], s4[4];
#pragma unroll
            for (int m = 0; m < 4; ++m) { c4[m] = (f32x4){1.f, 1.f, 1.f, 1.f}; s4[m] = (f32x4){0.f, 0.f, 0.f, 0.f}; }
            if (rope_on) {
#pragma unroll
                for (int m = 0; m < 4; ++m) { const int row = row0 + ai * HALF + m * 16, t = row & (SEQ - 1), pos = axis ? (t & 63) : (t >> 6);
                    c4[m] = *(const f32x4*)(rope + pos * 16 + 4 * fq); s4[m] = *(const f32x4*)(rope + 2048 + pos * 16 + 4 * fq); }
            }
#pragma unroll
            for (int m = 0; m < 4; ++m) { const int row = row0 + ai * HALF + m * 16; bf16_t* rowp = base + (size_t)row * ldc + col0;
                const float sr = scr[ai * HALF + wr * 64 + m * 16 + fr] * qs;
                const f32x4 cc = c4[m] * sr, ss = s4[m] * sr;
#pragma unroll
                for (int bj = 0; bj < 2; ++bj) {
                    const i32x4 a0 = acc[ai][bj][m][0], a1 = acc[ai][bj][m][1];
                    const f32x4 v0 = (f32x4){(float)a0[0], (float)a0[1], (float)a0[2], (float)a0[3]} * wv[bj][0], v1 = (f32x4){(float)a1[0], (float)a1[1], (float)a1[2], (float)a1[3]} * wv[bj][1];
                    u32x4 w;
                    w.x = cvt_pk_bf16(v0[0] * cc[0] - v0[1] * ss[0], v0[1] * cc[0] + v0[0] * ss[0]);
                    w.y = cvt_pk_bf16(v0[2] * cc[1] - v0[3] * ss[1], v0[3] * cc[1] + v0[2] * ss[1]);
                    w.z = cvt_pk_bf16(v1[0] * cc[2] - v1[1] * ss[2], v1[1] * cc[2] + v1[0] * ss[2]);
                    w.w = cvt_pk_bf16(v1[2] * cc[3] - v1[3] * ss[3], v1[3] * cc[3] + v1[2] * ss[3]);
                    *(u32x4*)(rowp + bj * HALF) = w; }
            }
        }
    }
};
struct EpiQKV {
    static constexpr bool PREF = false;
    bf16_t *Q, *Kb, *V; const float* rope;
    __device__ __forceinline__ void operator()(AccRef acc, const Unit& u, int wr, int wc, int fr, int fq) const {
        const int row0 = u.r0 + wr * 64 + fr, pn = u.pn;
        bf16_t* base; int ldc, colt;
        if (pn < 4) { base = Q; ldc = D; colt = pn * BM; } else if (pn == 4) { base = Kb; ldc = KVD; colt = 0; } else { base = V; ldc = KVD; colt = 0; }
        const bool rope_on = (pn < 5) && (u.pm < ML / BM);
        const float qs = (pn < 4) ? 0.125f * LOG2E : 1.0f;
        const int axis = wc & 1, col0 = colt + wc * 32 + 8 * fq;
#pragma unroll
        for (int ai = 0; ai < 2; ++ai) if (ai < u.nai)
#pragma unroll
            for (int m = 0; m < 4; ++m) { const int row = row0 + ai * HALF + m * 16; bf16_t* rowp = base + (size_t)row * ldc + col0;
                f32x4 c4 = (f32x4){1.f, 1.f, 1.f, 1.f}, s4 = (f32x4){0.f, 0.f, 0.f, 0.f};
                if (rope_on) { const int t = row & (SEQ - 1), pos = axis ? (t & 63) : (t >> 6); c4 = *(const f32x4*)(rope + pos * 16 + 4 * fq); s4 = *(const f32x4*)(rope + 2048 + pos * 16 + 4 * fq); }
                c4 *= qs; s4 *= qs;
#pragma unroll
                for (int bj = 0; bj < 2; ++bj) { const f32x4 v0 = acc[ai][bj][m][0], v1 = acc[ai][bj][m][1];
                    u32x4 w;
                    w.x = cvt_pk_bf16(v0[0] * c4[0] - v0[1] * s4[0], v0[1] * c4[0] + v0[0] * s4[0]);
                    w.y = cvt_pk_bf16(v0[2] * c4[1] - v0[3] * s4[1], v0[3] * c4[1] + v0[2] * s4[1]);
                    w.z = cvt_pk_bf16(v1[0] * c4[2] - v1[1] * s4[2], v1[1] * c4[2] + v1[0] * s4[2]);
                    w.w = cvt_pk_bf16(v1[2] * c4[3] - v1[3] * s4[3], v1[3] * c4[3] + v1[2] * s4[3]);
                    *(u32x4*)(rowp + bj * HALF) = w; } }
    }
};
}

struct Params {
    const float *x, *c, *ctx, *c_ctx, *ada_w, *ada_b, *norm_g, *w_qkv, *w_o, *sink, *pool_w, *pool_b, *pool_scale, *ffn_gu, *ffn_dn, *router_w, *router_b, *moe_gu, *moe_dn;
    float* out; unsigned char* ws;
};

__device__ __forceinline__ int src_col(int n, int mode, int F) {
    if (mode == 1) { if (n >= 1280) return n; const int dn = n & 63, i = dn >> 1, s = dn & 1; return (n & ~63) + (i & 15) + 32 * (i >> 4) + 16 * s; }
    if (mode == 2) { const int pn = n >> 8, bj = (n >> 7) & 1, jj = n & 127; return bj * F + 128 * pn + jj; }
    return n;
}
__device__ __forceinline__ void transpose_item(const float* W, int Nsrc, int K, bf16_t* Bt, int item, int nblk, int mode, int F, int lane) {
    const int kb = item / nblk, nb = item % nblk, k0 = kb * 64, n = nb * 64 + lane;
    const float* src = W + (size_t)k0 * Nsrc + src_col(n, mode, F);
    float v[64];
#pragma unroll
    for (int i = 0; i < 64; ++i) v[i] = src[(size_t)i * Nsrc];
    bf16_t* dst = Bt + (size_t)n * K + k0;
#pragma unroll
    for (int j = 0; j < 8; ++j) { u32x4 w; w.x = cvt_pk_bf16(v[8 * j], v[8 * j + 1]); w.y = cvt_pk_bf16(v[8 * j + 2], v[8 * j + 3]); w.z = cvt_pk_bf16(v[8 * j + 4], v[8 * j + 5]); w.w = cvt_pk_bf16(v[8 * j + 6], v[8 * j + 7]);
        *(u32x4*)(dst + 8 * j) = w; }
}
__device__ __forceinline__ void colmax_item(const float* W, unsigned* colmax, int item, int lane, int kb_mid) {
    const int kb = (item >> 4) ? kb_mid : 0, nb = item & 15, n = nb * 64 + lane;
    const float* src = W + (size_t)(kb * 64) * D + n;
    float v[64]; float mx = 0.f;
#pragma unroll
    for (int i = 0; i < 64; ++i) v[i] = src[(size_t)i * D];
#pragma unroll
    for (int i = 0; i < 64; ++i) mx = fmaxf(mx, fabsf(v[i]));
    atomicMax(colmax + n, __float_as_uint(mx));
}
__device__ __forceinline__ void fp8_item(const float* W, int K, unsigned char* Bq, const unsigned* colmax, float* sdn, int item, int lane) {
    const int kb = item >> 4, nb = item & 15, n = nb * 64 + lane;
    const float* src = W + (size_t)(kb * 64) * D + n;
    float v[64];
#pragma unroll
    for (int i = 0; i < 64; ++i) v[i] = src[(size_t)i * D];
    const float cm = __uint_as_float(colmax[n]), sc = cm > 0.f ? 128.0f / cm : 0.f;
    if (kb == 0) sdn[n] = cm * (1.0f / 128.0f);
    unsigned char* dst = Bq + (size_t)n * K + kb * 64;
#pragma unroll
    for (int c = 0; c < 4; ++c) { u32x4 w4;
#pragma unroll
        for (int q = 0; q < 4; ++q) w4[q] = pk4_fp8(v[16 * c + 4 * q] * sc, v[16 * c + 4 * q + 1] * sc, v[16 * c + 4 * q + 2] * sc, v[16 * c + 4 * q + 3] * sc);
        *(u32x4*)(dst + 16 * c) = w4; }
}
__device__ __forceinline__ void quant_item(const float* W, int Nsrc, signed char* Bq, float* sw, int nb, int mode, int F, LAS float* pmax, int wave, int lane) {
    const int n = nb * 64 + lane;
    const float* src = W + (size_t)(wave * 128) * Nsrc + src_col(n, mode, F);
    float v[128]; float mx = 0.f;
#pragma unroll
    for (int i = 0; i < 128; ++i) v[i] = src[(size_t)i * Nsrc];
#pragma unroll
    for (int i = 0; i < 128; ++i) mx = fmaxf(mx, fabsf(v[i]));
    pmax[wave * 64 + lane] = mx;
    __syncthreads();
    float cm = pmax[lane];
#pragma unroll
    for (int w = 1; w < 8; ++w) cm = fmaxf(cm, pmax[w * 64 + lane]);
    const float inv = cm > 0.f ? 127.0f / cm : 0.f;
    if (wave == 0) sw[n] = cm * (1.0f / 127.0f);
    signed char* dst = Bq + (size_t)n * D + wave * 128;
#pragma unroll
    for (int c = 0; c < 8; ++c) { u32x4 w4;
#pragma unroll
        for (int q = 0; q < 4; ++q) { unsigned wd = 0u;
#pragma unroll
            for (int b = 0; b < 4; ++b) { const int qi = (int)__builtin_rintf(v[16 * c + 4 * q + b] * inv); wd |= ((unsigned)qi & 0xffu) << (8 * b); }
            w4[q] = wd; }
        *(u32x4*)(dst + 16 * c) = w4; }
}
__device__ __forceinline__ void prologue(const Params& p, LAS unsigned char* lds, int G, int wg, int tid) {
    const int lane = tid & 63, wave = __builtin_amdgcn_readfirstlane(tid >> 6);
    LAS float* scond = (LAS float*)lds;
    for (int i = tid; i < 5 * D; i += 512) { const int cnd = i >> 10, k = i & 1023; const float v = cnd < 4 ? p.c[cnd * D + k] : p.c_ctx[k]; scond[i] = v / (1.0f + __expf(-v)); }
    __syncthreads();
    const int gw = wg * 8 + wave, NGW = G * 8;
    if (wg == G - 1) {
        float* rope = (float*)(p.ws + WS_ROPE);
        for (int i = tid; i < 2048; i += 512) { const int pos = i >> 4, f = i & 15;
            const int fq4 = f & 3, fd = f >> 2;
            double inv = fq4 == 0 ? 1.0 : (fq4 == 1 ? 0.5623413251903491 : (fq4 == 2 ? 0.31622776601683794 : 0.1778279410038923));
            inv *= fd == 0 ? 1.0 : (fd == 1 ? 0.1 : (fd == 2 ? 0.01 : 0.001));
            const double ang = (double)pos * inv, kq = __builtin_rint(ang * 0.6366197723675814);
            double r = __builtin_fma(-kq, 1.5707963267948966, ang); r = __builtin_fma(-kq, 6.123233995736766e-17, r);
            const double r2 = r * r;
            const double sr = r * (1.0 + r2 * (-1.0 / 6 + r2 * (1.0 / 120 + r2 * (-1.0 / 5040 + r2 * (1.0 / 362880 + r2 * (-1.0 / 39916800 + r2 * (1.0 / 6227020800.0)))))));
            const double cr = 1.0 + r2 * (-0.5 + r2 * (1.0 / 24 + r2 * (-1.0 / 720 + r2 * (1.0 / 40320 + r2 * (-1.0 / 3628800 + r2 * (1.0 / 479001600 + r2 * (-1.0 / 87178291200.0)))))));
            const int qd = (int)kq & 3;
            const double cs = qd == 0 ? cr : (qd == 1 ? -sr : (qd == 2 ? -cr : sr)), sn = qd == 0 ? sr : (qd == 1 ? cr : (qd == 2 ? -sr : -cr));
            rope[i] = (float)cs; rope[2048 + i] = (float)sn; }
    }
    {
        float* modp = (float*)(p.ws + WS_MODP);
        for (int it = gw; it < KP * 4 * 24; it += NGW) {
            const int part = it / 96, rem = it % 96, l = rem / 24, cb = rem % 24, n = cb * 256 + 4 * lane, k0 = part * (D / KP);
            const float* w = p.ada_w + ((size_t)l * D + k0) * 6144 + n;
            f32x4 a0 = {0.f, 0.f, 0.f, 0.f}, a1 = a0, a2 = a0, a3 = a0, a4 = a0;
#pragma unroll 8
            for (int k = 0; k < D / KP; ++k) { const f32x4 wv = *(const f32x4*)(w + (size_t)k * 6144);
                a0 += wv * scond[0 * D + k0 + k]; a1 += wv * scond[1 * D + k0 + k]; a2 += wv * scond[2 * D + k0 + k]; a3 += wv * scond[3 * D + k0 + k]; a4 += wv * scond[4 * D + k0 + k]; }
            float* o = modp + ((size_t)(part * 4 + l) * 5) * 6144 + n;
            *(f32x4*)(o + 0 * 6144) = a0; *(f32x4*)(o + 1 * 6144) = a1; *(f32x4*)(o + 2 * 6144) = a2; *(f32x4*)(o + 3 * 6144) = a3; *(f32x4*)(o + 4 * 6144) = a4;
        }
    }
    {
        LAS float* pmax = (LAS float*)(lds + 32768);
        float* swb = (float*)(p.ws + WS_SW);
        unsigned* qctr = (unsigned*)(p.ws + WS_CTL) + CW_QITEM;
        LAS int* qit = (LAS int*)(lds + 32768 + 8192);
        int nxt_it = 0;
        if (tid == 0) nxt_it = (int)atomicAdd(qctr, 1u);
        int par = 0;
        for (;; par ^= 1) {
            if (tid == 0) *qit = nxt_it;
            __syncthreads();
            const int it = *qit;
            if (it >= 2 * 88 + 16 * 112 + 2 * 24) break;
            if (tid == 0) nxt_it = (int)atomicAdd(qctr, 1u);
            if (it >= 2 * 88 + 16 * 112) { const int r = it - (2 * 88 + 16 * 112), mi = r / 24, nb = r % 24;
                quant_item(p.w_qkv + (size_t)mi * D * NQKV, NQKV, (signed char*)(p.ws + WS_WQKV) + (size_t)mi * NQKV * D, swb + SWQ_OFF + mi * NQKV, nb, 1, 0, pmax + par * 512, wave, lane); continue; }
            if (it < 2 * 88) { const int mi = it / 88, nb = it % 88; quant_item(p.ffn_gu + (size_t)mi * D * 2 * DFF, 2 * DFF, (signed char*)(p.ws + WS_WFGU) + (size_t)mi * 2 * DFF * D, swb + mi * 2 * DFF, nb, 2, DFF, pmax + par * 512, wave, lane); }
            else { const int r = it - 2 * 88, mi = r / 112, nb = r % 112; quant_item(p.moe_gu + (size_t)mi * D * 2 * DFE, 2 * DFE, (signed char*)(p.ws + WS_WMGU) + (size_t)mi * 2 * DFE * D, swb + 2 * 2 * DFF + mi * 2 * DFE, nb, 2, DFE, pmax + par * 512, wave, lane); }
        }
    }
    constexpr int I1 = 2 * 256, I2 = I1 + 8 * 16, I3 = I2 + 2 * 32, I4 = I3 + 16 * 32;
    unsigned* colmax = (unsigned*)(p.ws + WS_CTL + CTL_COLMAX);
    for (int it = gw; it < I4; it += NGW) {
        if (it >= I3) { const int r = it - I3, mi = r / 32, li = r % 32; colmax_item(p.moe_dn + (size_t)mi * DFE * D, colmax + (2 + mi) * D, li, lane, DFE / 128); }
        else if (it >= I2) { const int r = it - I2, mi = r / 32, li = r % 32; colmax_item(p.ffn_dn + (size_t)mi * DFF * D, colmax + mi * D, li, lane, DFF / 128); }
        else if (it >= I1) { const int r = it - I1, mi = r / 16, li = r % 16; transpose_item(p.pool_w + (size_t)mi * 256 * 256, 256, 256, (bf16_t*)(p.ws + WS_WPOOL) + (size_t)mi * 256 * 256, li, 4, 0, 0, lane); }
        else { const int mi = it / 256, li = it % 256; transpose_item(p.w_o + (size_t)mi * D * D, D, D, (bf16_t*)(p.ws + WS_WO) + (size_t)mi * D * D, li, 16, 0, 0, lane); }
    }
}
__device__ __forceinline__ void prologue_down_quant(const Params& p, int G, int wg, int tid) {
    const int lane = tid & 63, wave = __builtin_amdgcn_readfirstlane(tid >> 6), gw = wg * 8 + wave, NGW = G * 8;
    const unsigned* colmax = (const unsigned*)(p.ws + WS_CTL + CTL_COLMAX);
    float* sdn = (float*)(p.ws + WS_SDN);
    constexpr int J0 = 2 * 704, J1 = J0 + 16 * 896;
    for (int it = gw; it < J1; it += NGW) {
        if (it >= J0) { const int r = it - J0, mi = r / 896, li = r % 896; fp8_item(p.moe_dn + (size_t)mi * DFE * D, DFE, (unsigned char*)(p.ws + WS_WMDN) + (size_t)mi * D * DFE, colmax + (2 + mi) * D, sdn + (2 + mi) * D, li, lane); }
        else { const int mi = it / 704, li = it % 704; fp8_item(p.ffn_dn + (size_t)mi * DFF * D, DFF, (unsigned char*)(p.ws + WS_WFDN) + (size_t)mi * D * DFF, colmax + mi * D, sdn + mi * D, li, lane); }
    }
}

template <bool PARTS>
__device__ __forceinline__ f32x4 mod_vec(const float* modp, const float* mod, const float* ada_b, int l, int cond, int chunk, int col) {
    if (!PARTS) return *(const f32x4*)(mod + ((size_t)l * 5 + cond) * 6144 + chunk * D + col);
    f32x4 s = *(const f32x4*)(ada_b + (size_t)l * 6144 + chunk * D + col);
#pragma unroll 2
    for (int pt = 0; pt < KP; ++pt) s += *(const f32x4*)(modp + ((size_t)(pt * 4 + l) * 5 + cond) * 6144 + chunk * D + col);
    return s;
}
template <bool ROUTER, bool MOE_IN, bool PARTS, bool Q8>
__device__ __forceinline__ void thin_phase(const Params& p, LAS unsigned char* lds, int G, int wg, int tid, int M, bool has_post, int lpost, int wpost, bool has_pre, int lpre, int wpre,
                                           bool xin32, bool xout32, bool write_x, const bf16_t* y, bf16_t* hout, int lrouter) {
    const int lane = tid & 63, wave = __builtin_amdgcn_readfirstlane(tid >> 6);
    const float* modp = (const float*)(p.ws + WS_MODP);
    const float* modf = (const float*)(p.ws + WS_MOD);
    if (PARTS) {
        float* mo = (float*)(p.ws + WS_MOD);
        for (int i = wg * 512 + tid; i < 4 * 5 * 6144 / 4; i += G * 512) { const int e = i * 4, l = e / (5 * 6144), r = e % (5 * 6144), cnd = r / 6144, n = r % 6144;
            *(f32x4*)(mo + e) = mod_vec<true>(modp, modf, p.ada_b, l, cnd, n >> 10, n & 1023); }
    }
    LAS float* rw = (LAS float*)lds;
    LAS unsigned* lcnt = (LAS unsigned*)(lds + 32768);
    if (ROUTER) {
        const float* rwg = p.router_w + (size_t)lrouter * D * NE;
        for (int i = tid; i < D * NE; i += 512) { const int k = i >> 3, e = i & 7; rw[e * D + k] = rwg[i]; }
        if (tid < 8) lcnt[tid] = 0u;
        __syncthreads();
    }
    const int RPW = (M + G - 1) / G, r0 = wg * RPW, r1 = (r0 + RPW < M) ? r0 + RPW : M;
    int cur_cond = -1;
    f32x4 pa[4], pb[4], pc[4];
    f32x4 xA[4], xB[4], xC[4]; u32x2 rA[4], rB[4], rC[4], yA[4], yB[4], yC[4], zA[4], zB[4], zC[4];
    bf16_t* const xbs = (bf16_t*)(p.ws + WS_XB); float gA1 = 0.f, gA2 = 0.f, gB1 = 0.f, gB2 = 0.f, gC1 = 0.f, gC2 = 0.f;
#define TH_SLOT(row_, sl_, inf_) do { if (MOE_IN) { sl_ = *(const i32x2*)(p.ws + WS_MOE + MO_SLOT + (size_t)(row_) * 8); inf_ = *(const i32x4*)(p.ws + WS_MOE + MO_INFO + (size_t)(row_) * 16); } } while (0)
#define TH_LOAD(row_, xv_, xr2_, ya_, yb_, g1_, g2_, sl_, inf_) do { \
        if (xin32) { const float* xr_ = (row_) < ML ? p.x + (size_t)(row_) * D : p.ctx + (size_t)((row_) - ML) * D; \
            _Pragma("unroll") for (int j = 0; j < 4; ++j) xv_[j] = *(const f32x4*)(xr_ + 4 * lane + 256 * j); } \
        else { const bf16_t* xr_ = xbs + (size_t)(row_) * D; \
            _Pragma("unroll") for (int j = 0; j < 4; ++j) xr2_[j] = *(const u32x2*)(xr_ + 4 * lane + 256 * j); } \
        if (has_post) { \
            if (MOE_IN) { \
                g1_ = __int_as_float(inf_.z); g2_ = __int_as_float(inf_.w); \
                const bf16_t* y1_ = y + (size_t)sl_.x * D; const bf16_t* y2_ = y + (size_t)sl_.y * D; \
                _Pragma("unroll") for (int j = 0; j < 4; ++j) { ya_[j] = *(const u32x2*)(y1_ + 4 * lane + 256 * j); yb_[j] = *(const u32x2*)(y2_ + 4 * lane + 256 * j); } \
            } else { \
                const bf16_t* yr_ = y + (size_t)(row_) * D; \
                _Pragma("unroll") for (int j = 0; j < 4; ++j) ya_[j] = *(const u32x2*)(yr_ + 4 * lane + 256 * j); \
            } } } while (0)
#define TH_PROC(row_, xv, xr2_, ya_, yb_, g1_, g2_) do { \
        const int row = (row_); \
        if (!xin32) { _Pragma("unroll") for (int j = 0; j < 4; ++j) xv[j] = (f32x4){bf_lo(xr2_[j].x), bf_hi(xr2_[j].x), bf_lo(xr2_[j].y), bf_hi(xr2_[j].y)}; } \
        const int cond = row < ML ? (row >> 13) : 4; \
        if (cond != cur_cond) { \
            cur_cond = cond; \
            _Pragma("unroll") for (int j = 0; j < 4; ++j) { const int col = 4 * lane + 256 * j; \
                if (has_post) { const f32x4 gt = mod_vec<PARTS>(modp, modf, p.ada_b, lpost, cond, wpost ? 5 : 2, col); const f32x4 gp = *(const f32x4*)(p.norm_g + ((size_t)lpost * 4 + (wpost ? 3 : 1)) * D + col); pa[j] = gt * gp; } \
                else pa[j] = (f32x4){0.f, 0.f, 0.f, 0.f}; \
                if (has_pre) { const f32x4 sh = mod_vec<PARTS>(modp, modf, p.ada_b, lpre, cond, wpre ? 3 : 0, col), sc = mod_vec<PARTS>(modp, modf, p.ada_b, lpre, cond, wpre ? 4 : 1, col); \
                    const f32x4 gp = *(const f32x4*)(p.norm_g + ((size_t)lpre * 4 + (wpre ? 2 : 0)) * D + col); pb[j] = gp * (sc + 1.0f); pc[j] = sh; } \
                else { pb[j] = (f32x4){0.f, 0.f, 0.f, 0.f}; pc[j] = pb[j]; } \
            } \
        } \
        if (has_post) { \
            f32x4 yv[4]; \
            if (MOE_IN) { \
                _Pragma("unroll") for (int j = 0; j < 4; ++j) { const u32x2 a = ya_[j], b = yb_[j]; \
                    yv[j] = (f32x4){g1_ * bf_lo(a.x) + g2_ * bf_lo(b.x), g1_ * bf_hi(a.x) + g2_ * bf_hi(b.x), g1_ * bf_lo(a.y) + g2_ * bf_lo(b.y), g1_ * bf_hi(a.y) + g2_ * bf_hi(b.y)}; } \
            } else { \
                _Pragma("unroll") for (int j = 0; j < 4; ++j) { const u32x2 a = ya_[j]; yv[j] = (f32x4){bf_lo(a.x), bf_hi(a.x), bf_lo(a.y), bf_hi(a.y)}; } \
            } \
            float ss = 0.f; \
            _Pragma("unroll") for (int j = 0; j < 4; ++j) ss += (yv[j].x * yv[j].x + yv[j].y * yv[j].y) + (yv[j].z * yv[j].z + yv[j].w * yv[j].w); \
            const float rstd = 1.0f / sqrtf(wave_sum(ss) * (1.0f / D) + NORM_EPS); \
            _Pragma("unroll") for (int j = 0; j < 4; ++j) xv[j] += pa[j] * (yv[j] * rstd); \
            if (write_x) { \
                if (xout32) { float* xw = p.out + (size_t)row * D; \
                    _Pragma("unroll") for (int j = 0; j < 4; ++j) *(f32x4*)(xw + 4 * lane + 256 * j) = xv[j]; } \
                else { bf16_t* xw = xbs + (size_t)row * D; \
                    _Pragma("unroll") for (int j = 0; j < 4; ++j) { u32x2 w; w.x = cvt_pk_bf16(xv[j].x, xv[j].y); w.y = cvt_pk_bf16(xv[j].z, xv[j].w); *(u32x2*)(xw + 4 * lane + 256 * j) = w; \
                        xv[j] = (f32x4){bf_lo(w.x), bf_hi(w.x), bf_lo(w.y), bf_hi(w.y)}; } }     \
            } \
        } \
        if (has_pre) { \
            float ss = 0.f; \
            _Pragma("unroll") for (int j = 0; j < 4; ++j) ss += (xv[j].x * xv[j].x + xv[j].y * xv[j].y) + (xv[j].z * xv[j].z + xv[j].w * xv[j].w); \
            const float rstd = 1.0f / sqrtf(wave_sum(ss) * (1.0f / D) + NORM_EPS); \
            f32x4 hv[4]; \
            bf16_t* hr = hout + (size_t)row * D; \
            _Pragma("unroll") for (int j = 0; j < 4; ++j) hv[j] = (xv[j] * rstd) * pb[j] + pc[j]; \
            if (Q8) {     \
                float am = 0.f; \
                _Pragma("unroll") for (int j = 0; j < 4; ++j) am = fmaxf(fmaxf(am, fmaxf(fabsf(hv[j].x), fabsf(hv[j].y))), fmaxf(fabsf(hv[j].z), fabsf(hv[j].w))); \
                _Pragma("unroll") for (int o_ = 1; o_ < 64; o_ <<= 1) am = fmaxf(am, __shfl_xor(am, o_)); \
                const float qi_ = am > 0.f ? 127.0f / am : 0.f; \
                signed char* hq_ = (signed char*)(p.ws + WS_HQ) + (size_t)row * D; \
                _Pragma("unroll") for (int j = 0; j < 4; ++j) { \
                    const unsigned wd_ = ((unsigned)(int)__builtin_rintf(hv[j].x * qi_) & 0xffu) | (((unsigned)(int)__builtin_rintf(hv[j].y * qi_) & 0xffu) << 8) | (((unsigned)(int)__builtin_rintf(hv[j].z * qi_) & 0xffu) << 16) | (((unsigned)(int)__builtin_rintf(hv[j].w * qi_) & 0xffu) << 24); \
                    *(unsigned*)(hq_ + 4 * lane + 256 * j) = wd_; } \
                if (lane == 0) ((float*)(p.ws + WS_SA))[row] = am * (1.0f / 127.0f); \
            } else { \
                _Pragma("unroll") for (int j = 0; j < 4; ++j) { u32x2 w; w.x = cvt_pk_bf16(hv[j].x, hv[j].y); w.y = cvt_pk_bf16(hv[j].z, hv[j].w); *(u32x2*)(hr + 4 * lane + 256 * j) = w; } \
            } \
            if (ROUTER) { \
                float lg[8]; \
                _Pragma("unroll") for (int e = 0; e < 8; ++e) { float s_ = 0.f; \
                    _Pragma("unroll") for (int j = 0; j < 4; ++j) { const f32x4 w = *(const LAS f32x4*)(rw + e * D + 4 * lane + 256 * j); s_ += (hv[j].x * w.x + hv[j].y * w.y) + (hv[j].z * w.z + hv[j].w * w.w); } \
                    lg[e] = wave_sum(s_) + p.router_b[lrouter * NE + e]; } \
                int e1 = 0; float v1 = lg[0]; \
                _Pragma("unroll") for (int e = 1; e < 8; ++e) if (lg[e] > v1) { v1 = lg[e]; e1 = e; } \
                int e2 = -1; float v2 = -3.0e38f; \
                _Pragma("unroll") for (int e = 0; e < 8; ++e) if (e != e1 && lg[e] > v2) { v2 = lg[e]; e2 = e; } \
                const float g1 = 1.0f / (1.0f + __expf(v2 - v1)), g2 = 1.0f - g1; \
                if (lane == 0) { \
                    const unsigned p1 = atomicAdd((unsigned*)(lcnt + e1), 1u), p2 = atomicAdd((unsigned*)(lcnt + e2), 1u); \
                    i32x4 inf; inf.x = e1 | (e2 << 8); inf.y = (int)(p1 | (p2 << 16)); inf.z = __float_as_int(g1); inf.w = __float_as_int(g2); \
                    *(i32x4*)(p.ws + WS_MOE + MO_INFO + (size_t)row * 16) = inf; \
                } \
            } \
        } } while (0)
    {
        int rcur = r0 + wave;
        i32x2 slA = {0, 0}, slB = {0, 0}, slC = {0, 0}; i32x4 infA = {0, 0, 0, 0}, infB = {0, 0, 0, 0}, infC = {0, 0, 0, 0};
        if (rcur < r1) {
            TH_SLOT(rcur, slA, infA);
            if (rcur + 8 < r1) TH_SLOT(rcur + 8, slB, infB);
            if (rcur + 16 < r1) TH_SLOT(rcur + 16, slC, infC);
            TH_LOAD(rcur, xA, rA, yA, zA, gA1, gA2, slA, infA);
            if (rcur + 8 < r1) TH_LOAD(rcur + 8, xB, rB, yB, zB, gB1, gB2, slB, infB);
            for (;;) {
                if (rcur + 16 < r1) TH_LOAD(rcur + 16, xC, rC, yC, zC, gC1, gC2, slC, infC);
                if (rcur + 24 < r1) TH_SLOT(rcur + 24, slA, infA);
                TH_PROC(rcur, xA, rA, yA, zA, gA1, gA2);
                rcur += 8; if (rcur >= r1) break;
                if (rcur + 16 < r1) TH_LOAD(rcur + 16, xA, rA, yA, zA, gA1, gA2, slA, infA);
                if (rcur + 24 < r1) TH_SLOT(rcur + 24, slB, infB);
                TH_PROC(rcur, xB, rB, yB, zB, gB1, gB2);
                rcur += 8; if (rcur >= r1) break;
                if (rcur + 16 < r1) TH_LOAD(rcur + 16, xB, rB, yB, zB, gB1, gB2, slB, infB);
                if (rcur + 24 < r1) TH_SLOT(rcur + 24, slC, infC);
                TH_PROC(rcur, xC, rC, yC, zC, gC1, gC2);
                rcur += 8; if (rcur >= r1) break;
            }
        }
    }
#undef TH_LOAD
#undef TH_SLOT
#undef TH_PROC
    if (ROUTER) {
        __syncthreads();
        if (tid < 8) ((int*)(p.ws + WS_MOE + MO_WGCNT))[wg * 8 + tid] = (int)lcnt[tid];
    }
}

__device__ __forceinline__ void route_phase(const Params& p, LAS unsigned char* lds, int G, int wg, int tid, int M) {
    LAS int* cnt = (LAS int*)lds;
    LAS int* tab = (LAS int*)(lds + 32768);
    const int* wgcnt = (const int*)(p.ws + WS_MOE + MO_WGCNT);
    for (int i = tid; i < G * 8; i += 512) cnt[i] = wgcnt[i];
    __syncthreads();
    if (tid < 8) { int tot = 0, pre = 0; for (int w = 0; w < G; ++w) { const int c = cnt[w * 8 + tid]; if (w < wg) pre += c; tot += c; } tab[tid] = pre; tab[8 + tid] = tot; }
    __syncthreads();
    if (tid == 0) { int ts = 0; for (int e = 0; e < 8; ++e) { tab[16 + e] = ts; ts += (tab[8 + e] + 255) >> 8; } tab[24] = ts; }
    __syncthreads();
    int* rowidx = (int*)(p.ws + WS_MOE + MO_ROWIDX);
    const int RPW = (M + G - 1) / G, r0 = wg * RPW, r1 = (r0 + RPW < M) ? r0 + RPW : M;
    for (int row = r0 + tid; row < r1; row += 512) {
        const i32x4 inf = *(const i32x4*)(p.ws + WS_MOE + MO_INFO + (size_t)row * 16);
        const int e1 = inf.x & 255, e2 = (inf.x >> 8) & 255, p1 = inf.y & 0xffff, p2 = (inf.y >> 16) & 0xffff;
        const int s1 = tab[16 + e1] * 256 + tab[e1] + p1, s2 = tab[16 + e2] * 256 + tab[e2] + p2;
        rowidx[s1] = row; rowidx[s2] = row;
        { const float sc = ((const float*)(p.ws + WS_SA))[row]; float* sas = (float*)(p.ws + WS_SAS); sas[s1] = sc; sas[s2] = sc; }
        i32x2 sl; sl.x = s1; sl.y = s2; *(i32x2*)(p.ws + WS_MOE + MO_SLOT + (size_t)row * 8) = sl;
    }
    if (wg < 8) { const int e = wg, s0 = tab[16 + e] * 256 + tab[8 + e], s1 = tab[17 + e] * 256; for (int s = s0 + tid; s < s1; s += 512) { rowidx[s] = 0; ((float*)(p.ws + WS_SAS))[s] = 0.f; } }
    if (wg == 0 && tid < 32) ((int*)(p.ws + WS_MOE + MO_TAB))[tid] = (tid < 25) ? tab[tid] : 0;
    __syncthreads();
}

__device__ __forceinline__ void pooldiff_phase(const bf16_t* h, bf16_t* d, int G, int wg, int tid, int M) {
    const int chunk = tid & 127, seg = tid >> 7, hw = 1 << (chunk >> 5);
    const int RPW = (M + G - 1) / G, r0 = wg * RPW, r1 = (r0 + RPW < M) ? r0 + RPW : M;
    const int nseg = (r1 - r0 + 3) >> 2, ra = r0 + seg * nseg, rb = (ra + nseg < r1) ? ra + nseg : r1;
    const bf16_t* hc = h + chunk * 8; bf16_t* dc = d + chunk * 8;
    float S[8] = {0.f, 0.f, 0.f, 0.f, 0.f, 0.f, 0.f, 0.f};
    bool fresh = true;
#define PD_ACC(sgn_, v_) do { S[0] += sgn_ bf_lo(v_.x); S[1] += sgn_ bf_hi(v_.x); S[2] += sgn_ bf_lo(v_.y); S[3] += sgn_ bf_hi(v_.y); S[4] += sgn_ bf_lo(v_.z); S[5] += sgn_ bf_hi(v_.z); S[6] += sgn_ bf_lo(v_.w); S[7] += sgn_ bf_hi(v_.w); } while (0)
#pragma unroll 2
    for (int row = ra; row < rb; ++row) {
        int base, t, T;
        if (row < ML) { base = row & ~(SEQ - 1); t = row & (SEQ - 1); T = SEQ; } else { base = ML + ((row - ML) & ~(CTXL - 1)); t = (row - ML) & (CTXL - 1); T = CTXL; }
        const int lo = (t - hw) > 0 ? (t - hw) : 0, hi = (t + hw) < T ? (t + hw) : T;
        if (fresh || t == 0) {
            fresh = false;
#pragma unroll
            for (int i = 0; i < 8; ++i) S[i] = 0.f;
            for (int j = lo; j < hi; ++j) { const u32x4 v = *(const u32x4*)(hc + (size_t)(base + j) * D); PD_ACC(+, v); }
        } else {
            if (t + hw - 1 < T) { const u32x4 v = *(const u32x4*)(hc + (size_t)(base + t + hw - 1) * D); PD_ACC(+, v); }
            if (t - hw - 1 >= 0) { const u32x4 v = *(const u32x4*)(hc + (size_t)(base + t - hw - 1) * D); PD_ACC(-, v); }
        }
        const float inv = 1.0f / (float)(hi - lo);
        const u32x4 cv = *(const u32x4*)(hc + (size_t)row * D);
        u32x4 o;
        o.x = cvt_pk_bf16(S[0] * inv - bf_lo(cv.x), S[1] * inv - bf_hi(cv.x)); o.y = cvt_pk_bf16(S[2] * inv - bf_lo(cv.y), S[3] * inv - bf_hi(cv.y));
        o.z = cvt_pk_bf16(S[4] * inv - bf_lo(cv.z), S[5] * inv - bf_hi(cv.z)); o.w = cvt_pk_bf16(S[6] * inv - bf_lo(cv.w), S[7] * inv - bf_hi(cv.w));
        *(u32x4*)(dc + (size_t)row * D) = o;
    }
#undef PD_ACC
}

constexpr int AT_TILE = 8192, AT_KOFF = 0, AT_VOFF = 3 * AT_TILE;
constexpr float ATT_THR = 8.0f;
typedef short s16x4 __attribute__((ext_vector_type(4)));
__device__ __forceinline__ float vmax3(float a, float b, float c) { float r; asm("v_max3_f32 %0, %1, %2, %3" : "=v"(r) : "v"(a), "v"(b), "v"(c)); return r; }
__device__ __forceinline__ float xhalf_max(float v) { const u32x2 r = __builtin_amdgcn_permlane32_swap(__float_as_uint(v), __float_as_uint(v), false, false); return vmax3(__uint_as_float(r.x), __uint_as_float(r.y), __uint_as_float(r.y)); }
__device__ __forceinline__ s16x4 lds_tr16(const LAS unsigned char* p) { return __builtin_amdgcn_ds_read_tr16_b64_v4i16((LAS s16x4*)p); }
__device__ __forceinline__ void attn_phase(LAS unsigned char* lds, const bf16_t* Q, const bf16_t* Kg, const bf16_t* Vg, bf16_t* O, const float* sink, int n_units, int G, int wg, int tid) {
    const int wid = __builtin_amdgcn_readfirstlane(tid >> 6), lane = tid & 63, c = lane & 31, hh = lane >> 5;
    const int g = wid >> 1, qhalf = wid & 1;
    const int srow = wid * 8 + (lane >> 3), spos = lane & 7;
    const int skoff = srow * KVD + ((spos ^ ((srow >> 1) & 7)) * 8), svoff = srow * KVD + ((spos ^ (((srow >> 1) & 1) << 2)) * 8);
    const int ksw = (c >> 1) & 7;
    const int trq = (lane & 15) >> 2, trp = lane & 3, trblk = (lane >> 4) & 1;
    const int vtr_off = (4 * hh + trq) * 128 + (((2 * trblk + (trp >> 1)) ^ ((trq >> 1) << 2)) * 16) + 8 * (trp & 1);
    for (int unit = wg; unit < n_units; unit += G) {
        int qrow0, crow0, dlo, nband, hk;
        if (unit < 1024) { const int b = unit >> 8, rem = unit & 255, n = rem >> 2; hk = rem & 3; qrow0 = b * SEQ + n * 128; crow0 = ML + b * CTXL; dlo = (n > 0) ? -1 : 0; const int dhi = (n < 63) ? 1 : 0; nband = 2 * (dhi - dlo + 1); }
        else { const int cu = unit - 1024, b = cu >> 3, rem = cu & 7, n = rem >> 2; hk = rem & 3; crow0 = ML + b * CTXL; qrow0 = crow0 + n * 128; dlo = 0; nband = 0; }
        const int NT = nband + 4, head = hk * 4 + g;
        bf16x8 qf[2][4];
#pragma unroll
        for (int qb = 0; qb < 2; ++qb)
#pragma unroll
            for (int ks = 0; ks < 4; ++ks) qf[qb][ks] = *(const bf16x8*)(Q + (size_t)(qrow0 + qhalf * 64 + qb * 32 + c) * D + head * 64 + ks * 16 + hh * 8);
        const float m0 = sink[head] * LOG2E;
        float mrun0 = m0, mrun1 = m0, lrun0 = (hh == 0) ? 1.0f : 0.0f, lrun1 = lrun0;
        f32x16 o00, o01, o10, o11;
#pragma unroll
        for (int r = 0; r < 16; ++r) { o00[r] = 0.f; o01[r] = 0.f; o10[r] = 0.f; o11[r] = 0.f; }
#define AT_KROW(t_) (((t_) < nband) ? (qrow0 + (dlo + ((t_) >> 1)) * 128 + ((t_) & 1) * 64) : (crow0 + ((t_) - nband) * 64))
#define AT_STAGE(t_) do { const int _kr = AT_KROW(t_); const int _b = (t_) % 3; \
        __builtin_amdgcn_global_load_lds((const unsigned*)(Kg + (size_t)_kr * KVD + hk * 64 + skoff), (LAS unsigned*)(lds + AT_KOFF + _b * AT_TILE + wid * 1024), 16, 0, 0); \
        __builtin_amdgcn_global_load_lds((const unsigned*)(Vg + (size_t)_kr * KVD + hk * 64 + svoff), (LAS unsigned*)(lds + AT_VOFF + _b * AT_TILE + wid * 1024), 16, 0, 0); } while (0)
        AT_STAGE(0); AT_STAGE(1);
        asm volatile("" : "+v"(qf[0][0]), "+v"(qf[0][1]), "+v"(qf[0][2]), "+v"(qf[0][3]), "+v"(qf[1][0]), "+v"(qf[1][1]), "+v"(qf[1][2]), "+v"(qf[1][3]));
        asm volatile("s_waitcnt vmcnt(2)" ::: "memory");
        __builtin_amdgcn_s_barrier();
        for (int t = 0; t < NT; ++t) {
            int kp0 = 0; bool masked = false, skip = false;
            if (t < nband) { const int dl = dlo + (t >> 1), th = t & 1; kp0 = dl * 128 + th * 64; masked = (dl != 0); skip = (dl == -1 && th == 0 && qhalf == 1) || (dl == 1 && th == 1 && qhalf == 0); }
            if (t + 2 < NT) AT_STAGE(t + 2);
            const LAS unsigned char* kbuf = lds + AT_KOFF + (t % 3) * AT_TILE; const LAS unsigned char* vbuf = lds + AT_VOFF + (t % 3) * AT_TILE;
            if (!skip) {
                f32x16 s00, s01, s10, s11;
#pragma unroll
                for (int r = 0; r < 16; ++r) { s00[r] = -mrun0; s10[r] = -mrun0; s01[r] = -mrun1; s11[r] = -mrun1; }
#pragma unroll
                for (int ks = 0; ks < 4; ++ks) {
                    const bf16x8 kf0 = *(const LAS bf16x8*)(kbuf + c * 128 + (((2 * ks + hh) ^ ksw) * 16));
                    const bf16x8 kf1 = *(const LAS bf16x8*)(kbuf + (32 + c) * 128 + (((2 * ks + hh) ^ ksw) * 16));
                    s00 = __builtin_amdgcn_mfma_f32_32x32x16_bf16(kf0, qf[0][ks], s00, 0, 0, 0); s01 = __builtin_amdgcn_mfma_f32_32x32x16_bf16(kf0, qf[1][ks], s01, 0, 0, 0);
                    s10 = __builtin_amdgcn_mfma_f32_32x32x16_bf16(kf1, qf[0][ks], s10, 0, 0, 0); s11 = __builtin_amdgcn_mfma_f32_32x32x16_bf16(kf1, qf[1][ks], s11, 0, 0, 0);
                }
                if (masked) {
                    int bs = kp0 + 4 * hh - (qhalf * 64 + c) + 128;
                    asm volatile("; band mask" : "+v"(bs));
#pragma unroll
                    for (int r = 0; r < 16; ++r) { const int kr = (r & 3) + 8 * (r >> 2);
                        if ((unsigned)(bs + kr) > 256u) s00[r] = -1e30f;
                        if ((unsigned)(bs + kr - 32) > 256u) s01[r] = -1e30f;
                        if ((unsigned)(bs + kr + 32) > 256u) s10[r] = -1e30f;
                        if ((unsigned)(bs + kr) > 256u) s11[r] = -1e30f; }
                    asm volatile("" : "+v"(s00), "+v"(s01), "+v"(s10), "+v"(s11));
                }
                float mx0 = s00[0], mx1 = s01[0];
#pragma unroll
                for (int r = 0; r < 16; ++r) { mx0 = vmax3(mx0, s00[r], s10[r]); mx1 = vmax3(mx1, s01[r], s11[r]); }
                mx0 = xhalf_max(mx0); mx1 = xhalf_max(mx1);
                if (__builtin_amdgcn_ballot_w64(vmax3(mx0, mx1, mx1) > ATT_THR) != 0ull) {
                    float d0 = fmaxf(mx0, 0.f), d1 = fmaxf(mx1, 0.f);
                    asm volatile("; rescale" : "+v"(d0), "+v"(d1));
                    const float al0 = fast_exp2(-d0), al1 = fast_exp2(-d1);
                    mrun0 += d0; mrun1 += d1; lrun0 *= al0; lrun1 *= al1;
#pragma unroll
                    for (int r = 0; r < 16; ++r) { s00[r] -= d0; s10[r] -= d0; s01[r] -= d1; s11[r] -= d1; o00[r] *= al0; o10[r] *= al0; o01[r] *= al1; o11[r] *= al1; }
                    asm volatile("" : "+v"(s00), "+v"(s01), "+v"(s10), "+v"(s11));
                }
                float rs0 = 0.f, rs1 = 0.f;
#pragma unroll
                for (int r = 0; r < 16; ++r) { s00[r] = fast_exp2(s00[r]); s10[r] = fast_exp2(s10[r]); s01[r] = fast_exp2(s01[r]); s11[r] = fast_exp2(s11[r]);
                    rs0 += s00[r] + s10[r]; rs1 += s01[r] + s11[r]; }
                lrun0 += rs0; lrun1 += rs1;
                bf16x8 pf[2][2][2];
#pragma unroll
                for (int s2 = 0; s2 < 2; ++s2) {
                    u32x4 w;
                    w.x = cvt_pk_bf16(s00[8 * s2 + 0], s00[8 * s2 + 1]); w.y = cvt_pk_bf16(s00[8 * s2 + 2], s00[8 * s2 + 3]); w.z = cvt_pk_bf16(s00[8 * s2 + 4], s00[8 * s2 + 5]); w.w = cvt_pk_bf16(s00[8 * s2 + 6], s00[8 * s2 + 7]);
                    pf[0][0][s2] = __builtin_bit_cast(bf16x8, w);
                    w.x = cvt_pk_bf16(s01[8 * s2 + 0], s01[8 * s2 + 1]); w.y = cvt_pk_bf16(s01[8 * s2 + 2], s01[8 * s2 + 3]); w.z = cvt_pk_bf16(s01[8 * s2 + 4], s01[8 * s2 + 5]); w.w = cvt_pk_bf16(s01[8 * s2 + 6], s01[8 * s2 + 7]);
                    pf[0][1][s2] = __builtin_bit_cast(bf16x8, w);
                    w.x = cvt_pk_bf16(s10[8 * s2 + 0], s10[8 * s2 + 1]); w.y = cvt_pk_bf16(s10[8 * s2 + 2], s10[8 * s2 + 3]); w.z = cvt_pk_bf16(s10[8 * s2 + 4], s10[8 * s2 + 5]); w.w = cvt_pk_bf16(s10[8 * s2 + 6], s10[8 * s2 + 7]);
                    pf[1][0][s2] = __builtin_bit_cast(bf16x8, w);
                    w.x = cvt_pk_bf16(s11[8 * s2 + 0], s11[8 * s2 + 1]); w.y = cvt_pk_bf16(s11[8 * s2 + 2], s11[8 * s2 + 3]); w.z = cvt_pk_bf16(s11[8 * s2 + 4], s11[8 * s2 + 5]); w.w = cvt_pk_bf16(s11[8 * s2 + 6], s11[8 * s2 + 7]);
                    pf[1][1][s2] = __builtin_bit_cast(bf16x8, w);
                }
#pragma unroll
                for (int kb = 0; kb < 2; ++kb)
#pragma unroll
                    for (int s2 = 0; s2 < 2; ++s2) {
                        const int vo = vtr_off + (32 * kb + 16 * s2) * 128;
                        const s16x4 a0 = lds_tr16(vbuf + vo), a1 = lds_tr16(vbuf + vo + 8 * 128), b0 = lds_tr16(vbuf + (vo ^ 64)), b1 = lds_tr16(vbuf + (vo ^ 64) + 8 * 128);
                        const bf16x8 vf0 = __builtin_shufflevector(a0, a1, 0, 1, 2, 3, 4, 5, 6, 7), vf1 = __builtin_shufflevector(b0, b1, 0, 1, 2, 3, 4, 5, 6, 7);
                        o00 = __builtin_amdgcn_mfma_f32_32x32x16_bf16(vf0, pf[kb][0][s2], o00, 0, 0, 0); o01 = __builtin_amdgcn_mfma_f32_32x32x16_bf16(vf0, pf[kb][1][s2], o01, 0, 0, 0);
                        o10 = __builtin_amdgcn_mfma_f32_32x32x16_bf16(vf1, pf[kb][0][s2], o10, 0, 0, 0); o11 = __builtin_amdgcn_mfma_f32_32x32x16_bf16(vf1, pf[kb][1][s2], o11, 0, 0, 0);
                    }
            }
            if (t + 2 < NT) asm volatile("s_waitcnt vmcnt(2)" ::: "memory"); else asm volatile("s_waitcnt vmcnt(0)" ::: "memory");
            __builtin_amdgcn_s_barrier();
        }
#undef AT_STAGE
#undef AT_KROW
        const float l0 = lrun0 + __shfl_xor(lrun0, 32), l1 = lrun1 + __shfl_xor(lrun1, 32);
        const float i0 = 1.0f / l0, i1 = 1.0f / l1;
        bf16_t* orow0 = O + (size_t)(qrow0 + qhalf * 64 + c) * D + head * 64 + 4 * hh;
        bf16_t* orow1 = orow0 + (size_t)32 * D;
#pragma unroll
        for (int gq = 0; gq < 4; ++gq) {
            u32x2 w;
            w.x = cvt_pk_bf16(o00[4 * gq] * i0, o00[4 * gq + 1] * i0); w.y = cvt_pk_bf16(o00[4 * gq + 2] * i0, o00[4 * gq + 3] * i0); *(u32x2*)(orow0 + 8 * gq) = w;
            w.x = cvt_pk_bf16(o10[4 * gq] * i0, o10[4 * gq + 1] * i0); w.y = cvt_pk_bf16(o10[4 * gq + 2] * i0, o10[4 * gq + 3] * i0); *(u32x2*)(orow0 + 32 + 8 * gq) = w;
            w.x = cvt_pk_bf16(o01[4 * gq] * i1, o01[4 * gq + 1] * i1); w.y = cvt_pk_bf16(o01[4 * gq + 2] * i1, o01[4 * gq + 3] * i1); *(u32x2*)(orow1 + 8 * gq) = w;
            w.x = cvt_pk_bf16(o11[4 * gq] * i1, o11[4 * gq + 1] * i1); w.y = cvt_pk_bf16(o11[4 * gq + 2] * i1, o11[4 * gq + 3] * i1); *(u32x2*)(orow1 + 32 + 8 * gq) = w;
        }
    }
}

__device__ __forceinline__ int opaque_i(int v) { asm volatile("" : "+v"(v)); return v; }
__device__ __forceinline__ int opaque_s(int v) { asm volatile("" : "+s"(v)); return v; }
#if defined(__HIP_DEVICE_COMPILE__)
typedef const __attribute__((address_space(4))) Params* KargPtr;
#define TID() (wave_s * 64 + (int)__builtin_amdgcn_mbcnt_hi(~0u, __builtin_amdgcn_mbcnt_lo(~0u, (unsigned)opaque_i(0))))
#define LOADP() KargPtr kp_ = (KargPtr)__builtin_amdgcn_kernarg_segment_ptr(); asm volatile("" : "+s"(kp_)); const Params p = *kp_; unsigned char* const ws = p.ws; (void)ws
#define B_H   ((bf16_t*)(ws + WS_H))
#define B_Q   ((bf16_t*)(ws + WS_Q))
#define B_K   ((bf16_t*)(ws + WS_K))
#define B_V   ((bf16_t*)(ws + WS_V))
#define B_Y   ((bf16_t*)(ws + WS_Y))
#define B_ACT ((bf16_t*)(ws + WS_ACT))
#define B_XC  ((float*)(ws + WS_XC))
#define GRID_BAR() do { LOADP(); XcdBarrier b_; b_.bar = (unsigned*)(ws + WS_CTL) + CW_BAR; b_.x = xb_xcc_id(); b_.st = (volatile LAS unsigned*)(lds + LDSCTL_OFF); xcd_barrier(b_); } while (0)
template <int LP> __device__ __forceinline__ void layer_pair(LAS unsigned char* lds, const int G, const int wg, const int wave_s) {
    constexpr int lp = LP;
        const int LA = 2 * lp, LB = 2 * lp + 1;
        const int Mrows = (lp == 0) ? MT : ML;
        { LOADP(); pg8::Gemm g{opaque_s(D / 2), opaque_s(D / 2), opaque_s(D / 2)}; pg8::DenseOrder S; S.init(MT / 256, NQKV / 256, G, wg, ws + WS_HQ, ws + WS_WQKV + (size_t)lp * NQKV * D, D / 2, D / 2, 0);
          pg8::EpiQKVQ E{B_Q, B_K, B_V, (const float*)(ws + WS_ROPE), (const float*)(ws + WS_SA), (const float*)(ws + WS_SW) + SWQ_OFF + lp * NQKV};
          pg8::gemm_phase<pg8::EpiQKVQ, pg8::DenseOrder, false, 1>(lds, g, S, E, TID()); }
        GRID_BAR();
        { LOADP(); attn_phase(lds, B_Q, B_K, B_V, B_H, p.sink + lp * 16, (lp == 0) ? 1024 + 32 : 1024, G, wg, TID()); }
        GRID_BAR();
        { LOADP(); pg8::Gemm g{opaque_s(D), opaque_s(D), opaque_s(D)}; pg8::DenseOrder S; S.init(Mrows / 256, D / 256, G, wg, B_H, (const bf16_t*)(ws + WS_WO) + (size_t)lp * D * D, D, D, 0);
          pg8::EpiPlain E{B_Y, D};
          pg8::gemm_phase<pg8::EpiPlain, pg8::DenseOrder, false>(lds, g, S, E, TID()); }
        GRID_BAR();
        { LOADP(); thin_phase<false, false, false, true>(p, lds, G, wg, TID(), Mrows, true, LA, 0, true, LA, 1, lp == 0, false, true, B_Y, B_H, 0); }
        GRID_BAR();
        { LOADP(); pg8::Gemm g{opaque_s(D / 2), opaque_s(D / 2), opaque_s(D / 2)}; pg8::DenseOrder S; S.init(Mrows / 256, 2 * DFF / 256, G, wg, ws + WS_HQ, ws + WS_WFGU + (size_t)lp * 2 * DFF * D, D / 2, D / 2, 0);
          pg8::EpiSwigluQ E{(unsigned char*)(ws + WS_ACT), DFF, (const float*)(ws + WS_SA), (const float*)(ws + WS_SW) + lp * 2 * DFF, 0};
          pg8::gemm_phase<pg8::EpiSwigluQ, pg8::DenseOrder, false, 1>(lds, g, S, E, TID()); }
        GRID_BAR();
        { LOADP(); pg8::Gemm g{opaque_s(DFF / 2), opaque_s(DFF / 2), opaque_s(DFF / 2)}; pg8::DenseOrder S; S.init(Mrows / 256, D / 256, G, wg, ws + WS_ACT, ws + WS_WFDN + (size_t)lp * D * DFF, DFF / 2, DFF / 2, 0);
          pg8::EpiPlainS E{B_Y, D, (const float*)(ws + WS_SDN) + lp * D, 0};
          pg8::gemm_phase<pg8::EpiPlainS, pg8::DenseOrder, false, 2>(lds, g, S, E, TID()); }
        GRID_BAR();
        { LOADP(); thin_phase<false, false, false, false>(p, lds, G, wg, TID(), Mrows, true, LA, 1, true, LB, 0, false, false, true, B_Y, B_H, 0); }
        GRID_BAR();
        { LOADP(); pooldiff_phase(B_H, B_Q, G, wg, TID(), Mrows); }
        GRID_BAR();
        { LOADP(); pg8::Gemm g{opaque_s(D), opaque_s(256), opaque_s(256)}; pg8::DenseOrder S; S.init(Mrows / 256, 4, G, wg, B_Q, (const bf16_t*)(ws + WS_WPOOL) + (size_t)lp * 4 * 256 * 256, D, 256, 512);
          pg8::EpiPool E{B_Y, p.pool_b + lp * D, p.pool_scale + lp * D};
          pg8::gemm_phase<pg8::EpiPool, pg8::DenseOrder, false>(lds, g, S, E, TID()); }
        GRID_BAR();
        { LOADP(); thin_phase<true, false, false, true>(p, lds, G, wg, TID(), Mrows, true, LB, 0, true, LB, 1, false, false, true, B_Y, B_H, lp); }
        GRID_BAR();
        { LOADP(); route_phase(p, lds, G, wg, TID(), Mrows); }
        GRID_BAR();
        { LOADP();
          const int* tab = (const int*)(ws + WS_MOE + MO_TAB);
          pg8::MoeOrder S; S.nM = tab[24]; S.G = G; S.c = wg; S.rowidx = (const int*)(ws + WS_MOE + MO_ROWIDX);
          S.t1 = tab[17]; S.t2 = tab[18]; S.t3 = tab[19]; S.t4 = tab[20]; S.t5 = tab[21]; S.t6 = tab[22]; S.t7 = tab[23];
          S.nN = 2 * DFE / 256; S.nwg = S.nM * S.nN; S.A = (const char*)(ws + WS_HQ); S.B = (const char*)(ws + WS_WMGU + (size_t)lp * NE * 2 * DFE * D); S.tstepA = 256u * D; S.tstepB = 256u * D;
          S.estride = 2u * DFE * D; S.gather = 1;
          pg8::Gemm g{opaque_s(D / 2), opaque_s(D / 2), opaque_s(D / 2)}; pg8::EpiSwigluQ E{(unsigned char*)(ws + WS_ACT), DFE, (const float*)(ws + WS_SAS), (const float*)(ws + WS_SW) + 2 * 2 * DFF + lp * NE * 2 * DFE, 2 * DFE};
          pg8::gemm_phase<pg8::EpiSwigluQ, pg8::MoeOrder, true, 1>(lds, g, S, E, TID()); }
        GRID_BAR();
        { LOADP();
          const int* tab = (const int*)(ws + WS_MOE + MO_TAB);
          pg8::MoeOrder S; S.nM = tab[24]; S.G = G; S.c = wg; S.rowidx = (const int*)(ws + WS_MOE + MO_ROWIDX);
          S.t1 = tab[17]; S.t2 = tab[18]; S.t3 = tab[19]; S.t4 = tab[20]; S.t5 = tab[21]; S.t6 = tab[22]; S.t7 = tab[23];
          S.nN = D / 256; S.nwg = S.nM * S.nN; S.A = (const char*)(ws + WS_ACT); S.B = (const char*)(ws + WS_WMDN + (size_t)lp * NE * D * DFE); S.tstepA = 256u * DFE; S.tstepB = 256u * DFE;
          S.estride = (unsigned)D * DFE; S.gather = 0;
          pg8::Gemm g{opaque_s(DFE / 2), opaque_s(DFE / 2), opaque_s(DFE / 2)}; pg8::EpiPlainS E{B_Y, D, (const float*)(ws + WS_SDN) + (2 + lp * NE) * D, D};
          pg8::gemm_phase<pg8::EpiPlainS, pg8::MoeOrder, false, 2>(lds, g, S, E, TID()); }
        GRID_BAR();
        { LOADP(); thin_phase<false, true, false, true>(p, lds, G, wg, TID(), Mrows, true, LB, 1, lp == 0, LB + 1, 0, false, lp == 1, true, B_Y, B_H, 0); }
        if (lp == 0) GRID_BAR();
    }
#endif
__global__ void __launch_bounds__(512, 2) fwd_kernel(Params p_arg) {
#if defined(__HIP_DEVICE_COMPILE__)
    extern __shared__ __attribute__((aligned(16))) unsigned char lds_raw[];
    LAS unsigned char* lds = (LAS unsigned char*)lds_raw;
    const int G = gridDim.x, wg = blockIdx.x;
    asm volatile("s_setreg_imm32_b32 hwreg(HW_REG_MODE, 23, 1), 1");
    const int wave_s = __builtin_amdgcn_readfirstlane((int)threadIdx.x >> 6);
    { const int tid = TID();
      for (int u = tid; u < (LDS_BYTES - LDSCTL_OFF) / 4; u += 512) ((LAS unsigned*)(lds + LDSCTL_OFF))[u] = 0u; }
    __syncthreads();
    { LOADP(); (void)xcd_barrier_post((unsigned*)(ws + WS_CTL) + CW_BAR, (volatile LAS unsigned*)(lds + LDSCTL_OFF)); }

    { LOADP(); prologue(p, lds, G, wg, TID()); }
    GRID_BAR();
    { LOADP(); thin_phase<false, false, true, true>(p, lds, G, wg, TID(), MT, false, 0, 0, true, 0, 0, true, false, false, nullptr, B_H, 0); }
    { LOADP(); prologue_down_quant(p, G, wg, TID()); }
    GRID_BAR();

    layer_pair<0>(lds, G, wg, wave_s);
    layer_pair<1>(lds, G, wg, wave_s);
#endif
}

extern "C" void kernel_launch(void* const* d_in, const int* in_sizes, int n_in, void* d_out, int out_size, void* d_ws, size_t ws_size, hipStream_t stream) {
    static int grid = 0;
    if (grid == 0) {
        if (n_in != 19 || out_size != ML * D || ws_size < WS_END) { fprintf(stderr, "kernel_launch: unexpected problem (n_in %d, out %d, ws %zu < %zu)\n", n_in, out_size, ws_size, (size_t)WS_END); grid = -1; return; }
        int dev = 0, cus = 0, per_cu = 0;
        if (hipGetDevice(&dev) != hipSuccess || hipDeviceGetAttribute(&cus, hipDeviceAttributeMultiprocessorCount, dev) != hipSuccess) { grid = -1; return; }
        if (hipFuncSetAttribute((const void*)fwd_kernel, hipFuncAttributeMaxDynamicSharedMemorySize, LDS_BYTES) != hipSuccess) { fprintf(stderr, "kernel_launch: hipFuncSetAttribute failed\n"); grid = -1; return; }
        if (hipOccupancyMaxActiveBlocksPerMultiprocessor(&per_cu, (const void*)fwd_kernel, 512, LDS_BYTES) != hipSuccess || per_cu < 1) fprintf(stderr, "kernel_launch: occupancy query reports %d\n", per_cu);
        (void)hipGetLastError();
        grid = cus;
        if (grid > 1024) grid = 1024;
    }
    if (grid < 0) return;
    (void)in_sizes;
    (void)hipMemsetAsync((char*)d_ws + WS_CTL, 0, CTL_ZERO_BYTES, stream);
    Params p{};
    p.x = (const float*)d_in[0]; p.c = (const float*)d_in[1]; p.ctx = (const float*)d_in[2]; p.c_ctx = (const float*)d_in[3]; p.ada_w = (const float*)d_in[4]; p.ada_b = (const float*)d_in[5];
    p.norm_g = (const float*)d_in[6]; p.w_qkv = (const float*)d_in[7]; p.w_o = (const float*)d_in[8]; p.sink = (const float*)d_in[9]; p.pool_w = (const float*)d_in[10]; p.pool_b = (const float*)d_in[11];
    p.pool_scale = (const float*)d_in[12]; p.ffn_gu = (const float*)d_in[13]; p.ffn_dn = (const float*)d_in[14]; p.router_w = (const float*)d_in[15]; p.router_b = (const float*)d_in[16];
    p.moe_gu = (const float*)d_in[17]; p.moe_dn = (const float*)d_in[18];
    p.out = (float*)d_out; p.ws = (unsigned char*)d_ws;
    hipLaunchKernelGGL(fwd_kernel, dim3(grid), dim3(512), LDS_BYTES, stream, p);
}
```

```cpp
#include <hip/hip_runtime.h>
#include <cstdio>

#define GAS __attribute__((address_space(1)))
#define LAS __attribute__((address_space(3)))
typedef unsigned short bf16_t;
typedef short bf16x8 __attribute__((ext_vector_type(8)));
typedef float f32x4 __attribute__((ext_vector_type(4)));
typedef float f32x16 __attribute__((ext_vector_type(16)));
typedef unsigned u32x4 __attribute__((ext_vector_type(4)));
typedef unsigned u32x2 __attribute__((ext_vector_type(2)));
typedef int i32x4 __attribute__((ext_vector_type(4)));
typedef int i32x2 __attribute__((ext_vector_type(2)));
typedef int i32x8 __attribute__((ext_vector_type(8)));
template <bool I8> struct AccSel { typedef f32x4 T; };
template <> struct AccSel<true> { typedef i32x4 T; };

constexpr int D = 1024, NBATCH = 4, SEQ = 8192, CTXL = 256;
constexpr int ML = NBATCH * SEQ;
constexpr int MC = NBATCH * CTXL;
constexpr int MT = ML + MC;
constexpr int NQKV = 1536, KVD = 256;
constexpr int DFF = 2816, NE = 8, DFE = 3584;
constexpr int SLOTS = 69632;
constexpr int SWQ_OFF = 2 * 2 * 2816 + 16 * 2 * 3584;
constexpr int KP = 8;
constexpr float LOG2E = 1.4426950408889634f;
constexpr float NORM_EPS = 1e-6f;

constexpr size_t MiB = 1u << 20;
constexpr size_t WS_CTL = 0, CTL_ZERO_BYTES = 1 * MiB;
constexpr size_t WS_MODP = 1 * MiB;
constexpr size_t WS_ROPE = 5 * MiB;
constexpr size_t WS_MOD = 5 * MiB + 65536;
constexpr size_t WS_MOE = 6 * MiB;
constexpr size_t WS_XC = 8 * MiB;
constexpr size_t WS_WQKV = 12 * MiB;
constexpr size_t WS_WO = 18 * MiB;
constexpr size_t WS_WPOOL = 22 * MiB;
constexpr size_t WS_WFGU = 23 * MiB;
constexpr size_t WS_WFDN = 45 * MiB;
constexpr size_t WS_WMGU = 56 * MiB;
constexpr size_t WS_WMDN = 280 * MiB;
constexpr size_t WS_H = 392 * MiB;
constexpr size_t WS_Q = 458 * MiB;
constexpr size_t WS_K = 524 * MiB;
constexpr size_t WS_V = 541 * MiB;
constexpr size_t WS_Y = 558 * MiB;
constexpr size_t WS_ACT = 694 * MiB;
constexpr size_t WS_SA = 1170 * MiB;
constexpr size_t WS_SAS = 1170 * MiB + 512 * 1024;
constexpr size_t WS_SDN = 1170 * MiB + 800 * 1024;
constexpr size_t CTL_COLMAX = 128 * 1024;
constexpr size_t WS_XB = 1204 * MiB;
constexpr size_t WS_HQ = 1171 * MiB;
constexpr size_t WS_SW = 7 * MiB + 512 * 1024;
constexpr size_t WS_END = 1270 * MiB;
constexpr size_t MO_INFO = 0;
constexpr size_t MO_SLOT = 640 * 1024;
constexpr size_t MO_ROWIDX = 1024 * 1024;
constexpr size_t MO_WGCNT = 1024 * 1024 + 320 * 1024;
constexpr size_t MO_TAB = 1024 * 1024 + 384 * 1024;
constexpr int CW_BAR = 4096;
constexpr int CW_QITEM = 16384;

constexpr int RING_BYTES = 131072;
constexpr int LDSCTL_OFF = RING_BYTES;
constexpr int EPI_SCR_OFF = LDSCTL_OFF + 256;
constexpr int IDX_SCR_OFF = EPI_SCR_OFF + 4096;
constexpr int LDS_BYTES = 147456;

__device__ __forceinline__ unsigned cvt_pk_bf16(float lo, float hi) { unsigned r; asm("v_cvt_pk_bf16_f32 %0, %1, %2" : "=v"(r) : "v"(lo), "v"(hi)); return r; }
__device__ __forceinline__ float bf_lo(unsigned w) { return __uint_as_float(w << 16); }
__device__ __forceinline__ float bf_hi(unsigned w) { return __uint_as_float(w & 0xffff0000u); }
template <int CTRL> __device__ __forceinline__ float dpp_f(float v) { return __int_as_float(__builtin_amdgcn_update_dpp(0, __float_as_int(v), CTRL, 0xf, 0xf, true)); }
__device__ __forceinline__ float wave_sum(float v) {
    v += dpp_f<0x121>(v); v += dpp_f<0x122>(v); v += dpp_f<0x124>(v); v += dpp_f<0x128>(v);
    { const u32x2 r = __builtin_amdgcn_permlane16_swap(__float_as_uint(v), __float_as_uint(v), false, false); v = __uint_as_float(r.x) + __uint_as_float(r.y); }
    { const u32x2 r = __builtin_amdgcn_permlane32_swap(__float_as_uint(v), __float_as_uint(v), false, false); v = __uint_as_float(r.x) + __uint_as_float(r.y); }
    return v;
}
__device__ __forceinline__ float wave_max(float v) {
    v = fmaxf(v, dpp_f<0x121>(v)); v = fmaxf(v, dpp_f<0x122>(v)); v = fmaxf(v, dpp_f<0x124>(v)); v = fmaxf(v, dpp_f<0x128>(v));
    { const u32x2 r = __builtin_amdgcn_permlane16_swap(__float_as_uint(v), __float_as_uint(v), false, false); v = fmaxf(__uint_as_float(r.x), __uint_as_float(r.y)); }
    { const u32x2 r = __builtin_amdgcn_permlane32_swap(__float_as_uint(v), __float_as_uint(v), false, false); v = fmaxf(__uint_as_float(r.x), __uint_as_float(r.y)); }
    return v;
}
__device__ __forceinline__ float fast_exp2(float x) { return __builtin_amdgcn_exp2f(x); }
__device__ __forceinline__ float fast_rcp(float x) { return __builtin_amdgcn_rcpf(x); }
__device__ __forceinline__ float clamp448(float x) { return __builtin_amdgcn_fmed3f(x, -448.0f, 448.0f); }
__device__ __forceinline__ unsigned pk4_fp8(float a, float b, float c, float d) {
    unsigned w = 0u; w = (unsigned)__builtin_amdgcn_cvt_pk_fp8_f32(clamp448(a), clamp448(b), (int)w, false); w = (unsigned)__builtin_amdgcn_cvt_pk_fp8_f32(clamp448(c), clamp448(d), (int)w, true); return w; }

__device__ __forceinline__ unsigned pk4_fp8_sat(float a, float b, float c, float d) {
    unsigned w = 0u; w = (unsigned)__builtin_amdgcn_cvt_pk_fp8_f32(a, b, (int)w, false); w = (unsigned)__builtin_amdgcn_cvt_pk_fp8_f32(c, d, (int)w, true); return w; }
#define XB_TMO      128
#define XB_XCNT(j)  (256  + 64 * (j))
#define XB_XSUB(j)  (1280 + 64 * (j))
#define XB_XGEN(j)  (2304 + 64 * (j))
#define XB_FLAG     3328
#define XCD_BAR_WORDS 3456
#define XB_SPIN_CAP (1u << 18)
__device__ __forceinline__ unsigned xb_ld(unsigned* p)              { return __hip_atomic_load(p, __ATOMIC_RELAXED, __HIP_MEMORY_SCOPE_AGENT); }
__device__ __forceinline__ unsigned xb_add(unsigned* p, unsigned v) { return __hip_atomic_fetch_add(p, v, __ATOMIC_RELAXED, __HIP_MEMORY_SCOPE_AGENT); }
__device__ __forceinline__ unsigned xb_xcc_id() { return (unsigned)__builtin_amdgcn_s_getreg((3 << 11) | 20) & 0xFu; }
#define XB_SPIN(cond, bar) do { unsigned _sp = 0; while (cond) { __builtin_amdgcn_s_sleep(1); \
    if ((++_sp & 255u) == 0u) { if (xb_ld(&(bar)[XB_TMO])) break; if (_sp > XB_SPIN_CAP) { atomicAdd(&(bar)[XB_TMO], 1u); break; } } } } while (0)
struct XcdBarrier { unsigned* bar; unsigned x; volatile LAS unsigned* st; };
__device__ __forceinline__ XcdBarrier xcd_barrier_post(unsigned* bar, volatile LAS unsigned* st) {
    XcdBarrier b; b.bar = bar; b.x = xb_xcc_id(); b.st = st;
    if (threadIdx.x == 0) (void)xb_add(&bar[XB_XCNT(b.x)], 1u);
    return b;
}
__device__ __forceinline__ void xcd_barrier_complete(unsigned* bar, unsigned x, unsigned& nloc, unsigned& mask) {
    const unsigned G = gridDim.x * gridDim.y * gridDim.z;
    unsigned sum, msk, mine, sp = 0u;
    for (;;) {
        sum = 0u; msk = 0u; mine = 0u;
#pragma unroll
        for (unsigned j = 0; j < 16; ++j) { const unsigned c = xb_ld(&bar[XB_XCNT(j)]); sum += c; msk |= (c > 0u) ? (1u << j) : 0u; mine = (j == x) ? c : mine; }
        if (sum == G) break;
        __builtin_amdgcn_s_sleep(1);
        if ((++sp & 255u) == 0u) { if (xb_ld(&bar[XB_TMO])) break; if (sp > XB_SPIN_CAP) { atomicAdd(&bar[XB_TMO], 1u); break; } }
    }
    nloc = mine > 0u ? mine : 1u; mask = msk;
}
__device__ __forceinline__ u32x4 xb_ld4(const unsigned* p) { u32x4 v; asm volatile("global_load_dwordx4 %0, %1, off sc1\n\ts_waitcnt vmcnt(0)" : "=v"(v) : "v"(p) : "memory"); return v; }
__device__ __forceinline__ void xcd_barrier(const XcdBarrier& b) {
    asm volatile("s_waitcnt vmcnt(0)" ::: "memory");
    __syncthreads();
    if (threadIdx.x == 0) {
        unsigned* bar = b.bar;
        __builtin_amdgcn_s_waitcnt(0);
        unsigned nloc = b.st[0], mask = b.st[1];
        if (nloc == 0u) { xcd_barrier_complete(bar, b.x, nloc, mask); b.st[0] = nloc; b.st[1] = mask; }
        const unsigned old = xb_add(&bar[XB_XSUB(b.x)], 1u);
        const unsigned gen = old / nloc, tgt = gen + 1u;
        if (old + 1u == tgt * nloc) {
            __builtin_amdgcn_fence(__ATOMIC_RELEASE, "agent");
            asm volatile("s_waitcnt vmcnt(0)" ::: "memory");
            __hip_atomic_store(&bar[XB_FLAG + b.x], tgt, __ATOMIC_RELAXED, __HIP_MEMORY_SCOPE_AGENT);
        }
        unsigned sp = 0u;
        for (;;) {
            unsigned late = 0u;
#pragma unroll
            for (unsigned q = 0; q < 4; ++q) { const u32x4 v = xb_ld4(&bar[XB_FLAG + 4 * q]);
#pragma unroll
                for (unsigned j = 0; j < 4; ++j) late |= ((int)(v[j] - tgt) < 0) ? (1u << (4 * q + j)) : 0u; }
            if ((late & mask) == 0u) break;
            __builtin_amdgcn_s_sleep(1);
            if ((++sp & 255u) == 0u) { if (xb_ld(&bar[XB_TMO])) break; if (sp > XB_SPIN_CAP) { atomicAdd(&bar[XB_TMO], 1u); break; } }
        }
        __builtin_amdgcn_fence(__ATOMIC_ACQUIRE, "agent");
        asm volatile("s_waitcnt vmcnt(0)" ::: "memory");
    }
    __syncthreads();
}

namespace pg8 {
constexpr int BM = 256, BK = 64, HALF = 128, HTB = HALF * BK * 2, STAGE_BYTES = 8 * HTB, NXCD = 8, WGM = 8;
__device__ __forceinline__ int lds_byte(int r, int c) { const int st = (r >> 4) * 2 + (c >> 5), rr = r & 15, cc = c & 31, ob = rr * 64 + cc * 2; return st * 1024 + (ob ^ (((ob >> 9) & 1) << 5)); }
__device__ __forceinline__ void stage_rc(int b, int& R, int& C) { const int st = b / 1024, sb = b % 1024, swz = sb ^ (((sb >> 9) & 1) << 5); R = (st >> 1) * 16 + swz / 64; C = (st & 1) * 32 + (swz % 64) / 2; }
__device__ __forceinline__ int perm32(int rho) { const int n = rho >> 4, i = rho & 15; return 8 * (i >> 2) + 4 * n + (i & 3); }

struct Unit { int pm, pn, e, r0, nai; const char* a; const char* b; };
__device__ __forceinline__ f32x4 mma16(bf16x8 a, bf16x8 b, f32x4 c) { return __builtin_amdgcn_mfma_f32_16x16x32_bf16(a, b, c, 0, 0, 0); }
struct Frag16 { bf16x8 k[2]; };
struct Frag32 { i32x8 v; };
template <int MODE> struct FragSel { typedef Frag16 T; };
template <> struct FragSel<2> { typedef Frag32 T; };
__device__ __forceinline__ void load_frag(Frag16& f, const LAS unsigned char* p) { f.k[0] = *(const LAS bf16x8*)p; f.k[1] = *(const LAS bf16x8*)(p + 1024); }
__device__ __forceinline__ void load_frag(Frag32& f, const LAS unsigned char* p) { const i32x4 lo = *(const LAS i32x4*)p, hi = *(const LAS i32x4*)(p + 1024); f.v = __builtin_shufflevector(lo, hi, 0, 1, 2, 3, 4, 5, 6, 7); }
__device__ __forceinline__ f32x4 mma_frag(const Frag32& a, const Frag32& b, f32x4 c) {
    asm("v_mfma_f32_16x16x128_f8f6f4 %0, %1, %2, %0" : "+v"(c) : "v"(a.v), "v"(b.v));
    return c; }
__device__ __forceinline__ i32x4 mma16(bf16x8 a, bf16x8 b, i32x4 c) { return __builtin_amdgcn_mfma_i32_16x16x64_i8(__builtin_bit_cast(i32x4, a), __builtin_bit_cast(i32x4, b), c, 0, 0, 0); }
__device__ __forceinline__ f32x4 mma_frag_z(const Frag32& a, const Frag32& b, f32x4) {
    f32x4 c;
    asm("v_mfma_f32_16x16x128_f8f6f4 %0, %1, %2, 0" : "=&v"(c) : "v"(a.v), "v"(b.v));
    return c; }
__device__ __forceinline__ f32x4 mma_frag_z(const Frag16& a, const Frag16& b, f32x4) { const f32x4 c = mma16(a.k[0], b.k[0], (f32x4){0.f, 0.f, 0.f, 0.f}); return mma16(a.k[1], b.k[1], c); }
__device__ __forceinline__ i32x4 mma_frag_z(const Frag16& a, const Frag16& b, i32x4) { i32x4 c; asm("v_mfma_i32_16x16x64_i8 %0, %1, %2, 0" : "=&v"(c) : "v"(a.k[0]), "v"(b.k[0])); return mma16(a.k[1], b.k[1], c); }
__device__ __forceinline__ f32x4 mma_frag(const Frag16& a, const Frag16& b, f32x4 c) { c = mma16(a.k[0], b.k[0], c); return mma16(a.k[1], b.k[1], c); }
__device__ __forceinline__ i32x4 mma_frag(const Frag16& a, const Frag16& b, i32x4 c) { c = mma16(a.k[0], b.k[0], c); return mma16(a.k[1], b.k[1], c); }
struct Gemm { int lda, ldb, K; };

template <class Epi, class Sched, bool GATHER, int MODE = 0>
__device__ __forceinline__ void gemm_phase(LAS unsigned char* lds, const Gemm g, const Sched& S, const Epi& E, int tid) {
    const int wid = __builtin_amdgcn_readfirstlane(tid >> 6), lane = tid & 63, wr = wid >> 2, wc = wid & 3, fr = lane & 15, fq = lane >> 4;
    const int K = g.K, nt = K / BK;
    LAS unsigned char* const lds_ctl = lds;
    int R0, C0; stage_rc(tid * 16, R0, C0);
    const int Rb0 = (R0 & ~31) + perm32(R0 & 31);
    const unsigned voffA = (unsigned)(R0 * g.lda + C0) * 2u, voffB = (unsigned)(Rb0 * g.ldb + C0) * 2u;
    const unsigned dA64 = (unsigned)(64 * g.lda) * 2u, dB64 = (unsigned)(64 * g.ldb) * 2u;
    const size_t kstep = (size_t)(BK * 2);
    const size_t hstepA = (size_t)HALF * g.lda * 2, hstepB = (size_t)HALF * g.ldb * 2;
    const unsigned ldsw = (unsigned)wid * 1024u;
    const int aoff = lds_byte(wr * 64 + fr, fq * 8), boff = lds_byte(wc * 32 + fr, fq * 8);
    unsigned vo[4];
#define PG8_SA(b, h) (((b) * 2 + (h)) * HTB)
#define PG8_SB(b, h) ((4 + (b) * 2 + (h)) * HTB)
    const __amdgpu_buffer_rsrc_t rsA = __builtin_amdgcn_make_buffer_rsrc((void*)S.A, 0, -1, 0x00020000), rsB = __builtin_amdgcn_make_buffer_rsrc((void*)S.B, 0, -1, 0x00020000);
#define PG8_STAGE2(bufoff, rs_, base_, gbase, v0_, v1_, d1_) do { const unsigned so_ = (unsigned)((const char*)(gbase) - (const char*)(base_)); \
        __builtin_amdgcn_raw_ptr_buffer_load_lds(rs_, (LAS void*)(lds + (bufoff) + ldsw), 16, (int)(v0_), (int)so_, 0, 0); \
        __builtin_amdgcn_raw_ptr_buffer_load_lds(rs_, (LAS void*)(lds + (bufoff) + ldsw + 8192), 16, (int)(v1_), (int)(so_ + (unsigned)(d1_)), 0, 0); } while (0)
#define PG8_STAGE(bufoff, gbase, voff) PG8_STAGE2(bufoff, rsB, S.B, gbase, voffB, voffB, dB64)
#define PG8_STGA(bufoff, ptr, h, nx) do { if constexpr (GATHER) { PG8_STAGE2(bufoff, rsA, S.A, ptr, vo[2 * (h)], vo[2 * (h) + 1], 0u); } \
        else { PG8_STAGE2(bufoff, rsA, S.A, (ptr) + (h) * hstepA, voffA, voffA, dA64); } } while (0)
#define PG8_LDA(dst, b, h) do { _Pragma("unroll") for (int m = 0; m < 4; ++m) load_frag(dst[m], lds + PG8_SA(b, h) + aoff + m * 2048); } while (0)
#define PG8_LDB(dst, b, h) do { _Pragma("unroll") for (int n = 0; n < 2; ++n) load_frag(dst[n], lds + PG8_SB(b, h) + boff + n * 2048); } while (0)
#define PG8_MMA(ai, bj, At, Bt) do { __builtin_amdgcn_s_setprio(1); _Pragma("unroll") for (int m = 0; m < 4; ++m) _Pragma("unroll") for (int n = 0; n < 2; ++n) \
        acc[ai][bj][m][n] = mma_frag(Bt[n], At[m], acc[ai][bj][m][n]); __builtin_amdgcn_s_setprio(0); } while (0)
#define PG8_MMAZ(ai, bj, At, Bt) do { __builtin_amdgcn_s_setprio(1); _Pragma("unroll") for (int m = 0; m < 4; ++m) _Pragma("unroll") for (int n = 0; n < 2; ++n) \
        acc[ai][bj][m][n] = mma_frag_z(Bt[n], At[m], acc[ai][bj][m][n]); __builtin_amdgcn_s_setprio(0); } while (0)
#define PG8_WAIT_V(n) asm volatile("s_waitcnt vmcnt(" #n ")" ::: "memory")
#define PG8_WAIT_L(n) asm volatile("s_waitcnt lgkmcnt(" #n ")" ::: "memory")
#define PG8_BAR __builtin_amdgcn_s_barrier()
#define PG8_SCHED __builtin_amdgcn_sched_barrier(0)
    Unit cur, nxt; int ui = 0;
    if (!S.next(0, cur)) return;
#define PG8_PREF(u_, ui_) do { if constexpr (Epi::PREF) { const float* _pp = E.pref_ptr(u_, wid, lane); \
        if (_pp) __builtin_amdgcn_global_load_lds((const unsigned*)_pp, (LAS unsigned*)(lds_ctl + EPI_SCR_OFF + ((ui_) & 1) * 2048 + wid * 256), 4, 0, 0); } } while (0)
    PG8_PREF(cur, 0);
    if constexpr (GATHER) {
#pragma unroll
        for (int h = 0; h < 2; ++h) { vo[2 * h] = ((unsigned)S.row(cur, h * HALF + R0) * (unsigned)g.lda + (unsigned)C0) * 2u; vo[2 * h + 1] = ((unsigned)S.row(cur, h * HALF + R0 + 64) * (unsigned)g.lda + (unsigned)C0) * 2u; }
    }
    typedef typename AccSel<MODE == 1>::T AccT;
    AccT acc[2][2][4][2];
#define PG8_ZERO() do { if constexpr (false) { _Pragma("unroll") for (int a = 0; a < 2; ++a) _Pragma("unroll") for (int b = 0; b < 2; ++b) _Pragma("unroll") for (int m = 0; m < 4; ++m) _Pragma("unroll") for (int n = 0; n < 2; ++n) acc[a][b][m][n] = (AccT){0, 0, 0, 0}; } } while (0)
    PG8_ZERO();
    typedef typename FragSel<MODE>::T FragT;
    FragT At[4], B0[2], B1[2];
    const char* cA = cur.a; const char* cB = cur.b;
    PG8_STAGE(PG8_SB(0, 0), cB, voffB); PG8_STAGE(PG8_SB(0, 1), cB + hstepB, voffB); PG8_STGA(PG8_SA(0, 0), cA, 0, false); PG8_STGA(PG8_SA(0, 1), cA, 1, false);
    if (wr == 1) PG8_BAR;
    PG8_WAIT_V(2); PG8_BAR;
    PG8_STAGE(PG8_SB(1, 0), cB + kstep, voffB); PG8_STGA(PG8_SA(1, 0), cA + kstep, 0, false); PG8_STAGE(PG8_SB(1, 1), cB + hstepB + kstep, voffB);
    PG8_WAIT_V(6); PG8_BAR;
    for (;;) {
        const bool has_next = S.next(ui + 1, nxt);
        if constexpr (GATHER) {
            if (has_next) { if (wid < 4) __builtin_amdgcn_global_load_lds((const unsigned*)S.row_ptr(nxt, wid * 64 + lane), (LAS unsigned*)(lds_ctl + IDX_SCR_OFF + ((ui + 1) & 1) * 1024 + wid * 256), 4, 0, 0); }
        }
        const char* nA = has_next ? nxt.a : cA; const char* nB = has_next ? nxt.b : cB;
        for (int t = 0; t < nt; t += 2) {
            const bool last = (t == nt - 2);
            const char* a1 = cA + (size_t)(t + 1) * kstep;
            const char* a2 = last ? nA : cA + (size_t)(t + 2) * kstep; const char* b2 = last ? nB : cB + (size_t)(t + 2) * kstep;
            const char* a3 = a2 + kstep; const char* b3 = b2 + kstep;
            PG8_LDB(B0, 0, 0); PG8_LDB(B1, 0, 1); PG8_SCHED; PG8_LDA(At, 0, 0); PG8_STGA(PG8_SA(1, 1), a1, 1, false);
            if constexpr (GATHER) { if (last && has_next) {
                const LAS unsigned* it_ = (const LAS unsigned*)(lds_ctl + IDX_SCR_OFF + ((ui + 1) & 1) * 1024);
#pragma unroll
                for (int h = 0; h < 2; ++h) { vo[2 * h] = (it_[h * HALF + R0] * (unsigned)g.lda + (unsigned)C0) * 2u; vo[2 * h + 1] = (it_[h * HALF + R0 + 64] * (unsigned)g.lda + (unsigned)C0) * 2u; } } }
            PG8_WAIT_V(8); PG8_WAIT_L(0); PG8_BAR; if (t == 0) { PG8_MMAZ(0, 0, At, B0); PG8_MMAZ(0, 1, At, B1); } else { PG8_MMA(0, 0, At, B0); PG8_MMA(0, 1, At, B1); } PG8_BAR; PG8_SCHED;
            PG8_LDA(At, 0, 1); PG8_STAGE(PG8_SB(0, 0), b2, voffB); PG8_STAGE(PG8_SB(0, 1), b2 + hstepB, voffB); PG8_STGA(PG8_SA(0, 0), a2, 0, last);
            PG8_WAIT_V(8); PG8_WAIT_L(0); PG8_BAR; if (GATHER || cur.nai == 2) { if (t == 0) { PG8_MMAZ(1, 0, At, B0); PG8_MMAZ(1, 1, At, B1); } else { PG8_MMA(1, 0, At, B0); PG8_MMA(1, 1, At, B1); } } PG8_BAR; PG8_SCHED;
            PG8_LDB(B0, 1, 0); PG8_LDB(B1, 1, 1); PG8_SCHED; PG8_LDA(At, 1, 0); PG8_STGA(PG8_SA(0, 1), a2, 1, last);
            PG8_WAIT_V(8); PG8_WAIT_L(0); PG8_BAR; PG8_MMA(0, 0, At, B0); PG8_MMA(0, 1, At, B1); PG8_BAR; PG8_SCHED;
            PG8_LDA(At, 1, 1); PG8_STAGE(PG8_SB(1, 0), b3, voffB); PG8_STAGE(PG8_SB(1, 1), b3 + hstepB, voffB); PG8_STGA(PG8_SA(1, 0), a3, 0, last);
            PG8_WAIT_V(8); PG8_WAIT_L(0); PG8_BAR; if (GATHER || cur.nai == 2) { PG8_MMA(1, 0, At, B0); PG8_MMA(1, 1, At, B1); } PG8_BAR; PG8_SCHED;
        }
        if (wr == 0) PG8_BAR;
        if constexpr (MODE == 2) asm volatile("s_nop 15\n\ts_nop 7" ::: "memory");
        if constexpr (Epi::PREF) E(acc, cur, wr, wc, fr, fq, (const LAS float*)(lds_ctl + EPI_SCR_OFF + (ui & 1) * 2048));
        else E(acc, cur, wr, wc, fr, fq);
        if (!has_next) break;
        PG8_ZERO();
        cur = nxt; cA = nA; cB = nB; ++ui;
        PG8_PREF(cur, ui);
        if (wr == 1) PG8_BAR;
    }
    PG8_WAIT_V(0);
    PG8_BAR;
#undef PG8_PREF
#undef PG8_SA
#undef PG8_SB
#undef PG8_STAGE
#undef PG8_STAGE2
#undef PG8_STGA
#undef PG8_LDA
#undef PG8_LDB
#undef PG8_MMA
#undef PG8_MMAZ
#undef PG8_ZERO
#undef PG8_WAIT_V
#undef PG8_WAIT_L
#undef PG8_BAR
#undef PG8_SCHED
}

struct DenseOrder {
    int nM, nN, nwg, G, c; const char* A; const char* B; unsigned tstepA, tstepB, acolstep;
    __device__ __forceinline__ void init(int nM_, int nN_, int G_, int c_, const void* A_, const void* B_, int lda, int ldb, size_t acolstep_) {
        nM = nM_; nN = nN_; nwg = nM * nN; G = G_; c = c_; A = (const char*)A_; B = (const char*)B_; tstepA = (unsigned)(BM * lda * 2); tstepB = (unsigned)(BM * ldb * 2); acolstep = (unsigned)acolstep_; }
    __device__ __forceinline__ bool next(int i, Unit& u) const {
        const int nfull = (nwg / G) * G, R = nwg - nfull; const bool hs = R > 0 && 2 * R <= G;
        const long L = (long)i * G + c; if (L >= (hs ? nfull + 2 * R : nwg)) return false;
        int wgid = (int)L, sub = 0; u.nai = 2;
        if (hs && wgid >= nfull) { const int j = wgid - nfull; wgid = nfull + (j >> 1); sub = j & 1; u.nai = 1; }
        { const int q = nwg / NXCD, r = nwg % NXCD, xcd = wgid % NXCD, off = wgid / NXCD; wgid = (xcd < r ? xcd * (q + 1) : r * (q + 1) + (xcd - r) * q) + off; }
        const int nig = WGM * nN, gid = wgid / nig, fm = gid * WGM, gsz = (nM - fm) < WGM ? (nM - fm) : WGM;
        u.pm = fm + ((wgid % nig) % gsz); u.pn = (wgid % nig) / gsz; u.r0 = u.pm * BM + sub * HALF;
        u.e = 0; u.a = A + (size_t)u.pm * tstepA + (size_t)sub * (tstepA >> 1) + (size_t)u.pn * acolstep; u.b = B + (size_t)u.pn * tstepB; return true;
    }
    __device__ __forceinline__ int row(const Unit&, int) const { return 0; }
    __device__ __forceinline__ const int* row_ptr(const Unit&, int) const { return nullptr; }
};
struct MoeOrder {
    int nM, nN, nwg, G, c; const char* A; const char* B; unsigned tstepA, tstepB, estride; const int* rowidx; int gather;
    int t1, t2, t3, t4, t5, t6, t7;
    __device__ __forceinline__ bool next(int i, Unit& u) const {
        const int nfull = (nwg / G) * G, R = nwg - nfull; const bool hs = !gather && R > 0 && 2 * R <= G;
        const long L = (long)i * G + c; if (L >= (hs ? nfull + 2 * R : nwg)) return false;
        int wgid = (int)L, sub = 0; u.nai = 2;
        if (hs && wgid >= nfull) { const int j = wgid - nfull; wgid = nfull + (j >> 1); sub = j & 1; u.nai = 1; }
        { const int q = nwg / NXCD, r = nwg % NXCD, xcd = wgid % NXCD, off = wgid / NXCD; wgid = (xcd < r ? xcd * (q + 1) : r * (q + 1) + (xcd - r) * q) + off; }
        const int nig = WGM * nN, gid = wgid / nig, fm = gid * WGM, gsz = (nM - fm) < WGM ? (nM - fm) : WGM;
        u.pm = fm + ((wgid % nig) % gsz); u.pn = (wgid % nig) / gsz; u.r0 = u.pm * BM + sub * HALF;
        const int pm = u.pm;
        const int e = (pm >= t1) + (pm >= t2) + (pm >= t3) + (pm >= t4) + (pm >= t5) + (pm >= t6) + (pm >= t7);
        u.e = e; u.a = gather ? A : A + (size_t)pm * tstepA + (size_t)sub * (tstepA >> 1); u.b = B + (size_t)e * estride + (size_t)u.pn * tstepB; return true;
    }
    __device__ __forceinline__ int row(const Unit& u, int r) const { return rowidx[u.pm * BM + r]; }
    __device__ __forceinline__ const int* row_ptr(const Unit& u, int r) const { return rowidx + u.pm * BM + r; }
};

typedef const f32x4 (&AccRef)[2][2][4][2];
struct EpiPlain {
    static constexpr bool PREF = false;
    bf16_t* O; int ldc;
    __device__ __forceinline__ void operator()(AccRef acc, const Unit& u, int wr, int wc, int fr, int fq) const {
        const int row0 = u.r0 + wr * 64 + fr, col0 = u.pn * BM + wc * 32 + 8 * fq;
#pragma unroll
        for (int ai = 0; ai < 2; ++ai) if (ai < u.nai)
#pragma unroll
            for (int m = 0; m < 4; ++m) { bf16_t* rowp = O + (size_t)(row0 + ai * HALF + m * 16) * ldc + col0;
#pragma unroll
                for (int bj = 0; bj < 2; ++bj) { const f32x4 v0 = acc[ai][bj][m][0], v1 = acc[ai][bj][m][1];
                    u32x4 w; w.x = cvt_pk_bf16(v0[0], v0[1]); w.y = cvt_pk_bf16(v0[2], v0[3]); w.z = cvt_pk_bf16(v1[0], v1[1]); w.w = cvt_pk_bf16(v1[2], v1[3]);
                    *(u32x4*)(rowp + bj * HALF) = w; } }
    }
};
struct EpiPool {
    static constexpr bool PREF = false;
    bf16_t* O; const float* bias; const float* scale;
    __device__ __forceinline__ void operator()(AccRef acc, const Unit& u, int wr, int wc, int fr, int fq) const {
        const int row0 = u.r0 + wr * 64 + fr, col0 = u.pn * BM + wc * 32 + 8 * fq;
#pragma unroll
        for (int bj = 0; bj < 2; ++bj) {
            const f32x4 b0 = *(const f32x4*)(bias + col0 + bj * HALF), b1 = *(const f32x4*)(bias + col0 + bj * HALF + 4);
            const f32x4 s0 = *(const f32x4*)(scale + col0 + bj * HALF), s1 = *(const f32x4*)(scale + col0 + bj * HALF + 4);
#pragma unroll
            for (int ai = 0; ai < 2; ++ai) if (ai < u.nai)
#pragma unroll
                for (int m = 0; m < 4; ++m) { bf16_t* rowp = O + (size_t)(row0 + ai * HALF + m * 16) * D + col0;
                    const f32x4 v0 = (acc[ai][bj][m][0] + b0) * s0, v1 = (acc[ai][bj][m][1] + b1) * s1;
                    u32x4 w; w.x = cvt_pk_bf16(v0[0], v0[1]); w.y = cvt_pk_bf16(v0[2], v0[3]); w.z = cvt_pk_bf16(v1[0], v1[1]); w.w = cvt_pk_bf16(v1[2], v1[3]);
                    *(u32x4*)(rowp + bj * HALF) = w; }
        }
    }
};
struct EpiSwiglu {
    static constexpr bool PREF = false;
    bf16_t* O; int ldc;
    __device__ __forceinline__ void operator()(AccRef acc, const Unit& u, int wr, int wc, int fr, int fq) const {
        const int row0 = u.r0 + wr * 64 + fr, col0 = u.pn * HALF + wc * 32 + 8 * fq;
#pragma unroll
        for (int ai = 0; ai < 2; ++ai) if (ai < u.nai)
#pragma unroll
            for (int m = 0; m < 4; ++m) { bf16_t* rowp = O + (size_t)(row0 + ai * HALF + m * 16) * ldc + col0;
                float o[8];
#pragma unroll
                for (int n = 0; n < 2; ++n)
#pragma unroll
                    for (int j = 0; j < 4; ++j) { const float gv = acc[ai][0][m][n][j], uv = acc[ai][1][m][n][j];
                        o[4 * n + j] = gv * fast_rcp(1.0f + fast_exp2(-gv * LOG2E)) * uv; }
                u32x4 w; w.x = cvt_pk_bf16(o[0], o[1]); w.y = cvt_pk_bf16(o[2], o[3]); w.z = cvt_pk_bf16(o[4], o[5]); w.w = cvt_pk_bf16(o[6], o[7]);
                *(u32x4*)rowp = w; }
    }
};
typedef const i32x4 (&AccRefI)[2][2][4][2];
struct EpiSwigluQ {
    static constexpr bool PREF = true;
    unsigned char* O; int ldc; const float* sa; const float* sw; int swe;
    __device__ __forceinline__ const float* pref_ptr(const Unit& u, int wid, int lane) const {
        return wid < 4 ? sa + (size_t)u.r0 + wid * 64 + lane : sw + (size_t)u.e * swe + u.pn * BM + (wid - 4) * 64 + lane; }
    __device__ __forceinline__ void operator()(AccRefI acc, const Unit& u, int wr, int wc, int fr, int fq, const LAS float* scr) const {
        typedef float f32x2 __attribute__((ext_vector_type(2)));
        const int row0 = u.r0 + wr * 64 + fr, col0 = u.pn * HALF + wc * 32 + 8 * fq;
        const LAS float* swp = scr + 256 + wc * 32 + 8 * fq;
        f32x2 wl[4], wp[4];
#pragma unroll
        for (int q = 0; q < 4; ++q) { const f32x2 g2 = *(const LAS f32x2*)(swp + 2 * q), u2 = *(const LAS f32x2*)(swp + HALF + 2 * q); wl[q] = g2 * (-LOG2E); wp[q] = g2 * u2; }
#pragma unroll
        for (int ai = 0; ai < 2; ++ai) if (ai < u.nai)
#pragma unroll
            for (int m = 0; m < 4; ++m) { const int row = row0 + ai * HALF + m * 16; unsigned char* rowp = O + (size_t)row * ldc + col0;
                const float sr = scr[ai * HALF + wr * 64 + m * 16 + fr], sr2 = sr * sr;
                f32x2 o2[4];
#pragma unroll
                for (int q = 0; q < 4; ++q) { const int n = q >> 1, j = 2 * (q & 1);
                    const f32x2 G2 = {(float)acc[ai][0][m][n][j], (float)acc[ai][0][m][n][j + 1]}, U2 = {(float)acc[ai][1][m][n][j], (float)acc[ai][1][m][n][j + 1]};
                    const f32x2 t2 = (G2 * wl[q]) * sr;
                    f32x2 d2; d2.x = fast_exp2(t2.x); d2.y = fast_exp2(t2.y); d2 = d2 + 1.0f;
                    f32x2 r2; r2.x = fast_rcp(d2.x); r2.y = fast_rcp(d2.y);
                    o2[q] = ((G2 * U2) * wp[q]) * (r2 * sr2); }
                u32x2 w; w.x = pk4_fp8_sat(o2[0].x, o2[0].y, o2[1].x, o2[1].y); w.y = pk4_fp8_sat(o2[2].x, o2[2].y, o2[3].x, o2[3].y);
                *(u32x2*)rowp = w; }
    }
};
struct EpiPlainS {
    static constexpr bool PREF = true;
    bf16_t* O; int ldc; const float* cs; int cse;
    __device__ __forceinline__ const float* pref_ptr(const Unit& u, int wid, int lane) const {
        return wid < 4 ? (const float*)nullptr : cs + (size_t)u.e * cse + u.pn * BM + (wid - 4) * 64 + lane; }
    __device__ __forceinline__ void operator()(AccRef acc, const Unit& u, int wr, int wc, int fr, int fq, const LAS float* scr) const {
        const int row0 = u.r0 + wr * 64 + fr, col0 = u.pn * BM + wc * 32 + 8 * fq;
        const LAS float* cp = scr + 256 + wc * 32 + 8 * fq;
#pragma unroll
        for (int bj = 0; bj < 2; ++bj) {
            const f32x4 s0 = *(const LAS f32x4*)(cp + bj * HALF), s1 = *(const LAS f32x4*)(cp + bj * HALF + 4);
#pragma unroll
            for (int ai = 0; ai < 2; ++ai) if (ai < u.nai)
#pragma unroll
                for (int m = 0; m < 4; ++m) { bf16_t* rowp = O + (size_t)(row0 + ai * HALF + m * 16) * ldc + col0;
                    const f32x4 v0 = acc[ai][bj][m][0] * s0, v1 = acc[ai][bj][m][1] * s1;
                    u32x4 w; w.x = cvt_pk_bf16(v0[0], v0[1]); w.y = cvt_pk_bf16(v0[2], v0[3]); w.z = cvt_pk_bf16(v1[0], v1[1]); w.w = cvt_pk_bf16(v1[2], v1[3]);
                    *(u32x4*)(rowp + bj * HALF) = w; }
        }
    }
};
struct EpiQKVQ {
    static constexpr bool PREF = true;
    bf16_t *Q, *Kb, *V; const float* rope; const float* sa; const float* sw;
    __device__ __forceinline__ const float* pref_ptr(const Unit& u, int wid, int lane) const {
        return wid < 4 ? sa + (size_t)u.r0 + wid * 64 + lane : sw + u.pn * BM + (wid - 4) * 64 + lane; }
    __device__ __forceinline__ void operator()(AccRefI acc, const Unit& u, int wr, int wc, int fr, int fq, const LAS float* scr) const {
        const int row0 = u.r0 + wr * 64 + fr, pn = u.pn;
        bf16_t* base; int ldc, colt;
        if (pn < 4) { base = Q; ldc = D; colt = pn * BM; } else if (pn == 4) { base = Kb; ldc = KVD; colt = 0; } else { base = V; ldc = KVD; colt = 0; }
        const bool rope_on = (pn < 5) && (u.pm < ML / BM);
        const float qs = (pn < 4) ? 0.125f * LOG2E : 1.0f;
        const int axis = wc & 1, col0 = colt + wc * 32 + 8 * fq;
        const LAS float* cp = scr + 256 + wc * 32 + 8 * fq;
        const f32x4 wv[2][2] = {{*(const LAS f32x4*)cp, *(const LAS f32x4*)(cp + 4)}, {*(const LAS f32x4*)(cp + HALF), *(const LAS f32x4*)(cp + HALF + 4)}};
#pragma unroll
        for (int ai = 0; ai < 2; ++ai) if (ai < u.nai) {
            f32x4 c4[4], s4[4];
#pragma unroll
            for (int m = 0; m < 4; ++m) { c4[m] = (f32x4){1.f, 1.f, 1.f, 1.f}; s4[m] = (f32x4){0.f, 0.f, 0.f, 0.f}; }
            if (rope_on) {
#pragma unroll
                for (int m = 0; m < 4; ++m) { const int row = row0 + ai * HALF + m * 16, t = row & (SEQ - 1), pos = axis ? (t & 63) : (t >> 6);
                    c4[m] = *(const f32x4*)(rope + pos * 16 + 4 * fq); s4[m] = *(const f32x4*)(rope + 2048 + pos * 16 + 4 * fq); }
            }
#pragma unroll
            for (int m = 0; m < 4; ++m) { const int row = row0 + ai * HALF + m * 16; bf16_t* rowp = base + (size_t)row * ldc + col0;
                const float sr = scr[ai * HALF + wr * 64 + m * 16 + fr] * qs;
                const f32x4 cc = c4[m] * sr, ss = s4[m] * sr;
#pragma unroll
                for (int bj = 0; bj < 2; ++bj) {
                    const i32x4 a0 = acc[ai][bj][m][0], a1 = acc[ai][bj][m][1];
                    const f32x4 v0 = (f32x4){(float)a0[0], (float)a0[1], (float)a0[2], (float)a0[3]} * wv[bj][0], v1 = (f32x4){(float)a1[0], (float)a1[1], (float)a1[2], (float)a1[3]} * wv[bj][1];
                    u32x4 w;
                    w.x = cvt_pk_bf16(v0[0] * cc[0] - v0[1] * ss[0], v0[1] * cc[0] + v0[0] * ss[0]);
                    w.y = cvt_pk_bf16(v0[2] * cc[1] - v0[3] * ss[1], v0[3] * cc[1] + v0[2] * ss[1]);
                    w.z = cvt_pk_bf16(v1[0] * cc[2] - v1[1] * ss[2], v1[1] * cc[2] + v1[0] * ss[2]);
                    w.w = cvt_pk_bf16(v1[2] * cc[3] - v1[3] * ss[3], v1[3] * cc[3] + v1[2] * ss[3]);
                    *(u32x4*)(rowp + bj * HALF) = w; }
            }
        }
    }
};
struct EpiQKV {
    static constexpr bool PREF = false;
    bf16_t *Q, *Kb, *V; const float* rope;
    __device__ __forceinline__ void operator()(AccRef acc, const Unit& u, int wr, int wc, int fr, int fq) const {
        const int row0 = u.r0 + wr * 64 + fr, pn = u.pn;
        bf16_t* base; int ldc, colt;
        if (pn < 4) { base = Q; ldc = D; colt = pn * BM; } else if (pn == 4) { base = Kb; ldc = KVD; colt = 0; } else { base = V; ldc = KVD; colt = 0; }
        const bool rope_on = (pn < 5) && (u.pm < ML / BM);
        const float qs = (pn < 4) ? 0.125f * LOG2E : 1.0f;
        const int axis = wc & 1, col0 = colt + wc * 32 + 8 * fq;
#pragma unroll
        for (int ai = 0; ai < 2; ++ai) if (ai < u.nai)
#pragma unroll
            for (int m = 0; m < 4; ++m) { const int row = row0 + ai * HALF + m * 16; bf16_t* rowp = base + (size_t)row * ldc + col0;
                f32x4 c4 = (f32x4){1.f, 1.f, 1.f, 1.f}, s4 = (f32x4){0.f, 0.f, 0.f, 0.f};
                if (rope_on) { const int t = row & (SEQ - 1), pos = axis ? (t & 63) : (t >> 6); c4 = *(const f32x4*)(rope + pos * 16 + 4 * fq); s4 = *(const f32x4*)(rope + 2048 + pos * 16 + 4 * fq); }
                c4 *= qs; s4 *= qs;
#pragma unroll
                for (int bj = 0; bj < 2; ++bj) { const f32x4 v0 = acc[ai][bj][m][0], v1 = acc[ai][bj][m][1];
                    u32x4 w;
                    w.x = cvt_pk_bf16(v0[0] * c4[0] - v0[1] * s4[0], v0[1] * c4[0] + v0[0] * s4[0]);
                    w.y = cvt_pk_bf16(v0[2] * c4[1] - v0[3] * s4[1], v0[3] * c4[1] + v0[2] * s4[1]);
                    w.z = cvt_pk_bf16(v1[0] * c4[2] - v1[1] * s4[2], v1[1] * c4[2] + v1[0] * s4[2]);
                    w.w = cvt_pk_bf16(v1[2] * c4[3] - v1[3] * s4[3], v1[3] * c4[3] + v1[2] * s4[3]);
                    *(u32x4*)(rowp + bj * HALF) = w; } }
    }
};
}

struct Params {
    const float *x, *c, *ctx, *c_ctx, *ada_w, *ada_b, *norm_g, *w_qkv, *w_o, *sink, *pool_w, *pool_b, *pool_scale, *ffn_gu, *ffn_dn, *router_w, *router_b, *moe_gu, *moe_dn;
    float* out; unsigned char* ws;
};

__device__ __forceinline__ int src_col(int n, int mode, int F) {
    if (mode == 1) { if (n >= 1280) return n; const int dn = n & 63, i = dn >> 1, s = dn & 1; return (n & ~63) + (i & 15) + 32 * (i >> 4) + 16 * s; }
    if (mode == 2) { const int pn = n >> 8, bj = (n >> 7) & 1, jj = n & 127; return bj * F + 128 * pn + jj; }
    return n;
}
__device__ __forceinline__ void transpose_item(const float* W, int Nsrc, int K, bf16_t* Bt, int item, int nblk, int mode, int F, int lane) {
    const int kb = item / nblk, nb = item % nblk, k0 = kb * 64, n = nb * 64 + lane;
    const float* src = W + (size_t)k0 * Nsrc + src_col(n, mode, F);
    float v[64];
#pragma unroll
    for (int i = 0; i < 64; ++i) v[i] = src[(size_t)i * Nsrc];
    bf16_t* dst = Bt + (size_t)n * K + k0;
#pragma unroll
    for (int j = 0; j < 8; ++j) { u32x4 w; w.x = cvt_pk_bf16(v[8 * j], v[8 * j + 1]); w.y = cvt_pk_bf16(v[8 * j + 2], v[8 * j + 3]); w.z = cvt_pk_bf16(v[8 * j + 4], v[8 * j + 5]); w.w = cvt_pk_bf16(v[8 * j + 6], v[8 * j + 7]);
        *(u32x4*)(dst + 8 * j) = w; }
}
__device__ __forceinline__ void colmax_item(const float* W, unsigned* colmax, int item, int lane, int kb_mid) {
    const int kb = (item >> 4) ? kb_mid : 0, nb = item & 15, n = nb * 64 + lane;
    const float* src = W + (size_t)(kb * 64) * D + n;
    float v[64]; float mx = 0.f;
#pragma unroll
    for (int i = 0; i < 64; ++i) v[i] = src[(size_t)i * D];
#pragma unroll
    for (int i = 0; i < 64; ++i) mx = fmaxf(mx, fabsf(v[i]));
    atomicMax(colmax + n, __float_as_uint(mx));
}
__device__ __forceinline__ void fp8_item(const float* W, int K, unsigned char* Bq, const unsigned* colmax, float* sdn, int item, int lane) {
    const int kb = item >> 4, nb = item & 15, n = nb * 64 + lane;
    const float* src = W + (size_t)(kb * 64) * D + n;
    float v[64];
#pragma unroll
    for (int i = 0; i < 64; ++i) v[i] = src[(size_t)i * D];
    const float cm = __uint_as_float(colmax[n]), sc = cm > 0.f ? 128.0f / cm : 0.f;
    if (kb == 0) sdn[n] = cm * (1.0f / 128.0f);
    unsigned char* dst = Bq + (size_t)n * K + kb * 64;
#pragma unroll
    for (int c = 0; c < 4; ++c) { u32x4 w4;
#pragma unroll
        for (int q = 0; q < 4; ++q) w4[q] = pk4_fp8(v[16 * c + 4 * q] * sc, v[16 * c + 4 * q + 1] * sc, v[16 * c + 4 * q + 2] * sc, v[16 * c + 4 * q + 3] * sc);
        *(u32x4*)(dst + 16 * c) = w4; }
}
__device__ __forceinline__ void quant_item(const float* W, int Nsrc, signed char* Bq, float* sw, int nb, int mode, int F, LAS float* pmax, int wave, int lane) {
    const int n = nb * 64 + lane;
    const float* src = W + (size_t)(wave * 128) * Nsrc + src_col(n, mode, F);
    float v[128]; float mx = 0.f;
#pragma unroll
    for (int i = 0; i < 128; ++i) v[i] = src[(size_t)i * Nsrc];
#pragma unroll
    for (int i = 0; i < 128; ++i) mx = fmaxf(mx, fabsf(v[i]));
    pmax[wave * 64 + lane] = mx;
    __syncthreads();
    float cm = pmax[lane];
#pragma unroll
    for (int w = 1; w < 8; ++w) cm = fmaxf(cm, pmax[w * 64 + lane]);
    const float inv = cm > 0.f ? 127.0f / cm : 0.f;
    if (wave == 0) sw[n] = cm * (1.0f / 127.0f);
    signed char* dst = Bq + (size_t)n * D + wave * 128;
#pragma unroll
    for (int c = 0; c < 8; ++c) { u32x4 w4;
#pragma unroll
        for (int q = 0; q < 4; ++q) { unsigned wd = 0u;
#pragma unroll
            for (int b = 0; b < 4; ++b) { const int qi = (int)__builtin_rintf(v[16 * c + 4 * q + b] * inv); wd |= ((unsigned)qi & 0xffu) << (8 * b); }
            w4[q] = wd; }
        *(u32x4*)(dst + 16 * c) = w4; }
}
__device__ __forceinline__ void prologue(const Params& p, LAS unsigned char* lds, int G, int wg, int tid) {
    const int lane = tid & 63, wave = __builtin_amdgcn_readfirstlane(tid >> 6);
    LAS float* scond = (LAS float*)lds;
    for (int i = tid; i < 5 * D; i += 512) { const int cnd = i >> 10, k = i & 1023; const float v = cnd < 4 ? p.c[cnd * D + k] : p.c_ctx[k]; scond[i] = v / (1.0f + __expf(-v)); }
    __syncthreads();
    const int gw = wg * 8 + wave, NGW = G * 8;
    if (wg == G - 1) {
        float* rope = (float*)(p.ws + WS_ROPE);
        for (int i = tid; i < 2048; i += 512) { const int pos = i >> 4, f = i & 15;
            const int fq4 = f & 3, fd = f >> 2;
            double inv = fq4 == 0 ? 1.0 : (fq4 == 1 ? 0.5623413251903491 : (fq4 == 2 ? 0.31622776601683794 : 0.1778279410038923));
            inv *= fd == 0 ? 1.0 : (fd == 1 ? 0.1 : (fd == 2 ? 0.01 : 0.001));
            const double ang = (double)pos * inv, kq = __builtin_rint(ang * 0.6366197723675814);
            double r = __builtin_fma(-kq, 1.5707963267948966, ang); r = __builtin_fma(-kq, 6.123233995736766e-17, r);
            const double r2 = r * r;
            const double sr = r * (1.0 + r2 * (-1.0 / 6 + r2 * (1.0 / 120 + r2 * (-1.0 / 5040 + r2 * (1.0 / 362880 + r2 * (-1.0 / 39916800 + r2 * (1.0 / 6227020800.0)))))));
            const double cr = 1.0 + r2 * (-0.5 + r2 * (1.0 / 24 + r2 * (-1.0 / 720 + r2 * (1.0 / 40320 + r2 * (-1.0 / 3628800 + r2 * (1.0 / 479001600 + r2 * (-1.0 / 87178291200.0)))))));
            const int qd = (int)kq & 3;
            const double cs = qd == 0 ? cr : (qd == 1 ? -sr : (qd == 2 ? -cr : sr)), sn = qd == 0 ? sr : (qd == 1 ? cr : (qd == 2 ? -sr : -cr));
            rope[i] = (float)cs; rope[2048 + i] = (float)sn; }
    }
    {
        float* modp = (float*)(p.ws + WS_MODP);
        for (int it = gw; it < KP * 4 * 24; it += NGW) {
            const int part = it / 96, rem = it % 96, l = rem / 24, cb = rem % 24, n = cb * 256 + 4 * lane, k0 = part * (D / KP);
            const float* w = p.ada_w + ((size_t)l * D + k0) * 6144 + n;
            f32x4 a0 = {0.f, 0.f, 0.f, 0.f}, a1 = a0, a2 = a0, a3 = a0, a4 = a0;
#pragma unroll 8
            for (int k = 0; k < D / KP; ++k) { const f32x4 wv = *(const f32x4*)(w + (size_t)k * 6144);
                a0 += wv * scond[0 * D + k0 + k]; a1 += wv * scond[1 * D + k0 + k]; a2 += wv * scond[2 * D + k0 + k]; a3 += wv * scond[3 * D + k0 + k]; a4 += wv * scond[4 * D + k0 + k]; }
            float* o = modp + ((size_t)(part * 4 + l) * 5) * 6144 + n;
            *(f32x4*)(o + 0 * 6144) = a0; *(f32x4*)(o + 1 * 6144) = a1; *(f32x4*)(o + 2 * 6144) = a2; *(f32x4*)(o + 3 * 6144) = a3; *(f32x4*)(o + 4 * 6144) = a4;
        }
    }
    {
        LAS float* pmax = (LAS float*)(lds + 32768);
        float* swb = (float*)(p.ws + WS_SW);
        unsigned* qctr = (unsigned*)(p.ws + WS_CTL) + CW_QITEM;
        LAS int* qit = (LAS int*)(lds + 32768 + 8192);
        int nxt_it = 0;
        if (tid == 0) nxt_it = (int)atomicAdd(qctr, 1u);
        int par = 0;
        for (;; par ^= 1) {
            if (tid == 0) *qit = nxt_it;
            __syncthreads();
            const int it = *qit;
            if (it >= 2 * 88 + 16 * 112 + 2 * 24) break;
            if (tid == 0) nxt_it = (int)atomicAdd(qctr, 1u);
            if (it >= 2 * 88 + 16 * 112) { const int r = it - (2 * 88 + 16 * 112), mi = r / 24, nb = r % 24;
                quant_item(p.w_qkv + (size_t)mi * D * NQKV, NQKV, (signed char*)(p.ws + WS_WQKV) + (size_t)mi * NQKV * D, swb + SWQ_OFF + mi * NQKV, nb, 1, 0, pmax + par * 512, wave, lane); continue; }
            if (it < 2 * 88) { const int mi = it / 88, nb = it % 88; quant_item(p.ffn_gu + (size_t)mi * D * 2 * DFF, 2 * DFF, (signed char*)(p.ws + WS_WFGU) + (size_t)mi * 2 * DFF * D, swb + mi * 2 * DFF, nb, 2, DFF, pmax + par * 512, wave, lane); }
            else { const int r = it - 2 * 88, mi = r / 112, nb = r % 112; quant_item(p.moe_gu + (size_t)mi * D * 2 * DFE, 2 * DFE, (signed char*)(p.ws + WS_WMGU) + (size_t)mi * 2 * DFE * D, swb + 2 * 2 * DFF + mi * 2 * DFE, nb, 2, DFE, pmax + par * 512, wave, lane); }
        }
    }
    constexpr int I1 = 2 * 256, I2 = I1 + 8 * 16, I3 = I2 + 2 * 32, I4 = I3 + 16 * 32;
    unsigned* colmax = (unsigned*)(p.ws + WS_CTL + CTL_COLMAX);
    for (int it = gw; it < I4; it += NGW) {
        if (it >= I3) { const int r = it - I3, mi = r / 32, li = r % 32; colmax_item(p.moe_dn + (size_t)mi * DFE * D, colmax + (2 + mi) * D, li, lane, DFE / 128); }
        else if (it >= I2) { const int r = it - I2, mi = r / 32, li = r % 32; colmax_item(p.ffn_dn + (size_t)mi * DFF * D, colmax + mi * D, li, lane, DFF / 128); }
        else if (it >= I1) { const int r = it - I1, mi = r / 16, li = r % 16; transpose_item(p.pool_w + (size_t)mi * 256 * 256, 256, 256, (bf16_t*)(p.ws + WS_WPOOL) + (size_t)mi * 256 * 256, li, 4, 0, 0, lane); }
        else { const int mi = it / 256, li = it % 256; transpose_item(p.w_o + (size_t)mi * D * D, D, D, (bf16_t*)(p.ws + WS_WO) + (size_t)mi * D * D, li, 16, 0, 0, lane); }
    }
}
__device__ __forceinline__ void prologue_down_quant(const Params& p, int G, int wg, int tid) {
    const int lane = tid & 63, wave = __builtin_amdgcn_readfirstlane(tid >> 6), gw = wg * 8 + wave, NGW = G * 8;
    const unsigned* colmax = (const unsigned*)(p.ws + WS_CTL + CTL_COLMAX);
    float* sdn = (float*)(p.ws + WS_SDN);
    constexpr int J0 = 2 * 704, J1 = J0 + 16 * 896;
    for (int it = gw; it < J1; it += NGW) {
        if (it >= J0) { const int r = it - J0, mi = r / 896, li = r % 896; fp8_item(p.moe_dn + (size_t)mi * DFE * D, DFE, (unsigned char*)(p.ws + WS_WMDN) + (size_t)mi * D * DFE, colmax + (2 + mi) * D, sdn + (2 + mi) * D, li, lane); }
        else { const int mi = it / 704, li = it % 704; fp8_item(p.ffn_dn + (size_t)mi * DFF * D, DFF, (unsigned char*)(p.ws + WS_WFDN) + (size_t)mi * D * DFF, colmax + mi * D, sdn + mi * D, li, lane); }
    }
}

template <bool PARTS>
__device__ __forceinline__ f32x4 mod_vec(const float* modp, const float* mod, const float* ada_b, int l, int cond, int chunk, int col) {
    if (!PARTS) return *(const f32x4*)(mod + ((size_t)l * 5 + cond) * 6144 + chunk * D + col);
    f32x4 s = *(const f32x4*)(ada_b + (size_t)l * 6144 + chunk * D + col);
#pragma unroll 2
    for (int pt = 0; pt < KP; ++pt) s += *(const f32x4*)(modp + ((size_t)(pt * 4 + l) * 5 + cond) * 6144 + chunk * D + col);
    return s;
}
template <bool ROUTER, bool MOE_IN, bool PARTS, bool Q8>
__device__ __forceinline__ void thin_phase(const Params& p, LAS unsigned char* lds, int G, int wg, int tid, int M, bool has_post, int lpost, int wpost, bool has_pre, int lpre, int wpre,
                                           bool xin32, bool xout32, bool write_x, const bf16_t* y, bf16_t* hout, int lrouter) {
    const int lane = tid & 63, wave = __builtin_amdgcn_readfirstlane(tid >> 6);
    const float* modp = (const float*)(p.ws + WS_MODP);
    const float* modf = (const float*)(p.ws + WS_MOD);
    if (PARTS) {
        float* mo = (float*)(p.ws + WS_MOD);
        for (int i = wg * 512 + tid; i < 4 * 5 * 6144 / 4; i += G * 512) { const int e = i * 4, l = e / (5 * 6144), r = e % (5 * 6144), cnd = r / 6144, n = r % 6144;
            *(f32x4*)(mo + e) = mod_vec<true>(modp, modf, p.ada_b, l, cnd, n >> 10, n & 1023); }
    }
    LAS float* rw = (LAS float*)lds;
    LAS unsigned* lcnt = (LAS unsigned*)(lds + 32768);
    if (ROUTER) {
        const float* rwg = p.router_w + (size_t)lrouter * D * NE;
        for (int i = tid; i < D * NE; i += 512) { const int k = i >> 3, e = i & 7; rw[e * D + k] = rwg[i]; }
        if (tid < 8) lcnt[tid] = 0u;
        __syncthreads();
    }
    const int RPW = (M + G - 1) / G, r0 = wg * RPW, r1 = (r0 + RPW < M) ? r0 + RPW : M;
    int cur_cond = -1;
    f32x4 pa[4], pb[4], pc[4];
    f32x4 xA[4], xB[4], xC[4]; u32x2 rA[4], rB[4], rC[4], yA[4], yB[4], yC[4], zA[4], zB[4], zC[4];
    bf16_t* const xbs = (bf16_t*)(p.ws + WS_XB); float gA1 = 0.f, gA2 = 0.f, gB1 = 0.f, gB2 = 0.f, gC1 = 0.f, gC2 = 0.f;
#define TH_SLOT(row_, sl_, inf_) do { if (MOE_IN) { sl_ = *(const i32x2*)(p.ws + WS_MOE + MO_SLOT + (size_t)(row_) * 8); inf_ = *(const i32x4*)(p.ws + WS_MOE + MO_INFO + (size_t)(row_) * 16); } } while (0)
#define TH_LOAD(row_, xv_, xr2_, ya_, yb_, g1_, g2_, sl_, inf_) do { \
        if (xin32) { const float* xr_ = (row_) < ML ? p.x + (size_t)(row_) * D : p.ctx + (size_t)((row_) - ML) * D; \
            _Pragma("unroll") for (int j = 0; j < 4; ++j) xv_[j] = *(const f32x4*)(xr_ + 4 * lane + 256 * j); } \
        else { const bf16_t* xr_ = xbs + (size_t)(row_) * D; \
            _Pragma("unroll") for (int j = 0; j < 4; ++j) xr2_[j] = *(const u32x2*)(xr_ + 4 * lane + 256 * j); } \
        if (has_post) { \
            if (MOE_IN) { \
                g1_ = __int_as_float(inf_.z); g2_ = __int_as_float(inf_.w); \
                const bf16_t* y1_ = y + (size_t)sl_.x * D; const bf16_t* y2_ = y + (size_t)sl_.y * D; \
                _Pragma("unroll") for (int j = 0; j < 4; ++j) { ya_[j] = *(const u32x2*)(y1_ + 4 * lane + 256 * j); yb_[j] = *(const u32x2*)(y2_ + 4 * lane + 256 * j); } \
            } else { \
                const bf16_t* yr_ = y + (size_t)(row_) * D; \
                _Pragma("unroll") for (int j = 0; j < 4; ++j) ya_[j] = *(const u32x2*)(yr_ + 4 * lane + 256 * j); \
            } } } while (0)
#define TH_PROC(row_, xv, xr2_, ya_, yb_, g1_, g2_) do { \
        const int row = (row_); \
        if (!xin32) { _Pragma("unroll") for (int j = 0; j < 4; ++j) xv[j] = (f32x4){bf_lo(xr2_[j].x), bf_hi(xr2_[j].x), bf_lo(xr2_[j].y), bf_hi(xr2_[j].y)}; } \
        const int cond = row < ML ? (row >> 13) : 4; \
        if (cond != cur_cond) { \
            cur_cond = cond; \
            _Pragma("unroll") for (int j = 0; j < 4; ++j) { const int col = 4 * lane + 256 * j; \
                if (has_post) { const f32x4 gt = mod_vec<PARTS>(modp, modf, p.ada_b, lpost, cond, wpost ? 5 : 2, col); const f32x4 gp = *(const f32x4*)(p.norm_g + ((size_t)lpost * 4 + (wpost ? 3 : 1)) * D + col); pa[j] = gt * gp; } \
                else pa[j] = (f32x4){0.f, 0.f, 0.f, 0.f}; \
                if (has_pre) { const f32x4 sh = mod_vec<PARTS>(modp, modf, p.ada_b, lpre, cond, wpre ? 3 : 0, col), sc = mod_vec<PARTS>(modp, modf, p.ada_b, lpre, cond, wpre ? 4 : 1, col); \
                    const f32x4 gp = *(const f32x4*)(p.norm_g + ((size_t)lpre * 4 + (wpre ? 2 : 0)) * D + col); pb[j] = gp * (sc + 1.0f); pc[j] = sh; } \
                else { pb[j] = (f32x4){0.f, 0.f, 0.f, 0.f}; pc[j] = pb[j]; } \
            } \
        } \
        if (has_post) { \
            f32x4 yv[4]; \
            if (MOE_IN) { \
                _Pragma("unroll") for (int j = 0; j < 4; ++j) { const u32x2 a = ya_[j], b = yb_[j]; \
                    yv[j] = (f32x4){g1_ * bf_lo(a.x) + g2_ * bf_lo(b.x), g1_ * bf_hi(a.x) + g2_ * bf_hi(b.x), g1_ * bf_lo(a.y) + g2_ * bf_lo(b.y), g1_ * bf_hi(a.y) + g2_ * bf_hi(b.y)}; } \
            } else { \
                _Pragma("unroll") for (int j = 0; j < 4; ++j) { const u32x2 a = ya_[j]; yv[j] = (f32x4){bf_lo(a.x), bf_hi(a.x), bf_lo(a.y), bf_hi(a.y)}; } \
            } \
            float ss = 0.f; \
            _Pragma("unroll") for (int j = 0; j < 4; ++j) ss += (yv[j].x * yv[j].x + yv[j].y * yv[j].y) + (yv[j].z * yv[j].z + yv[j].w * yv[j].w); \
            const float rstd = 1.0f / sqrtf(wave_sum(ss) * (1.0f / D) + NORM_EPS); \
            _Pragma("unroll") for (int j = 0; j < 4; ++j) xv[j] += pa[j] * (yv[j] * rstd); \
            if (write_x) { \
                if (xout32) { float* xw = p.out + (size_t)row * D; \
                    _Pragma("unroll") for (int j = 0; j < 4; ++j) *(f32x4*)(xw + 4 * lane + 256 * j) = xv[j]; } \
                else { bf16_t* xw = xbs + (size_t)row * D; \
                    _Pragma("unroll") for (int j = 0; j < 4; ++j) { u32x2 w; w.x = cvt_pk_bf16(xv[j].x, xv[j].y); w.y = cvt_pk_bf16(xv[j].z, xv[j].w); *(u32x2*)(xw + 4 * lane + 256 * j) = w; \
                        xv[j] = (f32x4){bf_lo(w.x), bf_hi(w.x), bf_lo(w.y), bf_hi(w.y)}; } }     \
            } \
        } \
        if (has_pre) { \
            float ss = 0.f; \
            _Pragma("unroll") for (int j = 0; j < 4; ++j) ss += (xv[j].x * xv[j].x + xv[j].y * xv[j].y) + (xv[j].z * xv[j].z + xv[j].w * xv[j].w); \
            const float rstd = 1.0f / sqrtf(wave_sum(ss) * (1.0f / D) + NORM_EPS); \
            f32x4 hv[4]; \
            bf16_t* hr = hout + (size_t)row * D; \
            _Pragma("unroll") for (int j = 0; j < 4; ++j) hv[j] = (xv[j] * rstd) * pb[j] + pc[j]; \
            if (Q8) {     \
                float am = 0.f; \
                _Pragma("unroll") for (int j = 0; j < 4; ++j) am = fmaxf(fmaxf(am, fmaxf(fabsf(hv[j].x), fabsf(hv[j].y))), fmaxf(fabsf(hv[j].z), fabsf(hv[j].w))); \
                am = wave_max(am); \
                const float qi_ = am > 0.f ? 127.0f / am : 0.f; \
                signed char* hq_ = (signed char*)(p.ws + WS_HQ) + (size_t)row * D; \
                _Pragma("unroll") for (int j = 0; j < 4; ++j) { \
                    const unsigned wd_ = ((unsigned)(int)__builtin_rintf(hv[j].x * qi_) & 0xffu) | (((unsigned)(int)__builtin_rintf(hv[j].y * qi_) & 0xffu) << 8) | (((unsigned)(int)__builtin_rintf(hv[j].z * qi_) & 0xffu) << 16) | (((unsigned)(int)__builtin_rintf(hv[j].w * qi_) & 0xffu) << 24); \
                    *(unsigned*)(hq_ + 4 * lane + 256 * j) = wd_; } \
                if (lane == 0) ((float*)(p.ws + WS_SA))[row] = am * (1.0f / 127.0f); \
            } else { \
                _Pragma("unroll") for (int j = 0; j < 4; ++j) { u32x2 w; w.x = cvt_pk_bf16(hv[j].x, hv[j].y); w.y = cvt_pk_bf16(hv[j].z, hv[j].w); *(u32x2*)(hr + 4 * lane + 256 * j) = w; } \
            } \
            if (ROUTER) { \
                float lg[8]; \
                _Pragma("unroll") for (int e = 0; e < 8; ++e) { float s_ = 0.f; \
                    _Pragma("unroll") for (int j = 0; j < 4; ++j) { const f32x4 w = *(const LAS f32x4*)(rw + e * D + 4 * lane + 256 * j); s_ += (hv[j].x * w.x + hv[j].y * w.y) + (hv[j].z * w.z + hv[j].w * w.w); } \
                    lg[e] = wave_sum(s_) + p.router_b[lrouter * NE + e]; } \
                int e1 = 0; float v1 = lg[0]; \
                _Pragma("unroll") for (int e = 1; e < 8; ++e) if (lg[e] > v1) { v1 = lg[e]; e1 = e; } \
                int e2 = -1; float v2 = -3.0e38f; \
                _Pragma("unroll") for (int e = 0; e < 8; ++e) if (e != e1 && lg[e] > v2) { v2 = lg[e]; e2 = e; } \
                const float g1 = 1.0f / (1.0f + __expf(v2 - v1)), g2 = 1.0f - g1; \
                if (lane == 0) { \
                    const unsigned p1 = atomicAdd((unsigned*)(lcnt + e1), 1u), p2 = atomicAdd((unsigned*)(lcnt + e2), 1u); \
                    i32x4 inf; inf.x = e1 | (e2 << 8); inf.y = (int)(p1 | (p2 << 16)); inf.z = __float_as_int(g1); inf.w = __float_as_int(g2); \
                    *(i32x4*)(p.ws + WS_MOE + MO_INFO + (size_t)row * 16) = inf; \
                } \
            } \
        } } while (0)
    {
        int rcur = r0 + wave;
        i32x2 slA = {0, 0}, slB = {0, 0}, slC = {0, 0}; i32x4 infA = {0, 0, 0, 0}, infB = {0, 0, 0, 0}, infC = {0, 0, 0, 0};
        if (rcur < r1) {
            TH_SLOT(rcur, slA, infA);
            if (rcur + 8 < r1) TH_SLOT(rcur + 8, slB, infB);
            if (rcur + 16 < r1) TH_SLOT(rcur + 16, slC, infC);
            TH_LOAD(rcur, xA, rA, yA, zA, gA1, gA2, slA, infA);
            if (rcur + 8 < r1) TH_LOAD(rcur + 8, xB, rB, yB, zB, gB1, gB2, slB, infB);
            for (;;) {
                if (rcur + 16 < r1) TH_LOAD(rcur + 16, xC, rC, yC, zC, gC1, gC2, slC, infC);
                if (rcur + 24 < r1) TH_SLOT(rcur + 24, slA, infA);
                TH_PROC(rcur, xA, rA, yA, zA, gA1, gA2);
                rcur += 8; if (rcur >= r1) break;
                if (rcur + 16 < r1) TH_LOAD(rcur + 16, xA, rA, yA, zA, gA1, gA2, slA, infA);
                if (rcur + 24 < r1) TH_SLOT(rcur + 24, slB, infB);
                TH_PROC(rcur, xB, rB, yB, zB, gB1, gB2);
                rcur += 8; if (rcur >= r1) break;
                if (rcur + 16 < r1) TH_LOAD(rcur + 16, xB, rB, yB, zB, gB1, gB2, slB, infB);
                if (rcur + 24 < r1) TH_SLOT(rcur + 24, slC, infC);
                TH_PROC(rcur, xC, rC, yC, zC, gC1, gC2);
                rcur += 8; if (rcur >= r1) break;
            }
        }
    }
#undef TH_LOAD
#undef TH_SLOT
#undef TH_PROC
    if (ROUTER) {
        __syncthreads();
        if (tid < 8) ((int*)(p.ws + WS_MOE + MO_WGCNT))[wg * 8 + tid] = (int)lcnt[tid];
    }
}

__device__ __forceinline__ void route_phase(const Params& p, LAS unsigned char* lds, int G, int wg, int tid, int M) {
    LAS int* cnt = (LAS int*)lds;
    LAS int* tab = (LAS int*)(lds + 32768);
    const int* wgcnt = (const int*)(p.ws + WS_MOE + MO_WGCNT);
    for (int i = tid; i < G * 8; i += 512) cnt[i] = wgcnt[i];
    __syncthreads();
    if (tid < 8) { int tot = 0, pre = 0; for (int w = 0; w < G; ++w) { const int c = cnt[w * 8 + tid]; if (w < wg) pre += c; tot += c; } tab[tid] = pre; tab[8 + tid] = tot; }
    __syncthreads();
    if (tid == 0) { int ts = 0; for (int e = 0; e < 8; ++e) { tab[16 + e] = ts; ts += (tab[8 + e] + 255) >> 8; } tab[24] = ts; }
    __syncthreads();
    int* rowidx = (int*)(p.ws + WS_MOE + MO_ROWIDX);
    const int RPW = (M + G - 1) / G, r0 = wg * RPW, r1 = (r0 + RPW < M) ? r0 + RPW : M;
    for (int row = r0 + tid; row < r1; row += 512) {
        const i32x4 inf = *(const i32x4*)(p.ws + WS_MOE + MO_INFO + (size_t)row * 16);
        const int e1 = inf.x & 255, e2 = (inf.x >> 8) & 255, p1 = inf.y & 0xffff, p2 = (inf.y >> 16) & 0xffff;
        const int s1 = tab[16 + e1] * 256 + tab[e1] + p1, s2 = tab[16 + e2] * 256 + tab[e2] + p2;
        rowidx[s1] = row; rowidx[s2] = row;
        { const float sc = ((const float*)(p.ws + WS_SA))[row]; float* sas = (float*)(p.ws + WS_SAS); sas[s1] = sc; sas[s2] = sc; }
        i32x2 sl; sl.x = s1; sl.y = s2; *(i32x2*)(p.ws + WS_MOE + MO_SLOT + (size_t)row * 8) = sl;
    }
    if (wg < 8) { const int e = wg, s0 = tab[16 + e] * 256 + tab[8 + e], s1 = tab[17 + e] * 256; for (int s = s0 + tid; s < s1; s += 512) { rowidx[s] = 0; ((float*)(p.ws + WS_SAS))[s] = 0.f; } }
    if (wg == 0 && tid < 32) ((int*)(p.ws + WS_MOE + MO_TAB))[tid] = (tid < 25) ? tab[tid] : 0;
    __syncthreads();
}

__device__ __forceinline__ void pooldiff_phase(const bf16_t* h, bf16_t* d, int G, int wg, int tid, int M) {
    const int chunk = tid & 127, seg = tid >> 7, hw = 1 << (chunk >> 5);
    const int RPW = (M + G - 1) / G, r0 = wg * RPW, r1 = (r0 + RPW < M) ? r0 + RPW : M;
    const int nseg = (r1 - r0 + 3) >> 2, ra = r0 + seg * nseg, rb = (ra + nseg < r1) ? ra + nseg : r1;
    const bf16_t* hc = h + chunk * 8; bf16_t* dc = d + chunk * 8;
    float S[8] = {0.f, 0.f, 0.f, 0.f, 0.f, 0.f, 0.f, 0.f};
    bool fresh = true;
#define PD_ACC(sgn_, v_) do { S[0] += sgn_ bf_lo(v_.x); S[1] += sgn_ bf_hi(v_.x); S[2] += sgn_ bf_lo(v_.y); S[3] += sgn_ bf_hi(v_.y); S[4] += sgn_ bf_lo(v_.z); S[5] += sgn_ bf_hi(v_.z); S[6] += sgn_ bf_lo(v_.w); S[7] += sgn_ bf_hi(v_.w); } while (0)
#pragma unroll 2
    for (int row = ra; row < rb; ++row) {
        int base, t, T;
        if (row < ML) { base = row & ~(SEQ - 1); t = row & (SEQ - 1); T = SEQ; } else { base = ML + ((row - ML) & ~(CTXL - 1)); t = (row - ML) & (CTXL - 1); T = CTXL; }
        const int lo = (t - hw) > 0 ? (t - hw) : 0, hi = (t + hw) < T ? (t + hw) : T;
        if (fresh || t == 0) {
            fresh = false;
#pragma unroll
            for (int i = 0; i < 8; ++i) S[i] = 0.f;
            for (int j = lo; j < hi; ++j) { const u32x4 v = *(const u32x4*)(hc + (size_t)(base + j) * D); PD_ACC(+, v); }
        } else {
            if (t + hw - 1 < T) { const u32x4 v = *(const u32x4*)(hc + (size_t)(base + t + hw - 1) * D); PD_ACC(+, v); }
            if (t - hw - 1 >= 0) { const u32x4 v = *(const u32x4*)(hc + (size_t)(base + t - hw - 1) * D); PD_ACC(-, v); }
        }
        const float inv = 1.0f / (float)(hi - lo);
        const u32x4 cv = *(const u32x4*)(hc + (size_t)row * D);
        u32x4 o;
        o.x = cvt_pk_bf16(S[0] * inv - bf_lo(cv.x), S[1] * inv - bf_hi(cv.x)); o.y = cvt_pk_bf16(S[2] * inv - bf_lo(cv.y), S[3] * inv - bf_hi(cv.y));
        o.z = cvt_pk_bf16(S[4] * inv - bf_lo(cv.z), S[5] * inv - bf_hi(cv.z)); o.w = cvt_pk_bf16(S[6] * inv - bf_lo(cv.w), S[7] * inv - bf_hi(cv.w));
        *(u32x4*)(dc + (size_t)row * D) = o;
    }
#undef PD_ACC
}

constexpr int AT_TILE = 8192, AT_KOFF = 0, AT_VOFF = 3 * AT_TILE;
constexpr float ATT_THR = 8.0f;
typedef short s16x4 __attribute__((ext_vector_type(4)));
__device__ __forceinline__ float vmax3(float a, float b, float c) { float r; asm("v_max3_f32 %0, %1, %2, %3" : "=v"(r) : "v"(a), "v"(b), "v"(c)); return r; }
__device__ __forceinline__ float xhalf_max(float v) { const u32x2 r = __builtin_amdgcn_permlane32_swap(__float_as_uint(v), __float_as_uint(v), false, false); return vmax3(__uint_as_float(r.x), __uint_as_float(r.y), __uint_as_float(r.y)); }
__device__ __forceinline__ s16x4 lds_tr16(const LAS unsigned char* p) { return __builtin_amdgcn_ds_read_tr16_b64_v4i16((LAS s16x4*)p); }
__device__ __forceinline__ void attn_phase(LAS unsigned char* lds, const bf16_t* Q, const bf16_t* Kg, const bf16_t* Vg, bf16_t* O, const float* sink, int n_units, int G, int wg, int tid) {
    const int wid = __builtin_amdgcn_readfirstlane(tid >> 6), lane = tid & 63, c = lane & 31, hh = lane >> 5;
    const int g = wid >> 1, qhalf = wid & 1;
    const int srow = wid * 8 + (lane >> 3), spos = lane & 7;
    const int skoff = srow * KVD + ((spos ^ ((srow >> 1) & 7)) * 8), svoff = srow * KVD + ((spos ^ (((srow >> 1) & 1) << 2)) * 8);
    const int ksw = (c >> 1) & 7;
    const int trq = (lane & 15) >> 2, trp = lane & 3, trblk = (lane >> 4) & 1;
    const int vtr_off = (4 * hh + trq) * 128 + (((2 * trblk + (trp >> 1)) ^ ((trq >> 1) << 2)) * 16) + 8 * (trp & 1);
    for (int unit = wg; unit < n_units; unit += G) {
        int qrow0, crow0, dlo, nband, hk;
        if (unit < 1024) { const int b = unit >> 8, rem = unit & 255, n = rem >> 2; hk = rem & 3; qrow0 = b * SEQ + n * 128; crow0 = ML + b * CTXL; dlo = (n > 0) ? -1 : 0; const int dhi = (n < 63) ? 1 : 0; nband = 2 * (dhi - dlo + 1); }
        else { const int cu = unit - 1024, b = cu >> 3, rem = cu & 7, n = rem >> 2; hk = rem & 3; crow0 = ML + b * CTXL; qrow0 = crow0 + n * 128; dlo = 0; nband = 0; }
        const int NT = nband + 4, head = hk * 4 + g;
        bf16x8 qf[2][4];
#pragma unroll
        for (int qb = 0; qb < 2; ++qb)
#pragma unroll
            for (int ks = 0; ks < 4; ++ks) qf[qb][ks] = *(const bf16x8*)(Q + (size_t)(qrow0 + qhalf * 64 + qb * 32 + c) * D + head * 64 + ks * 16 + hh * 8);
        const float m0 = sink[head] * LOG2E;
        float mrun0 = m0, mrun1 = m0, lrun0 = (hh == 0) ? 1.0f : 0.0f, lrun1 = lrun0;
        f32x16 o00, o01, o10, o11;
#pragma unroll
        for (int r = 0; r < 16; ++r) { o00[r] = 0.f; o01[r] = 0.f; o10[r] = 0.f; o11[r] = 0.f; }
#define AT_KROW(t_) (((t_) < nband) ? (qrow0 + (dlo + ((t_) >> 1)) * 128 + ((t_) & 1) * 64) : (crow0 + ((t_) - nband) * 64))
#define AT_STAGE(t_) do { const int _kr = AT_KROW(t_); const int _b = (t_) % 3; \
        __builtin_amdgcn_global_load_lds((const unsigned*)(Kg + (size_t)_kr * KVD + hk * 64 + skoff), (LAS unsigned*)(lds + AT_KOFF + _b * AT_TILE + wid * 1024), 16, 0, 0); \
        __builtin_amdgcn_global_load_lds((const unsigned*)(Vg + (size_t)_kr * KVD + hk * 64 + svoff), (LAS unsigned*)(lds + AT_VOFF + _b * AT_TILE + wid * 1024), 16, 0, 0); } while (0)
        AT_STAGE(0); AT_STAGE(1);
        asm volatile("" : "+v"(qf[0][0]), "+v"(qf[0][1]), "+v"(qf[0][2]), "+v"(qf[0][3]), "+v"(qf[1][0]), "+v"(qf[1][1]), "+v"(qf[1][2]), "+v"(qf[1][3]));
        asm volatile("s_waitcnt vmcnt(2)" ::: "memory");
        __builtin_amdgcn_s_barrier();
        for (int t = 0; t < NT; ++t) {
            int kp0 = 0; bool masked = false, skip = false;
            if (t < nband) { const int dl = dlo + (t >> 1), th = t & 1; kp0 = dl * 128 + th * 64; masked = (dl != 0); skip = (dl == -1 && th == 0 && qhalf == 1) || (dl == 1 && th == 1 && qhalf == 0); }
            if (t + 2 < NT) AT_STAGE(t + 2);
            const LAS unsigned char* kbuf = lds + AT_KOFF + (t % 3) * AT_TILE; const LAS unsigned char* vbuf = lds + AT_VOFF + (t % 3) * AT_TILE;
            if (!skip) {
                f32x16 s00, s01, s10, s11;
#pragma unroll
                for (int r = 0; r < 16; ++r) { s00[r] = -mrun0; s10[r] = -mrun0; s01[r] = -mrun1; s11[r] = -mrun1; }
#pragma unroll
                for (int ks = 0; ks < 4; ++ks) {
                    const bf16x8 kf0 = *(const LAS bf16x8*)(kbuf + c * 128 + (((2 * ks + hh) ^ ksw) * 16));
                    const bf16x8 kf1 = *(const LAS bf16x8*)(kbuf + (32 + c) * 128 + (((2 * ks + hh) ^ ksw) * 16));
                    s00 = __builtin_amdgcn_mfma_f32_32x32x16_bf16(kf0, qf[0][ks], s00, 0, 0, 0); s01 = __builtin_amdgcn_mfma_f32_32x32x16_bf16(kf0, qf[1][ks], s01, 0, 0, 0);
                    s10 = __builtin_amdgcn_mfma_f32_32x32x16_bf16(kf1, qf[0][ks], s10, 0, 0, 0); s11 = __builtin_amdgcn_mfma_f32_32x32x16_bf16(kf1, qf[1][ks], s11, 0, 0, 0);
                }
                if (masked) {
                    int bs = kp0 + 4 * hh - (qhalf * 64 + c) + 128;
                    asm volatile("; band mask" : "+v"(bs));
#pragma unroll
                    for (int r = 0; r < 16; ++r) { const int kr = (r & 3) + 8 * (r >> 2);
                        if ((unsigned)(bs + kr) > 256u) s00[r] = -1e30f;
                        if ((unsigned)(bs + kr - 32) > 256u) s01[r] = -1e30f;
                        if ((unsigned)(bs + kr + 32) > 256u) s10[r] = -1e30f;
                        if ((unsigned)(bs + kr) > 256u) s11[r] = -1e30f; }
                    asm volatile("" : "+v"(s00), "+v"(s01), "+v"(s10), "+v"(s11));
                }
                float mx0 = s00[0], mx1 = s01[0];
#pragma unroll
                for (int r = 0; r < 16; ++r) { mx0 = vmax3(mx0, s00[r], s10[r]); mx1 = vmax3(mx1, s01[r], s11[r]); }
                mx0 = xhalf_max(mx0); mx1 = xhalf_max(mx1);
                if (__builtin_amdgcn_ballot_w64(vmax3(mx0, mx1, mx1) > ATT_THR) != 0ull) {
                    float d0 = fmaxf(mx0, 0.f), d1 = fmaxf(mx1, 0.f);
                    asm volatile("; rescale" : "+v"(d0), "+v"(d1));
                    const float al0 = fast_exp2(-d0), al1 = fast_exp2(-d1);
                    mrun0 += d0; mrun1 += d1; lrun0 *= al0; lrun1 *= al1;
#pragma unroll
                    for (int r = 0; r < 16; ++r) { s00[r] -= d0; s10[r] -= d0; s01[r] -= d1; s11[r] -= d1; o00[r] *= al0; o10[r] *= al0; o01[r] *= al1; o11[r] *= al1; }
                    asm volatile("" : "+v"(s00), "+v"(s01), "+v"(s10), "+v"(s11));
                }
                float rs0 = 0.f, rs1 = 0.f;
#pragma unroll
                for (int r = 0; r < 16; ++r) { s00[r] = fast_exp2(s00[r]); s10[r] = fast_exp2(s10[r]); s01[r] = fast_exp2(s01[r]); s11[r] = fast_exp2(s11[r]);
                    rs0 += s00[r] + s10[r]; rs1 += s01[r] + s11[r]; }
                lrun0 += rs0; lrun1 += rs1;
                bf16x8 pf[2][2][2];
#pragma unroll
                for (int s2 = 0; s2 < 2; ++s2) {
                    u32x4 w;
                    w.x = cvt_pk_bf16(s00[8 * s2 + 0], s00[8 * s2 + 1]); w.y = cvt_pk_bf16(s00[8 * s2 + 2], s00[8 * s2 + 3]); w.z = cvt_pk_bf16(s00[8 * s2 + 4], s00[8 * s2 + 5]); w.w = cvt_pk_bf16(s00[8 * s2 + 6], s00[8 * s2 + 7]);
                    pf[0][0][s2] = __builtin_bit_cast(bf16x8, w);
                    w.x = cvt_pk_bf16(s01[8 * s2 + 0], s01[8 * s2 + 1]); w.y = cvt_pk_bf16(s01[8 * s2 + 2], s01[8 * s2 + 3]); w.z = cvt_pk_bf16(s01[8 * s2 + 4], s01[8 * s2 + 5]); w.w = cvt_pk_bf16(s01[8 * s2 + 6], s01[8 * s2 + 7]);
                    pf[0][1][s2] = __builtin_bit_cast(bf16x8, w);
                    w.x = cvt_pk_bf16(s10[8 * s2 + 0], s10[8 * s2 + 1]); w.y = cvt_pk_bf16(s10[8 * s2 + 2], s10[8 * s2 + 3]); w.z = cvt_pk_bf16(s10[8 * s2 + 4], s10[8 * s2 + 5]); w.w = cvt_pk_bf16(s10[8 * s2 + 6], s10[8 * s2 + 7]);
                    pf[1][0][s2] = __builtin_bit_cast(bf16x8, w);
                    w.x = cvt_pk_bf16(s11[8 * s2 + 0], s11[8 * s2 + 1]); w.y = cvt_pk_bf16(s11[8 * s2 + 2], s11[8 * s2 + 3]); w.z = cvt_pk_bf16(s11[8 * s2 + 4], s11[8 * s2 + 5]); w.w = cvt_pk_bf16(s11[8 * s2 + 6], s11[8 * s2 + 7]);
                    pf[1][1][s2] = __builtin_bit_cast(bf16x8, w);
                }
#pragma unroll
                for (int kb = 0; kb < 2; ++kb)
#pragma unroll
                    for (int s2 = 0; s2 < 2; ++s2) {
                        const int vo = vtr_off + (32 * kb + 16 * s2) * 128;
                        const s16x4 a0 = lds_tr16(vbuf + vo), a1 = lds_tr16(vbuf + vo + 8 * 128), b0 = lds_tr16(vbuf + (vo ^ 64)), b1 = lds_tr16(vbuf + (vo ^ 64) + 8 * 128);
                        const bf16x8 vf0 = __builtin_shufflevector(a0, a1, 0, 1, 2, 3, 4, 5, 6, 7), vf1 = __builtin_shufflevector(b0, b1, 0, 1, 2, 3, 4, 5, 6, 7);
                        o00 = __builtin_amdgcn_mfma_f32_32x32x16_bf16(vf0, pf[kb][0][s2], o00, 0, 0, 0); o01 = __builtin_amdgcn_mfma_f32_32x32x16_bf16(vf0, pf[kb][1][s2], o01, 0, 0, 0);
                        o10 = __builtin_amdgcn_mfma_f32_32x32x16_bf16(vf1, pf[kb][0][s2], o10, 0, 0, 0); o11 = __builtin_amdgcn_mfma_f32_32x32x16_bf16(vf1, pf[kb][1][s2], o11, 0, 0, 0);
                    }
            }
            if (t + 2 < NT) asm volatile("s_waitcnt vmcnt(2)" ::: "memory"); else asm volatile("s_waitcnt vmcnt(0)" ::: "memory");
            __builtin_amdgcn_s_barrier();
        }
#undef AT_STAGE
#undef AT_KROW
        const float l0 = lrun0 + __shfl_xor(lrun0, 32), l1 = lrun1 + __shfl_xor(lrun1, 32);
        const float i0 = 1.0f / l0, i1 = 1.0f / l1;
        bf16_t* orow0 = O + (size_t)(qrow0 + qhalf * 64 + c) * D + head * 64 + 4 * hh;
        bf16_t* orow1 = orow0 + (size_t)32 * D;
#pragma unroll
        for (int gq = 0; gq < 4; ++gq) {
            u32x2 w;
            w.x = cvt_pk_bf16(o00[4 * gq] * i0, o00[4 * gq + 1] * i0); w.y = cvt_pk_bf16(o00[4 * gq + 2] * i0, o00[4 * gq + 3] * i0); *(u32x2*)(orow0 + 8 * gq) = w;
            w.x = cvt_pk_bf16(o10[4 * gq] * i0, o10[4 * gq + 1] * i0); w.y = cvt_pk_bf16(o10[4 * gq + 2] * i0, o10[4 * gq + 3] * i0); *(u32x2*)(orow0 + 32 + 8 * gq) = w;
            w.x = cvt_pk_bf16(o01[4 * gq] * i1, o01[4 * gq + 1] * i1); w.y = cvt_pk_bf16(o01[4 * gq + 2] * i1, o01[4 * gq + 3] * i1); *(u32x2*)(orow1 + 8 * gq) = w;
            w.x = cvt_pk_bf16(o11[4 * gq] * i1, o11[4 * gq + 1] * i1); w.y = cvt_pk_bf16(o11[4 * gq + 2] * i1, o11[4 * gq + 3] * i1); *(u32x2*)(orow1 + 32 + 8 * gq) = w;
        }
    }
}

__device__ __forceinline__ int opaque_i(int v) { asm volatile("" : "+v"(v)); return v; }
__device__ __forceinline__ int opaque_s(int v) { asm volatile("" : "+s"(v)); return v; }
#if defined(__HIP_DEVICE_COMPILE__)
typedef const __attribute__((address_space(4))) Params* KargPtr;
#define TID() (wave_s * 64 + (int)__builtin_amdgcn_mbcnt_hi(~0u, __builtin_amdgcn_mbcnt_lo(~0u, (unsigned)opaque_i(0))))
#define LOADP() KargPtr kp_ = (KargPtr)__builtin_amdgcn_kernarg_segment_ptr(); asm volatile("" : "+s"(kp_)); const Params p = *kp_; unsigned char* const ws = p.ws; (void)ws
#define B_H   ((bf16_t*)(ws + WS_H))
#define B_Q   ((bf16_t*)(ws + WS_Q))
#define B_K   ((bf16_t*)(ws + WS_K))
#define B_V   ((bf16_t*)(ws + WS_V))
#define B_Y   ((bf16_t*)(ws + WS_Y))
#define B_ACT ((bf16_t*)(ws + WS_ACT))
#define B_XC  ((float*)(ws + WS_XC))
#define GRID_BAR() do { LOADP(); XcdBarrier b_; b_.bar = (unsigned*)(ws + WS_CTL) + CW_BAR; b_.x = xb_xcc_id(); b_.st = (volatile LAS unsigned*)(lds + LDSCTL_OFF); xcd_barrier(b_); } while (0)
template <int LP> __device__ __forceinline__ void layer_pair(LAS unsigned char* lds, const int G, const int wg, const int wave_s) {
    constexpr int lp = LP;
        const int LA = 2 * lp, LB = 2 * lp + 1;
        const int Mrows = (lp == 0) ? MT : ML;
        { LOADP(); pg8::Gemm g{opaque_s(D / 2), opaque_s(D / 2), opaque_s(D / 2)}; pg8::DenseOrder S; S.init(MT / 256, NQKV / 256, G, wg, ws + WS_HQ, ws + WS_WQKV + (size_t)lp * NQKV * D, D / 2, D / 2, 0);
          pg8::EpiQKVQ E{B_Q, B_K, B_V, (const float*)(ws + WS_ROPE), (const float*)(ws + WS_SA), (const float*)(ws + WS_SW) + SWQ_OFF + lp * NQKV};
          pg8::gemm_phase<pg8::EpiQKVQ, pg8::DenseOrder, false, 1>(lds, g, S, E, TID()); }
        GRID_BAR();
        { LOADP(); attn_phase(lds, B_Q, B_K, B_V, B_H, p.sink + lp * 16, (lp == 0) ? 1024 + 32 : 1024, G, wg, TID()); }
        GRID_BAR();
        { LOADP(); pg8::Gemm g{opaque_s(D), opaque_s(D), opaque_s(D)}; pg8::DenseOrder S; S.init(Mrows / 256, D / 256, G, wg, B_H, (const bf16_t*)(ws + WS_WO) + (size_t)lp * D * D, D, D, 0);
          pg8::EpiPlain E{B_Y, D};
          pg8::gemm_phase<pg8::EpiPlain, pg8::DenseOrder, false>(lds, g, S, E, TID()); }
        GRID_BAR();
        { LOADP(); thin_phase<false, false, false, true>(p, lds, G, wg, TID(), Mrows, true, LA, 0, true, LA, 1, lp == 0, false, true, B_Y, B_H, 0); }
        GRID_BAR();
        { LOADP(); pg8::Gemm g{opaque_s(D / 2), opaque_s(D / 2), opaque_s(D / 2)}; pg8::DenseOrder S; S.init(Mrows / 256, 2 * DFF / 256, G, wg, ws + WS_HQ, ws + WS_WFGU + (size_t)lp * 2 * DFF * D, D / 2, D / 2, 0);
          pg8::EpiSwigluQ E{(unsigned char*)(ws + WS_ACT), DFF, (const float*)(ws + WS_SA), (const float*)(ws + WS_SW) + lp * 2 * DFF, 0};
          pg8::gemm_phase<pg8::EpiSwigluQ, pg8::DenseOrder, false, 1>(lds, g, S, E, TID()); }
        GRID_BAR();
        { LOADP(); pg8::Gemm g{opaque_s(DFF / 2), opaque_s(DFF / 2), opaque_s(DFF / 2)}; pg8::DenseOrder S; S.init(Mrows / 256, D / 256, G, wg, ws + WS_ACT, ws + WS_WFDN + (size_t)lp * D * DFF, DFF / 2, DFF / 2, 0);
          pg8::EpiPlainS E{B_Y, D, (const float*)(ws + WS_SDN) + lp * D, 0};
          pg8::gemm_phase<pg8::EpiPlainS, pg8::DenseOrder, false, 2>(lds, g, S, E, TID()); }
        GRID_BAR();
        { LOADP(); thin_phase<false, false, false, false>(p, lds, G, wg, TID(), Mrows, true, LA, 1, true, LB, 0, false, false, true, B_Y, B_H, 0); }
        GRID_BAR();
        { LOADP(); pooldiff_phase(B_H, B_Q, G, wg, TID(), Mrows); }
        GRID_BAR();
        { LOADP(); pg8::Gemm g{opaque_s(D), opaque_s(256), opaque_s(256)}; pg8::DenseOrder S; S.init(Mrows / 256, 4, G, wg, B_Q, (const bf16_t*)(ws + WS_WPOOL) + (size_t)lp * 4 * 256 * 256, D, 256, 512);
          pg8::EpiPool E{B_Y, p.pool_b + lp * D, p.pool_scale + lp * D};
          pg8::gemm_phase<pg8::EpiPool, pg8::DenseOrder, false>(lds, g, S, E, TID()); }
        GRID_BAR();
        { LOADP(); thin_phase<true, false, false, true>(p, lds, G, wg, TID(), Mrows, true, LB, 0, true, LB, 1, false, false, true, B_Y, B_H, lp); }
        GRID_BAR();
        { LOADP(); route_phase(p, lds, G, wg, TID(), Mrows); }
        GRID_BAR();
        { LOADP();
          const int* tab = (const int*)(ws + WS_MOE + MO_TAB);
          pg8::MoeOrder S; S.nM = tab[24]; S.G = G; S.c = wg; S.rowidx = (const int*)(ws + WS_MOE + MO_ROWIDX);
          S.t1 = tab[17]; S.t2 = tab[18]; S.t3 = tab[19]; S.t4 = tab[20]; S.t5 = tab[21]; S.t6 = tab[22]; S.t7 = tab[23];
          S.nN = 2 * DFE / 256; S.nwg = S.nM * S.nN; S.A = (const char*)(ws + WS_HQ); S.B = (const char*)(ws + WS_WMGU + (size_t)lp * NE * 2 * DFE * D); S.tstepA = 256u * D; S.tstepB = 256u * D;
          S.estride = 2u * DFE * D; S.gather = 1;
          pg8::Gemm g{opaque_s(D / 2), opaque_s(D / 2), opaque_s(D / 2)}; pg8::EpiSwigluQ E{(unsigned char*)(ws + WS_ACT), DFE, (const float*)(ws + WS_SAS), (const float*)(ws + WS_SW) + 2 * 2 * DFF + lp * NE * 2 * DFE, 2 * DFE};
          pg8::gemm_phase<pg8::EpiSwigluQ, pg8::MoeOrder, true, 1>(lds, g, S, E, TID()); }
        GRID_BAR();
        { LOADP();
          const int* tab = (const int*)(ws + WS_MOE + MO_TAB);
          pg8::MoeOrder S; S.nM = tab[24]; S.G = G; S.c = wg; S.rowidx = (const int*)(ws + WS_MOE + MO_ROWIDX);
          S.t1 = tab[17]; S.t2 = tab[18]; S.t3 = tab[19]; S.t4 = tab[20]; S.t5 = tab[21]; S.t6 = tab[22]; S.t7 = tab[23];
          S.nN = D / 256; S.nwg = S.nM * S.nN; S.A = (const char*)(ws + WS_ACT); S.B = (const char*)(ws + WS_WMDN + (size_t)lp * NE * D * DFE); S.tstepA = 256u * DFE; S.tstepB = 256u * DFE;
          S.estride = (unsigned)D * DFE; S.gather = 0;
          pg8::Gemm g{opaque_s(DFE / 2), opaque_s(DFE / 2), opaque_s(DFE / 2)}; pg8::EpiPlainS E{B_Y, D, (const float*)(ws + WS_SDN) + (2 + lp * NE) * D, D};
          pg8::gemm_phase<pg8::EpiPlainS, pg8::MoeOrder, false, 2>(lds, g, S, E, TID()); }
        GRID_BAR();
        { LOADP(); thin_phase<false, true, false, true>(p, lds, G, wg, TID(), Mrows, true, LB, 1, lp == 0, LB + 1, 0, false, lp == 1, true, B_Y, B_H, 0); }
        if (lp == 0) GRID_BAR();
    }
#endif
__global__ void __launch_bounds__(512, 2) fwd_kernel(Params p_arg) {
#if defined(__HIP_DEVICE_COMPILE__)
    extern __shared__ __attribute__((aligned(16))) unsigned char lds_raw[];
    LAS unsigned char* lds = (LAS unsigned char*)lds_raw;
    const int G = gridDim.x, wg = blockIdx.x;
    asm volatile("s_setreg_imm32_b32 hwreg(HW_REG_MODE, 23, 1), 1");
    const int wave_s = __builtin_amdgcn_readfirstlane((int)threadIdx.x >> 6);
    { const int tid = TID();
      for (int u = tid; u < (LDS_BYTES - LDSCTL_OFF) / 4; u += 512) ((LAS unsigned*)(lds + LDSCTL_OFF))[u] = 0u; }
    __syncthreads();
    { LOADP(); (void)xcd_barrier_post((unsigned*)(ws + WS_CTL) + CW_BAR, (volatile LAS unsigned*)(lds + LDSCTL_OFF)); }

    { LOADP(); prologue(p, lds, G, wg, TID()); }
    GRID_BAR();
    { LOADP(); thin_phase<false, false, true, true>(p, lds, G, wg, TID(), MT, false, 0, 0, true, 0, 0, true, false, false, nullptr, B_H, 0); }
    { LOADP(); prologue_down_quant(p, G, wg, TID()); }
    GRID_BAR();

    layer_pair<0>(lds, G, wg, wave_s);
    layer_pair<1>(lds, G, wg, wave_s);
#endif
}

extern "C" void kernel_launch(void* const* d_in, const int* in_sizes, int n_in, void* d_out, int out_size, void* d_ws, size_t ws_size, hipStream_t stream) {
    static int grid = 0;
    if (grid == 0) {
        if (n_in != 19 || out_size != ML * D || ws_size < WS_END) { fprintf(stderr, "kernel_launch: unexpected problem (n_in %d, out %d, ws %zu < %zu)\n", n_in, out_size, ws_size, (size_t)WS_END); grid = -1; return; }
        int dev = 0, cus = 0, per_cu = 0;
        if (hipGetDevice(&dev) != hipSuccess || hipDeviceGetAttribute(&cus, hipDeviceAttributeMultiprocessorCount, dev) != hipSuccess) { grid = -1; return; }
        if (hipFuncSetAttribute((const void*)fwd_kernel, hipFuncAttributeMaxDynamicSharedMemorySize, LDS_BYTES) != hipSuccess) { fprintf(stderr, "kernel_launch: hipFuncSetAttribute failed\n"); grid = -1; return; }
        if (hipOccupancyMaxActiveBlocksPerMultiprocessor(&per_cu, (const void*)fwd_kernel, 512, LDS_BYTES) != hipSuccess || per_cu < 1) fprintf(stderr, "kernel_launch: occupancy query reports %d\n", per_cu);
        (void)hipGetLastError();
        grid = cus;
        if (grid > 1024) grid = 1024;
    }
    if (grid < 0) return;
    (void)in_sizes;
    (void)hipMemsetAsync((char*)d_ws + WS_CTL, 0, CTL_ZERO_BYTES, stream);
    Params p{};
    p.x = (const float*)d_in[0]; p.c = (const float*)d_in[1]; p.ctx = (const float*)d_in[2]; p.c_ctx = (const float*)d_in[3]; p.ada_w = (const float*)d_in[4]; p.ada_b = (const float*)d_in[5];
    p.norm_g = (const float*)d_in[6]; p.w_qkv = (const float*)d_in[7]; p.w_o = (const float*)d_in[8]; p.sink = (const float*)d_in[9]; p.pool_w = (const float*)d_in[10]; p.pool_b = (const float*)d_in[11];
    p.pool_scale = (const float*)d_in[12]; p.ffn_gu = (const float*)d_in[13]; p.ffn_dn = (const float*)d_in[14]; p.router_w = (const float*)d_in[15]; p.router_b = (const float*)d_in[16];
    p.moe_gu = (const float*)d_in[17]; p.moe_dn = (const float*)d_in[18];
    p.out = (float*)d_out; p.ws = (unsigned char*)d_ws;
    hipLaunchKernelGGL(fwd_kernel, dim3(grid), dim3(512), LDS_BYTES, stream, p);
}
```

```cpp
#include <hip/hip_runtime.h>
#include <cstdio>

#define GAS __attribute__((address_space(1)))
#define LAS __attribute__((address_space(3)))
typedef unsigned short bf16_t;
typedef short bf16x8 __attribute__((ext_vector_type(8)));
typedef float f32x4 __attribute__((ext_vector_type(4)));
typedef float f32x16 __attribute__((ext_vector_type(16)));
typedef unsigned u32x4 __attribute__((ext_vector_type(4)));
typedef unsigned u32x2 __attribute__((ext_vector_type(2)));
typedef int i32x4 __attribute__((ext_vector_type(4)));
typedef int i32x2 __attribute__((ext_vector_type(2)));
typedef int i32x8 __attribute__((ext_vector_type(8)));
template <bool I8> struct AccSel { typedef f32x4 T; };
template <> struct AccSel<true> { typedef i32x4 T; };

constexpr int D = 1024, NBATCH = 4, SEQ = 8192, CTXL = 256;
constexpr int ML = NBATCH * SEQ;
constexpr int MC = NBATCH * CTXL;
constexpr int MT = ML + MC;
constexpr int NQKV = 1536, KVD = 256;
constexpr int DFF = 2816, NE = 8, DFE = 3584;
constexpr int SLOTS = 69632;
constexpr int SWQ_OFF = 2 * 2 * 2816 + 16 * 2 * 3584;
constexpr int KP = 8;
constexpr float LOG2E = 1.4426950408889634f;
constexpr float NORM_EPS = 1e-6f;

constexpr size_t MiB = 1u << 20;
constexpr size_t WS_CTL = 0, CTL_ZERO_BYTES = 1 * MiB;
constexpr size_t WS_MODP = 1 * MiB;
constexpr size_t WS_ROPE = 5 * MiB;
constexpr size_t WS_MOD = 5 * MiB + 65536;
constexpr size_t WS_MOE = 6 * MiB;
constexpr size_t WS_XC = 8 * MiB;
constexpr size_t WS_WQKV = 12 * MiB;
constexpr size_t WS_WO = 18 * MiB;
constexpr size_t WS_WPOOL = 22 * MiB;
constexpr size_t WS_WFGU = 23 * MiB;
constexpr size_t WS_WFDN = 45 * MiB;
constexpr size_t WS_WMGU = 56 * MiB;
constexpr size_t WS_WMDN = 280 * MiB;
constexpr size_t WS_H = 392 * MiB;
constexpr size_t WS_Q = 458 * MiB;
constexpr size_t WS_K = 524 * MiB;
constexpr size_t WS_V = 541 * MiB;
constexpr size_t WS_Y = 558 * MiB;
constexpr size_t WS_ACT = 694 * MiB;
constexpr size_t WS_SA = 1170 * MiB;
constexpr size_t WS_SAS = 1170 * MiB + 512 * 1024;
constexpr size_t WS_SDN = 1170 * MiB + 800 * 1024;
constexpr size_t CTL_COLMAX = 128 * 1024;
constexpr size_t WS_XB = 1204 * MiB;
constexpr size_t WS_HQ = 1171 * MiB;
constexpr size_t WS_SW = 7 * MiB + 512 * 1024;
constexpr size_t WS_END = 1270 * MiB;
constexpr size_t MO_INFO = 0;
constexpr size_t MO_SLOT = 640 * 1024;
constexpr size_t MO_ROWIDX = 1024 * 1024;
constexpr size_t MO_WGCNT = 1024 * 1024 + 320 * 1024;
constexpr size_t MO_TAB = 1024 * 1024 + 384 * 1024;
constexpr int CW_BAR = 4096;
constexpr int CW_QITEM = 16384;

constexpr int RING_BYTES = 131072;
constexpr int LDSCTL_OFF = RING_BYTES;
constexpr int EPI_SCR_OFF = LDSCTL_OFF + 256;
constexpr int IDX_SCR_OFF = EPI_SCR_OFF + 4096;
constexpr int LDS_BYTES = 147456;

__device__ __forceinline__ unsigned cvt_pk_bf16(float lo, float hi) { unsigned r; asm("v_cvt_pk_bf16_f32 %0, %1, %2" : "=v"(r) : "v"(lo), "v"(hi)); return r; }
__device__ __forceinline__ float bf_lo(unsigned w) { return __uint_as_float(w << 16); }
__device__ __forceinline__ float bf_hi(unsigned w) { return __uint_as_float(w & 0xffff0000u); }
template <int CTRL> __device__ __forceinline__ float dpp_f(float v) { return __int_as_float(__builtin_amdgcn_update_dpp(0, __float_as_int(v), CTRL, 0xf, 0xf, true)); }
__device__ __forceinline__ float wave_sum(float v) {
    v += dpp_f<0x121>(v); v += dpp_f<0x122>(v); v += dpp_f<0x124>(v); v += dpp_f<0x128>(v);
    { const u32x2 r = __builtin_amdgcn_permlane16_swap(__float_as_uint(v), __float_as_uint(v), false, false); v = __uint_as_float(r.x) + __uint_as_float(r.y); }
    { const u32x2 r = __builtin_amdgcn_permlane32_swap(__float_as_uint(v), __float_as_uint(v), false, false); v = __uint_as_float(r.x) + __uint_as_float(r.y); }
    return v;
}
__device__ __forceinline__ float wave_max(float v) {
    v = fmaxf(v, dpp_f<0x121>(v)); v = fmaxf(v, dpp_f<0x122>(v)); v = fmaxf(v, dpp_f<0x124>(v)); v = fmaxf(v, dpp_f<0x128>(v));
    { const u32x2 r = __builtin_amdgcn_permlane16_swap(__float_as_uint(v), __float_as_uint(v), false, false); v = fmaxf(__uint_as_float(r.x), __uint_as_float(r.y)); }
    { const u32x2 r = __builtin_amdgcn_permlane32_swap(__float_as_uint(v), __float_as_uint(v), false, false); v = fmaxf(__uint_as_float(r.x), __uint_as_float(r.y)); }
    return v;
}
__device__ __forceinline__ float fast_exp2(float x) { return __builtin_amdgcn_exp2f(x); }
__device__ __forceinline__ float fast_rcp(float x) { return __builtin_amdgcn_rcpf(x); }
__device__ __forceinline__ float clamp448(float x) { return __builtin_amdgcn_fmed3f(x, -448.0f, 448.0f); }
__device__ __forceinline__ unsigned pk4_fp8(float a, float b, float c, float d) {
    unsigned w = 0u; w = (unsigned)__builtin_amdgcn_cvt_pk_fp8_f32(clamp448(a), clamp448(b), (int)w, false); w = (unsigned)__builtin_amdgcn_cvt_pk_fp8_f32(clamp448(c), clamp448(d), (int)w, true); return w; }

__device__ __forceinline__ unsigned pk4_fp8_sat(float a, float b, float c, float d) {
    unsigned w = 0u; w = (unsigned)__builtin_amdgcn_cvt_pk_fp8_f32(a, b, (int)w, false); w = (unsigned)__builtin_amdgcn_cvt_pk_fp8_f32(c, d, (int)w, true); return w; }
#define XB_TMO      128
#define XB_XCNT(j)  (256  + 64 * (j))
#define XB_XSUB(j)  (1280 + 64 * (j))
#define XB_XGEN(j)  (2304 + 64 * (j))
#define XB_FLAG     3328
#define XCD_BAR_WORDS 3456
#define XB_SPIN_CAP (1u << 18)
__device__ __forceinline__ unsigned xb_ld(unsigned* p)              { return __hip_atomic_load(p, __ATOMIC_RELAXED, __HIP_MEMORY_SCOPE_AGENT); }
__device__ __forceinline__ unsigned xb_add(unsigned* p, unsigned v) { return __hip_atomic_fetch_add(p, v, __ATOMIC_RELAXED, __HIP_MEMORY_SCOPE_AGENT); }
__device__ __forceinline__ unsigned xb_xcc_id() { return (unsigned)__builtin_amdgcn_s_getreg((3 << 11) | 20) & 0xFu; }
#define XB_SPIN(cond, bar) do { unsigned _sp = 0; while (cond) { __builtin_amdgcn_s_sleep(1); \
    if ((++_sp & 255u) == 0u) { if (xb_ld(&(bar)[XB_TMO])) break; if (_sp > XB_SPIN_CAP) { atomicAdd(&(bar)[XB_TMO], 1u); break; } } } } while (0)
struct XcdBarrier { unsigned* bar; unsigned x; volatile LAS unsigned* st; };
__device__ __forceinline__ XcdBarrier xcd_barrier_post(unsigned* bar, volatile LAS unsigned* st) {
    XcdBarrier b; b.bar = bar; b.x = xb_xcc_id(); b.st = st;
    if (threadIdx.x == 0) (void)xb_add(&bar[XB_XCNT(b.x)], 1u);
    return b;
}
__device__ __forceinline__ void xcd_barrier_complete(unsigned* bar, unsigned x, unsigned& nloc, unsigned& mask) {
    const unsigned G = gridDim.x * gridDim.y * gridDim.z;
    unsigned sum, msk, mine, sp = 0u;
    for (;;) {
        sum = 0u; msk = 0u; mine = 0u;
#pragma unroll
        for (unsigned j = 0; j < 16; ++j) { const unsigned c = xb_ld(&bar[XB_XCNT(j)]); sum += c; msk |= (c > 0u) ? (1u << j) : 0u; mine = (j == x) ? c : mine; }
        if (sum == G) break;
        __builtin_amdgcn_s_sleep(1);
        if ((++sp & 255u) == 0u) { if (xb_ld(&bar[XB_TMO])) break; if (sp > XB_SPIN_CAP) { atomicAdd(&bar[XB_TMO], 1u); break; } }
    }
    nloc = mine > 0u ? mine : 1u; mask = msk;
}
__device__ __forceinline__ u32x4 xb_ld4(const unsigned* p) { u32x4 v; asm volatile("global_load_dwordx4 %0, %1, off sc1\n\ts_waitcnt vmcnt(0)" : "=v"(v) : "v"(p) : "memory"); return v; }
__device__ __forceinline__ void xcd_barrier(const XcdBarrier& b) {
    asm volatile("s_waitcnt vmcnt(0)" ::: "memory");
    __syncthreads();
    if (threadIdx.x == 0) {
        unsigned* bar = b.bar;
        __builtin_amdgcn_s_waitcnt(0);
        unsigned nloc = b.st[0], mask = b.st[1];
        if (nloc == 0u) { xcd_barrier_complete(bar, b.x, nloc, mask); b.st[0] = nloc; b.st[1] = mask; }
        const unsigned old = xb_add(&bar[XB_XSUB(b.x)], 1u);
        const unsigned gen = old / nloc, tgt = gen + 1u;
        if (old + 1u == tgt * nloc) {
            __builtin_amdgcn_fence(__ATOMIC_RELEASE, "agent");
            asm volatile("s_waitcnt vmcnt(0)" ::: "memory");
            __hip_atomic_store(&bar[XB_FLAG + b.x], tgt, __ATOMIC_RELAXED, __HIP_MEMORY_SCOPE_AGENT);
        }
        unsigned sp = 0u;
        for (;;) {
            unsigned late = 0u;
#pragma unroll
            for (unsigned q = 0; q < 4; ++q) { const u32x4 v = xb_ld4(&bar[XB_FLAG + 4 * q]);
#pragma unroll
                for (unsigned j = 0; j < 4; ++j) late |= ((int)(v[j] - tgt) < 0) ? (1u << (4 * q + j)) : 0u; }
            if ((late & mask) == 0u) break;
            __builtin_amdgcn_s_sleep(1);
            if ((++sp & 255u) == 0u) { if (xb_ld(&bar[XB_TMO])) break; if (sp > XB_SPIN_CAP) { atomicAdd(&bar[XB_TMO], 1u); break; } }
        }
        __builtin_amdgcn_fence(__ATOMIC_ACQUIRE, "agent");
        asm volatile("s_waitcnt vmcnt(0)" ::: "memory");
    }
    __syncthreads();
}

namespace pg8 {
constexpr int BM = 256, BK = 64, HALF = 128, HTB = HALF * BK * 2, STAGE_BYTES = 8 * HTB, NXCD = 8, WGM = 8;
__device__ __forceinline__ int lds_byte(int r, int c) { const int st = (r >> 4) * 2 + (c >> 5), rr = r & 15, cc = c & 31, ob = rr * 64 + cc * 2; return st * 1024 + (ob ^ (((ob >> 9) & 1) << 5)); }
__device__ __forceinline__ void stage_rc(int b, int& R, int& C) { const int st = b / 1024, sb = b % 1024, swz = sb ^ (((sb >> 9) & 1) << 5); R = (st >> 1) * 16 + swz / 64; C = (st & 1) * 32 + (swz % 64) / 2; }
__device__ __forceinline__ int perm32(int rho) { const int n = rho >> 4, i = rho & 15; return 8 * (i >> 2) + 4 * n + (i & 3); }

struct Unit { int pm, pn, e, r0, nai; const char* a; const char* b; };
__device__ __forceinline__ f32x4 mma16(bf16x8 a, bf16x8 b, f32x4 c) { return __builtin_amdgcn_mfma_f32_16x16x32_bf16(a, b, c, 0, 0, 0); }
struct Frag16 { bf16x8 k[2]; };
struct Frag32 { i32x8 v; };
template <int MODE> struct FragSel { typedef Frag16 T; };
template <> struct FragSel<2> { typedef Frag32 T; };
__device__ __forceinline__ void load_frag(Frag16& f, const LAS unsigned char* p) { f.k[0] = *(const LAS bf16x8*)p; f.k[1] = *(const LAS bf16x8*)(p + 1024); }
__device__ __forceinline__ void load_frag(Frag32& f, const LAS unsigned char* p) { const i32x4 lo = *(const LAS i32x4*)p, hi = *(const LAS i32x4*)(p + 1024); f.v = __builtin_shufflevector(lo, hi, 0, 1, 2, 3, 4, 5, 6, 7); }
__device__ __forceinline__ f32x4 mma_frag(const Frag32& a, const Frag32& b, f32x4 c) {
    asm("v_mfma_f32_16x16x128_f8f6f4 %0, %1, %2, %0" : "+v"(c) : "v"(a.v), "v"(b.v));
    return c; }
__device__ __forceinline__ i32x4 mma16(bf16x8 a, bf16x8 b, i32x4 c) { return __builtin_amdgcn_mfma_i32_16x16x64_i8(__builtin_bit_cast(i32x4, a), __builtin_bit_cast(i32x4, b), c, 0, 0, 0); }
__device__ __forceinline__ f32x4 mma_frag_z(const Frag32& a, const Frag32& b, f32x4) {
    f32x4 c;
    asm("v_mfma_f32_16x16x128_f8f6f4 %0, %1, %2, 0" : "=&v"(c) : "v"(a.v), "v"(b.v));
    return c; }
__device__ __forceinline__ f32x4 mma_frag_z(const Frag16& a, const Frag16& b, f32x4) { const f32x4 c = mma16(a.k[0], b.k[0], (f32x4){0.f, 0.f, 0.f, 0.f}); return mma16(a.k[1], b.k[1], c); }
__device__ __forceinline__ i32x4 mma_frag_z(const Frag16& a, const Frag16& b, i32x4) { i32x4 c; asm("v_mfma_i32_16x16x64_i8 %0, %1, %2, 0" : "=&v"(c) : "v"(a.k[0]), "v"(b.k[0])); return mma16(a.k[1], b.k[1], c); }
__device__ __forceinline__ f32x4 mma_frag(const Frag16& a, const Frag16& b, f32x4 c) { c = mma16(a.k[0], b.k[0], c); return mma16(a.k[1], b.k[1], c); }
__device__ __forceinline__ i32x4 mma_frag(const Frag16& a, const Frag16& b, i32x4 c) { c = mma16(a.k[0], b.k[0], c); return mma16(a.k[1], b.k[1], c); }
struct Gemm { int lda, ldb, K; };

template <class Epi, class Sched, bool GATHER, int MODE = 0>
__device__ __forceinline__ void gemm_phase(LAS unsigned char* lds, const Gemm g, const Sched& S, const Epi& E, int tid) {
    const int wid = __builtin_amdgcn_readfirstlane(tid >> 6), lane = tid & 63, wr = wid >> 2, wc = wid & 3, fr = lane & 15, fq = lane >> 4;
    const int K = g.K, nt = K / BK;
    LAS unsigned char* const lds_ctl = lds;
    int R0, C0; stage_rc(tid * 16, R0, C0);
    const int Rb0 = (R0 & ~31) + perm32(R0 & 31);
    const unsigned voffA = (unsigned)(R0 * g.lda + C0) * 2u, voffB = (unsigned)(Rb0 * g.ldb + C0) * 2u;
    const unsigned dA64 = (unsigned)(64 * g.lda) * 2u, dB64 = (unsigned)(64 * g.ldb) * 2u;
    const size_t kstep = (size_t)(BK * 2);
    const size_t hstepA = (size_t)HALF * g.lda * 2, hstepB = (size_t)HALF * g.ldb * 2;
    const unsigned ldsw = (unsigned)wid * 1024u;
    const int aoff = lds_byte(wr * 64 + fr, fq * 8), boff = lds_byte(wc * 32 + fr, fq * 8);
    unsigned vo[4];
#define PG8_SA(b, h) (((b) * 2 + (h)) * HTB)
#define PG8_SB(b, h) ((4 + (b) * 2 + (h)) * HTB)
    const __amdgpu_buffer_rsrc_t rsA = __builtin_amdgcn_make_buffer_rsrc((void*)S.A, 0, -1, 0x00020000), rsB = __builtin_amdgcn_make_buffer_rsrc((void*)S.B, 0, -1, 0x00020000);
#define PG8_STAGE2(bufoff, rs_, base_, gbase, v0_, v1_, d1_) do { const unsigned so_ = (unsigned)((const char*)(gbase) - (const char*)(base_)); \
        __builtin_amdgcn_raw_ptr_buffer_load_lds(rs_, (LAS void*)(lds + (bufoff) + ldsw), 16, (int)(v0_), (int)so_, 0, 0); \
        __builtin_amdgcn_raw_ptr_buffer_load_lds(rs_, (LAS void*)(lds + (bufoff) + ldsw + 8192), 16, (int)(v1_), (int)(so_ + (unsigned)(d1_)), 0, 0); } while (0)
#define PG8_STAGE(bufoff, gbase, voff) PG8_STAGE2(bufoff, rsB, S.B, gbase, voffB, voffB, dB64)
#define PG8_STGA(bufoff, ptr, h, nx) do { if constexpr (GATHER) { PG8_STAGE2(bufoff, rsA, S.A, ptr, vo[2 * (h)], vo[2 * (h) + 1], 0u); } \
        else { PG8_STAGE2(bufoff, rsA, S.A, (ptr) + (h) * hstepA, voffA, voffA, dA64); } } while (0)
#define PG8_LDA(dst, b, h) do { _Pragma("unroll") for (int m = 0; m < 4; ++m) load_frag(dst[m], lds + PG8_SA(b, h) + aoff + m * 2048); } while (0)
#define PG8_LDB(dst, b, h) do { _Pragma("unroll") for (int n = 0; n < 2; ++n) load_frag(dst[n], lds + PG8_SB(b, h) + boff + n * 2048); } while (0)
#define PG8_MMA(ai, bj, At, Bt) do { __builtin_amdgcn_s_setprio(1); _Pragma("unroll") for (int m = 0; m < 4; ++m) _Pragma("unroll") for (int n = 0; n < 2; ++n) \
        acc[ai][bj][m][n] = mma_frag(Bt[n], At[m], acc[ai][bj][m][n]); __builtin_amdgcn_s_setprio(0); } while (0)
#define PG8_MMAZ(ai, bj, At, Bt) do { __builtin_amdgcn_s_setprio(1); _Pragma("unroll") for (int m = 0; m < 4; ++m) _Pragma("unroll") for (int n = 0; n < 2; ++n) \
        acc[ai][bj][m][n] = mma_frag_z(Bt[n], At[m], acc[ai][bj][m][n]); __builtin_amdgcn_s_setprio(0); } while (0)
#define PG8_WAIT_V(n) asm volatile("s_waitcnt vmcnt(" #n ")" ::: "memory")
#define PG8_WAIT_L(n) asm volatile("s_waitcnt lgkmcnt(" #n ")" ::: "memory")
#define PG8_BAR __builtin_amdgcn_s_barrier()
#define PG8_SCHED __builtin_amdgcn_sched_barrier(0)
    Unit cur, nxt; int ui = 0;
    if (!S.next(0, cur)) return;
#define PG8_PREF(u_, ui_) do { if constexpr (Epi::PREF) { const float* _pp = E.pref_ptr(u_, wid, lane); \
        if (_pp) __builtin_amdgcn_global_load_lds((const unsigned*)_pp, (LAS unsigned*)(lds_ctl + EPI_SCR_OFF + ((ui_) & 1) * 2048 + wid * 256), 4, 0, 0); } } while (0)
    PG8_PREF(cur, 0);
    if constexpr (GATHER) {
#pragma unroll
        for (int h = 0; h < 2; ++h) { vo[2 * h] = ((unsigned)S.row(cur, h * HALF + R0) * (unsigned)g.lda + (unsigned)C0) * 2u; vo[2 * h + 1] = ((unsigned)S.row(cur, h * HALF + R0 + 64) * (unsigned)g.lda + (unsigned)C0) * 2u; }
    }
    typedef typename AccSel<MODE == 1>::T AccT;
    AccT acc[2][2][4][2];
#define PG8_ZERO() do { if constexpr (false) { _Pragma("unroll") for (int a = 0; a < 2; ++a) _Pragma("unroll") for (int b = 0; b < 2; ++b) _Pragma("unroll") for (int m = 0; m < 4; ++m) _Pragma("unroll") for (int n = 0; n < 2; ++n) acc[a][b][m][n] = (AccT){0, 0, 0, 0}; } } while (0)
    PG8_ZERO();
    typedef typename FragSel<MODE>::T FragT;
    FragT At[4], B0[2], B1[2];
    const char* cA = cur.a; const char* cB = cur.b;
    PG8_STAGE(PG8_SB(0, 0), cB, voffB); PG8_STAGE(PG8_SB(0, 1), cB + hstepB, voffB); PG8_STGA(PG8_SA(0, 0), cA, 0, false); PG8_STGA(PG8_SA(0, 1), cA, 1, false);
    if (wr == 1) PG8_BAR;
    PG8_WAIT_V(2); PG8_BAR;
    PG8_STAGE(PG8_SB(1, 0), cB + kstep, voffB); PG8_STGA(PG8_SA(1, 0), cA + kstep, 0, false); PG8_STAGE(PG8_SB(1, 1), cB + hstepB + kstep, voffB);
    PG8_WAIT_V(6); PG8_BAR;
    for (;;) {
        const bool has_next = S.next(ui + 1, nxt);
        if constexpr (GATHER) {
            if (has_next) { if (wid < 4) __builtin_amdgcn_global_load_lds((const unsigned*)S.row_ptr(nxt, wid * 64 + lane), (LAS unsigned*)(lds_ctl + IDX_SCR_OFF + ((ui + 1) & 1) * 1024 + wid * 256), 4, 0, 0); }
        }
        const char* nA = has_next ? nxt.a : cA; const char* nB = has_next ? nxt.b : cB;
        for (int t = 0; t < nt; t += 2) {
            const bool last = (t == nt - 2);
            const char* a1 = cA + (size_t)(t + 1) * kstep;
            const char* a2 = last ? nA : cA + (size_t)(t + 2) * kstep; const char* b2 = last ? nB : cB + (size_t)(t + 2) * kstep;
            const char* a3 = a2 + kstep; const char* b3 = b2 + kstep;
            PG8_LDB(B0, 0, 0); PG8_LDB(B1, 0, 1); PG8_SCHED; PG8_LDA(At, 0, 0); PG8_STGA(PG8_SA(1, 1), a1, 1, false);
            if constexpr (GATHER) { if (last && has_next) {
                const LAS unsigned* it_ = (const LAS unsigned*)(lds_ctl + IDX_SCR_OFF + ((ui + 1) & 1) * 1024);
#pragma unroll
                for (int h = 0; h < 2; ++h) { vo[2 * h] = (it_[h * HALF + R0] * (unsigned)g.lda + (unsigned)C0) * 2u; vo[2 * h + 1] = (it_[h * HALF + R0 + 64] * (unsigned)g.lda + (unsigned)C0) * 2u; } } }
            PG8_WAIT_V(8); PG8_WAIT_L(0); PG8_BAR; if (t == 0) { PG8_MMAZ(0, 0, At, B0); PG8_MMAZ(0, 1, At, B1); } else { PG8_MMA(0, 0, At, B0); PG8_MMA(0, 1, At, B1); } PG8_BAR; PG8_SCHED;
            PG8_LDA(At, 0, 1); PG8_STAGE(PG8_SB(0, 0), b2, voffB); PG8_STAGE(PG8_SB(0, 1), b2 + hstepB, voffB); PG8_STGA(PG8_SA(0, 0), a2, 0, last);
            PG8_WAIT_V(8); PG8_WAIT_L(0); PG8_BAR; if (GATHER || cur.nai == 2) { if (t == 0) { PG8_MMAZ(1, 0, At, B0); PG8_MMAZ(1, 1, At, B1); } else { PG8_MMA(1, 0, At, B0); PG8_MMA(1, 1, At, B1); } } PG8_BAR; PG8_SCHED;
            PG8_LDB(B0, 1, 0); PG8_LDB(B1, 1, 1); PG8_SCHED; PG8_LDA(At, 1, 0); PG8_STGA(PG8_SA(0, 1), a2, 1, last);
            PG8_WAIT_V(8); PG8_WAIT_L(0); PG8_BAR; PG8_MMA(0, 0, At, B0); PG8_MMA(0, 1, At, B1); PG8_BAR; PG8_SCHED;
            PG8_LDA(At, 1, 1); PG8_STAGE(PG8_SB(1, 0), b3, voffB); PG8_STAGE(PG8_SB(1, 1), b3 + hstepB, voffB); PG8_STGA(PG8_SA(1, 0), a3, 0, last);
            PG8_WAIT_V(8); PG8_WAIT_L(0); PG8_BAR; if (GATHER || cur.nai == 2) { PG8_MMA(1, 0, At, B0); PG8_MMA(1, 1, At, B1); } PG8_BAR; PG8_SCHED;
        }
        if (wr == 0) PG8_BAR;
        if constexpr (MODE == 2) asm volatile("s_nop 15\n\ts_nop 7" ::: "memory");
        if constexpr (Epi::PREF) E(acc, cur, wr, wc, fr, fq, (const LAS float*)(lds_ctl + EPI_SCR_OFF + (ui & 1) * 2048));
        else E(acc, cur, wr, wc, fr, fq);
        if (!has_next) break;
        PG8_ZERO();
        cur = nxt; cA = nA; cB = nB; ++ui;
        PG8_PREF(cur, ui);
        if (wr == 1) PG8_BAR;
    }
    PG8_WAIT_V(0);
    PG8_BAR;
#undef PG8_PREF
#undef PG8_SA
#undef PG8_SB
#undef PG8_STAGE
#undef PG8_STAGE2
#undef PG8_STGA
#undef PG8_LDA
#undef PG8_LDB
#undef PG8_MMA
#undef PG8_MMAZ
#undef PG8_ZERO
#undef PG8_WAIT_V
#undef PG8_WAIT_L
#undef PG8_BAR
#undef PG8_SCHED
}

struct DenseOrder {
    int nM, nN, nwg, G, c; const char* A; const char* B; unsigned tstepA, tstepB, acolstep;
    __device__ __forceinline__ void init(int nM_, int nN_, int G_, int c_, const void* A_, const void* B_, int lda, int ldb, size_t acolstep_) {
        nM = nM_; nN = nN_; nwg = nM * nN; G = G_; c = c_; A = (const char*)A_; B = (const char*)B_; tstepA = (unsigned)(BM * lda * 2); tstepB = (unsigned)(BM * ldb * 2); acolstep = (unsigned)acolstep_; }
    __device__ __forceinline__ bool next(int i, Unit& u) const {
        const int nfull = (nwg / G) * G, R = nwg - nfull; const bool hs = R > 0 && 2 * R <= G;
        const long L = (long)i * G + c; if (L >= (hs ? nfull + 2 * R : nwg)) return false;
        int wgid = (int)L, sub = 0; u.nai = 2;
        if (hs && wgid >= nfull) { const int j = wgid - nfull; wgid = nfull + (j >> 1); sub = j & 1; u.nai = 1; }
        { const int q = nwg / NXCD, r = nwg % NXCD, xcd = wgid % NXCD, off = wgid / NXCD; wgid = (xcd < r ? xcd * (q + 1) : r * (q + 1) + (xcd - r) * q) + off; }
        const int nig = WGM * nN, gid = wgid / nig, fm = gid * WGM, gsz = (nM - fm) < WGM ? (nM - fm) : WGM;
        u.pm = fm + ((wgid % nig) % gsz); u.pn = (wgid % nig) / gsz; u.r0 = u.pm * BM + sub * HALF;
        u.e = 0; u.a = A + (size_t)u.pm * tstepA + (size_t)sub * (tstepA >> 1) + (size_t)u.pn * acolstep; u.b = B + (size_t)u.pn * tstepB; return true;
    }
    __device__ __forceinline__ int row(const Unit&, int) const { return 0; }
    __device__ __forceinline__ const int* row_ptr(const Unit&, int) const { return nullptr; }
};
struct MoeOrder {
    int nM, nN, nwg, G, c; const char* A; const char* B; unsigned tstepA, tstepB, estride; const int* rowidx; int gather;
    int t1, t2, t3, t4, t5, t6, t7;
    __device__ __forceinline__ bool next(int i, Unit& u) const {
        const int nfull = (nwg / G) * G, R = nwg - nfull; const bool hs = !gather && R > 0 && 2 * R <= G;
        const long L = (long)i * G + c; if (L >= (hs ? nfull + 2 * R : nwg)) return false;
        int wgid = (int)L, sub = 0; u.nai = 2;
        if (hs && wgid >= nfull) { const int j = wgid - nfull; wgid = nfull + (j >> 1); sub = j & 1; u.nai = 1; }
        { const int q = nwg / NXCD, r = nwg % NXCD, xcd = wgid % NXCD, off = wgid / NXCD; wgid = (xcd < r ? xcd * (q + 1) : r * (q + 1) + (xcd - r) * q) + off; }
        const int nig = WGM * nN, gid = wgid / nig, fm = gid * WGM, gsz = (nM - fm) < WGM ? (nM - fm) : WGM;
        u.pm = fm + ((wgid % nig) % gsz); u.pn = (wgid % nig) / gsz; u.r0 = u.pm * BM + sub * HALF;
        const int pm = u.pm;
        const int e = (pm >= t1) + (pm >= t2) + (pm >= t3) + (pm >= t4) + (pm >= t5) + (pm >= t6) + (pm >= t7);
        u.e = e; u.a = gather ? A : A + (size_t)pm * tstepA + (size_t)sub * (tstepA >> 1); u.b = B + (size_t)e * estride + (size_t)u.pn * tstepB; return true;
    }
    __device__ __forceinline__ int row(const Unit& u, int r) const { return rowidx[u.pm * BM + r]; }
    __device__ __forceinline__ const int* row_ptr(const Unit& u, int r) const { return rowidx + u.pm * BM + r; }
};

typedef const f32x4 (&AccRef)[2][2][4][2];
struct EpiPlain {
    static constexpr bool PREF = false;
    bf16_t* O; int ldc;
    __device__ __forceinline__ void operator()(AccRef acc, const Unit& u, int wr, int wc, int fr, int fq) const {
        const int row0 = u.r0 + wr * 64 + fr, col0 = u.pn * BM + wc * 32 + 8 * fq;
#pragma unroll
        for (int ai = 0; ai < 2; ++ai) if (ai < u.nai)
#pragma unroll
            for (int m = 0; m < 4; ++m) { bf16_t* rowp = O + (size_t)(row0 + ai * HALF + m * 16) * ldc + col0;
#pragma unroll
                for (int bj = 0; bj < 2; ++bj) { const f32x4 v0 = acc[ai][bj][m][0], v1 = acc[ai][bj][m][1];
                    u32x4 w; w.x = cvt_pk_bf16(v0[0], v0[1]); w.y = cvt_pk_bf16(v0[2], v0[3]); w.z = cvt_pk_bf16(v1[0], v1[1]); w.w = cvt_pk_bf16(v1[2], v1[3]);
                    *(u32x4*)(rowp + bj * HALF) = w; } }
    }
};
struct EpiPool {
    static constexpr bool PREF = false;
    bf16_t* O; const float* bias; const float* scale;
    __device__ __forceinline__ void operator()(AccRef acc, const Unit& u, int wr, int wc, int fr, int fq) const {
        const int row0 = u.r0 + wr * 64 + fr, col0 = u.pn * BM + wc * 32 + 8 * fq;
#pragma unroll
        for (int bj = 0; bj < 2; ++bj) {
            const f32x4 b0 = *(const f32x4*)(bias + col0 + bj * HALF), b1 = *(const f32x4*)(bias + col0 + bj * HALF + 4);
            const f32x4 s0 = *(const f32x4*)(scale + col0 + bj * HALF), s1 = *(const f32x4*)(scale + col0 + bj * HALF + 4);
#pragma unroll
            for (int ai = 0; ai < 2; ++ai) if (ai < u.nai)
#pragma unroll
                for (int m = 0; m < 4; ++m) { bf16_t* rowp = O + (size_t)(row0 + ai * HALF + m * 16) * D + col0;
                    const f32x4 v0 = (acc[ai][bj][m][0] + b0) * s0, v1 = (acc[ai][bj][m][1] + b1) * s1;
                    u32x4 w; w.x = cvt_pk_bf16(v0[0], v0[1]); w.y = cvt_pk_bf16(v0[2], v0[3]); w.z = cvt_pk_bf16(v1[0], v1[1]); w.w = cvt_pk_bf16(v1[2], v1[3]);
                    *(u32x4*)(rowp + bj * HALF) = w; }
        }
    }
};
struct EpiSwiglu {
    static constexpr bool PREF = false;
    bf16_t* O; int ldc;
    __device__ __forceinline__ void operator()(AccRef acc, const Unit& u, int wr, int wc, int fr, int fq) const {
        const int row0 = u.r0 + wr * 64 + fr, col0 = u.pn * HALF + wc * 32 + 8 * fq;
#pragma unroll
        for (int ai = 0; ai < 2; ++ai) if (ai < u.nai)
#pragma unroll
            for (int m = 0; m < 4; ++m) { bf16_t* rowp = O + (size_t)(row0 + ai * HALF + m * 16) * ldc + col0;
                float o[8];
#pragma unroll
                for (int n = 0; n < 2; ++n)
#pragma unroll
                    for (int j = 0; j < 4; ++j) { const float gv = acc[ai][0][m][n][j], uv = acc[ai][1][m][n][j];
                        o[4 * n + j] = gv * fast_rcp(1.0f + fast_exp2(-gv * LOG2E)) * uv; }
                u32x4 w; w.x = cvt_pk_bf16(o[0], o[1]); w.y = cvt_pk_bf16(o[2], o[3]); w.z = cvt_pk_bf16(o[4], o[5]); w.w = cvt_pk_bf16(o[6], o[7]);
                *(u32x4*)rowp = w; }
    }
};
typedef const i32x4 (&AccRefI)[2][2][4][2];
struct EpiSwigluQ {
    static constexpr bool PREF = true;
    unsigned char* O; int ldc; const float* sa; const float* sw; int swe;
    __device__ __forceinline__ const float* pref_ptr(const Unit& u, int wid, int lane) const {
        return wid < 4 ? sa + (size_t)u.r0 + wid * 64 + lane : sw + (size_t)u.e * swe + u.pn * BM + (wid - 4) * 64 + lane; }
    __device__ __forceinline__ void operator()(AccRefI acc, const Unit& u, int wr, int wc, int fr, int fq, const LAS float* scr) const {
        typedef float f32x2 __attribute__((ext_vector_type(2)));
        const int row0 = u.r0 + wr * 64 + fr, col0 = u.pn * HALF + wc * 32 + 8 * fq;
        const LAS float* swp = scr + 256 + wc * 32 + 8 * fq;
        f32x2 wl[4], wp[4];
#pragma unroll
        for (int q = 0; q < 4; ++q) { const f32x2 g2 = *(const LAS f32x2*)(swp + 2 * q), u2 = *(const LAS f32x2*)(swp + HALF + 2 * q); wl[q] = g2 * (-LOG2E); wp[q] = g2 * u2; }
#pragma unroll
        for (int ai = 0; ai < 2; ++ai) if (ai < u.nai)
#pragma unroll
            for (int m = 0; m < 4; ++m) { const int row = row0 + ai * HALF + m * 16; unsigned char* rowp = O + (size_t)row * ldc + col0;
                const float sr = scr[ai * HALF + wr * 64 + m * 16 + fr], sr2 = sr * sr;
                f32x2 o2[4];
#pragma unroll
                for (int q = 0; q < 4; ++q) { const int n = q >> 1, j = 2 * (q & 1);
                    const f32x2 G2 = {(float)acc[ai][0][m][n][j], (float)acc[ai][0][m][n][j + 1]}, U2 = {(float)acc[ai][1][m][n][j], (float)acc[ai][1][m][n][j + 1]};
                    const f32x2 t2 = (G2 * wl[q]) * sr;
                    f32x2 d2; d2.x = fast_exp2(t2.x); d2.y = fast_exp2(t2.y); d2 = d2 + 1.0f;
                    f32x2 r2; r2.x = fast_rcp(d2.x); r2.y = fast_rcp(d2.y);
                    o2[q] = ((G2 * U2) * wp[q]) * (r2 * sr2); }
                u32x2 w; w.x = pk4_fp8_sat(o2[0].x, o2[0].y, o2[1].x, o2[1].y); w.y = pk4_fp8_sat(o2[2].x, o2[2].y, o2[3].x, o2[3].y);
                *(u32x2*)rowp = w; }
    }
};
struct EpiPlainS {
    static constexpr bool PREF = true;
    bf16_t* O; int ldc; const float* cs; int cse;
    __device__ __forceinline__ const float* pref_ptr(const Unit& u, int wid, int lane) const {
        return wid < 4 ? (const float*)nullptr : cs + (size_t)u.e * cse + u.pn * BM + (wid - 4) * 64 + lane; }
    __device__ __forceinline__ void operator()(AccRef acc, const Unit& u, int wr, int wc, int fr, int fq, const LAS float* scr) const {
        const int row0 = u.r0 + wr * 64 + fr, col0 = u.pn * BM + wc * 32 + 8 * fq;
        const LAS float* cp = scr + 256 + wc * 32 + 8 * fq;
#pragma unroll
        for (int bj = 0; bj < 2; ++bj) {
            const f32x4 s0 = *(const LAS f32x4*)(cp + bj * HALF), s1 = *(const LAS f32x4*)(cp + bj * HALF + 4);
#pragma unroll
            for (int ai = 0; ai < 2; ++ai) if (ai < u.nai)
#pragma unroll
                for (int m = 0; m < 4; ++m) { bf16_t* rowp = O + (size_t)(row0 + ai * HALF + m * 16) * ldc + col0;
                    const f32x4 v0 = acc[ai][bj][m][0] * s0, v1 = acc[ai][bj][m][1] * s1;
                    u32x4 w; w.x = cvt_pk_bf16(v0[0], v0[1]); w.y = cvt_pk_bf16(v0[2], v0[3]); w.z = cvt_pk_bf16(v1[0], v1[1]); w.w = cvt_pk_bf16(v1[2], v1[3]);
                    *(u32x4*)(rowp + bj * HALF) = w; }
        }
    }
};
struct EpiQKVQ {
    static constexpr bool PREF = true;
    bf16_t *Q, *Kb, *V; const float* rope; const float* sa; const float* sw;
    __device__ __forceinline__ const float* pref_ptr(const Unit& u, int wid, int lane) const {
        return wid < 4 ? sa + (size_t)u.r0 + wid * 64 + lane : sw + u.pn * BM + (wid - 4) * 64 + lane; }
    __device__ __forceinline__ void operator()(AccRefI acc, const Unit& u, int wr, int wc, int fr, int fq, const LAS float* scr) const {
        const int row0 = u.r0 + wr * 64 + fr, pn = u.pn;
        bf16_t* base; int ldc, colt;
        if (pn < 4) { base = Q; ldc = D; colt = pn * BM; } else if (pn == 4) { base = Kb; ldc = KVD; colt = 0; } else { base = V; ldc = KVD; colt = 0; }
        const bool rope_on = (pn < 5) && (u.pm < ML / BM);
        const float qs = (pn < 4) ? 0.125f * LOG2E : 1.0f;
        const int axis = wc & 1, col0 = colt + wc * 32 + 8 * fq;
        const LAS float* cp = scr + 256 + wc * 32 + 8 * fq;
        const f32x4 wv[2][2] = {{*(const LAS f32x4*)cp, *(const LAS f32x4*)(cp + 4)}, {*(const LAS f32x4*)(cp + HALF), *(const LAS f32x4*)(cp + HALF + 4)}};
#pragma unroll
        for (int ai = 0; ai < 2; ++ai) if (ai < u.nai) {
            f32x4 c4[4], s4[4];
#pragma unroll
            for (int m = 0; m < 4; ++m) { c4[m] = (f32x4){1.f, 1.f, 1.f, 1.f}; s4[m] = (f32x4){0.f, 0.f, 0.f, 0.f}; }
            if (rope_on) {
#pragma unroll
                for (int m = 0; m < 4; ++m) { const int row = row0 + ai * HALF + m * 16, t = row & (SEQ - 1), pos = axis ? (t & 63) : (t >> 6);
                    c4[m] = *(const f32x4*)(rope + pos * 16 + 4 * fq); s4[m] = *(const f32x4*)(rope + 2048 + pos * 16 + 4 * fq); }
            }
#pragma unroll
            for (int m = 0; m < 4; ++m) { const int row = row0 + ai * HALF + m * 16; bf16_t* rowp = base + (size_t)row * ldc + col0;
                const float sr = scr[ai * HALF + wr * 64 + m * 16 + fr] * qs;
                const f32x4 cc = c4[m] * sr, ss = s4[m] * sr;
#pragma unroll
                for (int bj = 0; bj < 2; ++bj) {
                    const i32x4 a0 = acc[ai][bj][m][0], a1 = acc[ai][bj][m][1];
                    const f32x4 v0 = (f32x4){(float)a0[0], (float)a0[1], (float)a0[2], (float)a0[3]} * wv[bj][0], v1 = (f32x4){(float)a1[0], (float)a1[1], (float)a1[2], (float)a1[3]} * wv[bj][1];
                    u32x4 w;
                    w.x = cvt_pk_bf16(v0[0] * cc[0] - v0[1] * ss[0], v0[1] * cc[0] + v0[0] * ss[0]);
                    w.y = cvt_pk_bf16(v0[2] * cc[1] - v0[3] * ss[1], v0[3] * cc[1] + v0[2] * ss[1]);
                    w.z = cvt_pk_bf16(v1[0] * cc[2] - v1[1] * ss[2], v1[1] * cc[2] + v1[0] * ss[2]);
                    w.w = cvt_pk_bf16(v1[2] * cc[3] - v1[3] * ss[3], v1[3] * cc[3] + v1[2] * ss[3]);
                    *(u32x4*)(rowp + bj * HALF) = w; }
            }
        }
    }
};
struct EpiQKV {
    static constexpr bool PREF = false;
    bf16_t *Q, *Kb, *V; const float* rope;
    __device__ __forceinline__ void operator()(AccRef acc, const Unit& u, int wr, int wc, int fr, int fq) const {
        const int row0 = u.r0 + wr * 64 + fr, pn = u.pn;
        bf16_t* base; int ldc, colt;
        if (pn < 4) { base = Q; ldc = D; colt = pn * BM; } else if (pn == 4) { base = Kb; ldc = KVD; colt = 0; } else { base = V; ldc = KVD; colt = 0; }
        const bool rope_on = (pn < 5) && (u.pm < ML / BM);
        const float qs = (pn < 4) ? 0.125f * LOG2E : 1.0f;
        const int axis = wc & 1, col0 = colt + wc * 32 + 8 * fq;
#pragma unroll
        for (int ai = 0; ai < 2; ++ai) if (ai < u.nai)
#pragma unroll
            for (int m = 0; m < 4; ++m) { const int row = row0 + ai * HALF + m * 16; bf16_t* rowp = base + (size_t)row * ldc + col0;
                f32x4 c4 = (f32x4){1.f, 1.f, 1.f, 1.f}, s4 = (f32x4){0.f, 0.f, 0.f, 0.f};
                if (rope_on) { const int t = row & (SEQ - 1), pos = axis ? (t & 63) : (t >> 6); c4 = *(const f32x4*)(rope + pos * 16 + 4 * fq); s4 = *(const f32x4*)(rope + 2048 + pos * 16 + 4 * fq); }
                c4 *= qs; s4 *= qs;
#pragma unroll
                for (int bj = 0; bj < 2; ++bj) { const f32x4 v0 = acc[ai][bj][m][0], v1 = acc[ai][bj][m][1];
                    u32x4 w;
                    w.x = cvt_pk_bf16(v0[0] * c4[0] - v0[1] * s4[0], v0[1] * c4[0] + v0[0] * s4[0]);
                    w.y = cvt_pk_bf16(v0[2] * c4[1] - v0[3] * s4[1], v0[3] * c4[1] + v0[2] * s4[1]);
                    w.z = cvt_pk_bf16(v1[0] * c4[2] - v1[1] * s4[2], v1[1] * c4[2] + v1[0] * s4[2]);
                    w.w = cvt_pk_bf16(v1[2] * c4[3] - v1[3] * s4[3], v1[3] * c4[3] + v1[2] * s4[3]);
                    *(u32x4*)(rowp + bj * HALF) = w; } }
    }
};
}

struct Params {
    const float *x, *c, *ctx, *c_ctx, *ada_w, *ada_b, *norm_g, *w_qkv, *w_o, *sink, *pool_w, *pool_b, *pool_scale, *ffn_gu, *ffn_dn, *router_w, *router_b, *moe_gu, *moe_dn;
    float* out; unsigned char* ws;
};

__device__ __forceinline__ int src_col(int n, int mode, int F) {
    if (mode == 1) { if (n >= 1280) return n; const int dn = n & 63, i = dn >> 1, s = dn & 1; return (n & ~63) + (i & 15) + 32 * (i >> 4) + 16 * s; }
    if (mode == 2) { const int pn = n >> 8, bj = (n >> 7) & 1, jj = n & 127; return bj * F + 128 * pn + jj; }
    return n;
}
__device__ __forceinline__ void transpose_item(const float* W, int Nsrc, int K, bf16_t* Bt, int item, int nblk, int mode, int F, int lane) {
    const int kb = item / nblk, nb = item % nblk, k0 = kb * 64, n = nb * 64 + lane;
    const float* src = W + (size_t)k0 * Nsrc + src_col(n, mode, F);
    float v[64];
#pragma unroll
    for (int i = 0; i < 64; ++i) v[i] = src[(size_t)i * Nsrc];
    bf16_t* dst = Bt + (size_t)n * K + k0;
#pragma unroll
    for (int j = 0; j < 8; ++j) { u32x4 w; w.x = cvt_pk_bf16(v[8 * j], v[8 * j + 1]); w.y = cvt_pk_bf16(v[8 * j + 2], v[8 * j + 3]); w.z = cvt_pk_bf16(v[8 * j + 4], v[8 * j + 5]); w.w = cvt_pk_bf16(v[8 * j + 6], v[8 * j + 7]);
        *(u32x4*)(dst + 8 * j) = w; }
}
__device__ __forceinline__ void colmax_item(const float* W, unsigned* colmax, int item, int lane, int kb_mid) {
    const int kb = (item >> 4) ? kb_mid : 0, nb = item & 15, n = nb * 64 + lane;
    const float* src = W + (size_t)(kb * 64) * D + n;
    float v[64]; float mx = 0.f;
#pragma unroll
    for (int i = 0; i < 64; ++i) v[i] = src[(size_t)i * D];
#pragma unroll
    for (int i = 0; i < 64; ++i) mx = fmaxf(mx, fabsf(v[i]));
    atomicMax(colmax + n, __float_as_uint(mx));
}
__device__ __forceinline__ void fp8_item(const float* W, int K, unsigned char* Bq, const unsigned* colmax, float* sdn, int item, int lane) {
    const int kb = item >> 4, nb = item & 15, n = nb * 64 + lane;
    const float* src = W + (size_t)(kb * 64) * D + n;
    float v[64];
#pragma unroll
    for (int i = 0; i < 64; ++i) v[i] = src[(size_t)i * D];
    const float cm = __uint_as_float(colmax[n]), sc = cm > 0.f ? 128.0f / cm : 0.f;
    if (kb == 0) sdn[n] = cm * (1.0f / 128.0f);
    unsigned char* dst = Bq + (size_t)n * K + kb * 64;
#pragma unroll
    for (int c = 0; c < 4; ++c) { u32x4 w4;
#pragma unroll
        for (int q = 0; q < 4; ++q) w4[q] = pk4_fp8(v[16 * c + 4 * q] * sc, v[16 * c + 4 * q + 1] * sc, v[16 * c + 4 * q + 2] * sc, v[16 * c + 4 * q + 3] * sc);
        *(u32x4*)(dst + 16 * c) = w4; }
}
__device__ __forceinline__ void quant_item(const float* W, int Nsrc, signed char* Bq, float* sw, int nb, int mode, int F, LAS float* pmax, int wave, int lane) {
    const int n = nb * 64 + lane;
    const float* src = W + (size_t)(wave * 128) * Nsrc + src_col(n, mode, F);
    float v[128]; float mx = 0.f;
#pragma unroll
    for (int i = 0; i < 128; ++i) v[i] = src[(size_t)i * Nsrc];
#pragma unroll
    for (int i = 0; i < 128; ++i) mx = fmaxf(mx, fabsf(v[i]));
    pmax[wave * 64 + lane] = mx;
    __syncthreads();
    float cm = pmax[lane];
#pragma unroll
    for (int w = 1; w < 8; ++w) cm = fmaxf(cm, pmax[w * 64 + lane]);
    const float inv = cm > 0.f ? 127.0f / cm : 0.f;
    if (wave == 0) sw[n] = cm * (1.0f / 127.0f);
    signed char* dst = Bq + (size_t)n * D + wave * 128;
#pragma unroll
    for (int c = 0; c < 8; ++c) { u32x4 w4;
#pragma unroll
        for (int q = 0; q < 4; ++q) { unsigned wd = 0u;
#pragma unroll
            for (int b = 0; b < 4; ++b) { const int qi = (int)__builtin_rintf(v[16 * c + 4 * q + b] * inv); wd |= ((unsigned)qi & 0xffu) << (8 * b); }
            w4[q] = wd; }
        *(u32x4*)(dst + 16 * c) = w4; }
}
__device__ __forceinline__ void prologue(const Params& p, LAS unsigned char* lds, int G, int wg, int tid) {
    const int lane = tid & 63, wave = __builtin_amdgcn_readfirstlane(tid >> 6);
    LAS float* scond = (LAS float*)lds;
    for (int i = tid; i < 5 * D; i += 512) { const int cnd = i >> 10, k = i & 1023; const float v = cnd < 4 ? p.c[cnd * D + k] : p.c_ctx[k]; scond[i] = v / (1.0f + __expf(-v)); }
    __syncthreads();
    const int gw = wg * 8 + wave, NGW = G * 8;
    if (wg == G - 1) {
        float* rope = (float*)(p.ws + WS_ROPE);
        for (int i = tid; i < 2048; i += 512) { const int pos = i >> 4, f = i & 15;
            const int fq4 = f & 3, fd = f >> 2;
            double inv = fq4 == 0 ? 1.0 : (fq4 == 1 ? 0.5623413251903491 : (fq4 == 2 ? 0.31622776601683794 : 0.1778279410038923));
            inv *= fd == 0 ? 1.0 : (fd == 1 ? 0.1 : (fd == 2 ? 0.01 : 0.001));
            const double ang = (double)pos * inv, kq = __builtin_rint(ang * 0.6366197723675814);
            double r = __builtin_fma(-kq, 1.5707963267948966, ang); r = __builtin_fma(-kq, 6.123233995736766e-17, r);
            const double r2 = r * r;
            const double sr = r * (1.0 + r2 * (-1.0 / 6 + r2 * (1.0 / 120 + r2 * (-1.0 / 5040 + r2 * (1.0 / 362880 + r2 * (-1.0 / 39916800 + r2 * (1.0 / 6227020800.0)))))));
            const double cr = 1.0 + r2 * (-0.5 + r2 * (1.0 / 24 + r2 * (-1.0 / 720 + r2 * (1.0 / 40320 + r2 * (-1.0 / 3628800 + r2 * (1.0 / 479001600 + r2 * (-1.0 / 87178291200.0)))))));
            const int qd = (int)kq & 3;
            const double cs = qd == 0 ? cr : (qd == 1 ? -sr : (qd == 2 ? -cr : sr)), sn = qd == 0 ? sr : (qd == 1 ? cr : (qd == 2 ? -sr : -cr));
            rope[i] = (float)cs; rope[2048 + i] = (float)sn; }
    }
    {
        float* modp = (float*)(p.ws + WS_MODP);
        for (int it = gw; it < KP * 4 * 24; it += NGW) {
            const int part = it / 96, rem = it % 96, l = rem / 24, cb = rem % 24, n = cb * 256 + 4 * lane, k0 = part * (D / KP);
            const float* w = p.ada_w + ((size_t)l * D + k0) * 6144 + n;
            f32x4 a0 = {0.f, 0.f, 0.f, 0.f}, a1 = a0, a2 = a0, a3 = a0, a4 = a0;
#pragma unroll 8
            for (int k = 0; k < D / KP; ++k) { const f32x4 wv = *(const f32x4*)(w + (size_t)k * 6144);
                a0 += wv * scond[0 * D + k0 + k]; a1 += wv * scond[1 * D + k0 + k]; a2 += wv * scond[2 * D + k0 + k]; a3 += wv * scond[3 * D + k0 + k]; a4 += wv * scond[4 * D + k0 + k]; }
            float* o = modp + ((size_t)(part * 4 + l) * 5) * 6144 + n;
            *(f32x4*)(o + 0 * 6144) = a0; *(f32x4*)(o + 1 * 6144) = a1; *(f32x4*)(o + 2 * 6144) = a2; *(f32x4*)(o + 3 * 6144) = a3; *(f32x4*)(o + 4 * 6144) = a4;
        }
    }
    {
        LAS float* pmax = (LAS float*)(lds + 32768);
        float* swb = (float*)(p.ws + WS_SW);
        unsigned* qctr = (unsigned*)(p.ws + WS_CTL) + CW_QITEM;
        LAS int* qit = (LAS int*)(lds + 32768 + 8192);
        int nxt_it = 0;
        if (tid == 0) nxt_it = (int)atomicAdd(qctr, 1u);
        int par = 0;
        for (;; par ^= 1) {
            if (tid == 0) *qit = nxt_it;
            __syncthreads();
            const int it = *qit;
            if (it >= 2 * 88 + 16 * 112 + 2 * 24) break;
            if (tid == 0) nxt_it = (int)atomicAdd(qctr, 1u);
            if (it >= 2 * 88 + 16 * 112) { const int r = it - (2 * 88 + 16 * 112), mi = r / 24, nb = r % 24;
                quant_item(p.w_qkv + (size_t)mi * D * NQKV, NQKV, (signed char*)(p.ws + WS_WQKV) + (size_t)mi * NQKV * D, swb + SWQ_OFF + mi * NQKV, nb, 1, 0, pmax + par * 512, wave, lane); continue; }
            if (it < 2 * 88) { const int mi = it / 88, nb = it % 88; quant_item(p.ffn_gu + (size_t)mi * D * 2 * DFF, 2 * DFF, (signed char*)(p.ws + WS_WFGU) + (size_t)mi * 2 * DFF * D, swb + mi * 2 * DFF, nb, 2, DFF, pmax + par * 512, wave, lane); }
            else { const int r = it - 2 * 88, mi = r / 112, nb = r % 112; quant_item(p.moe_gu + (size_t)mi * D * 2 * DFE, 2 * DFE, (signed char*)(p.ws + WS_WMGU) + (size_t)mi * 2 * DFE * D, swb + 2 * 2 * DFF + mi * 2 * DFE, nb, 2, DFE, pmax + par * 512, wave, lane); }
        }
    }
    constexpr int I1 = 2 * 256, I2 = I1 + 8 * 16, I3 = I2 + 2 * 32, I4 = I3 + 16 * 32;
    unsigned* colmax = (unsigned*)(p.ws + WS_CTL + CTL_COLMAX);
    for (int it = gw; it < I4; it += NGW) {
        if (it >= I3) { const int r = it - I3, mi = r / 32, li = r % 32; colmax_item(p.moe_dn + (size_t)mi * DFE * D, colmax + (2 + mi) * D, li, lane, DFE / 128); }
        else if (it >= I2) { const int r = it - I2, mi = r / 32, li = r % 32; colmax_item(p.ffn_dn + (size_t)mi * DFF * D, colmax + mi * D, li, lane, DFF / 128); }
        else if (it >= I1) { const int r = it - I1, mi = r / 16, li = r % 16; transpose_item(p.pool_w + (size_t)mi * 256 * 256, 256, 256, (bf16_t*)(p.ws + WS_WPOOL) + (size_t)mi * 256 * 256, li, 4, 0, 0, lane); }
        else { const int mi = it / 256, li = it % 256; transpose_item(p.w_o + (size_t)mi * D * D, D, D, (bf16_t*)(p.ws + WS_WO) + (size_t)mi * D * D, li, 16, 0, 0, lane); }
    }
}
__device__ __forceinline__ void prologue_down_quant(const Params& p, int G, int wg, int tid) {
    const int lane = tid & 63, wave = __builtin_amdgcn_readfirstlane(tid >> 6), gw = wg * 8 + wave, NGW = G * 8;
    const unsigned* colmax = (const unsigned*)(p.ws + WS_CTL + CTL_COLMAX);
    float* sdn = (float*)(p.ws + WS_SDN);
    constexpr int J0 = 2 * 704, J1 = J0 + 16 * 896;
    for (int it = gw; it < J1; it += NGW) {
        if (it >= J0) { const int r = it - J0, mi = r / 896, li = r % 896; fp8_item(p.moe_dn + (size_t)mi * DFE * D, DFE, (unsigned char*)(p.ws + WS_WMDN) + (size_t)mi * D * DFE, colmax + (2 + mi) * D, sdn + (2 + mi) * D, li, lane); }
        else { const int mi = it / 704, li = it % 704; fp8_item(p.ffn_dn + (size_t)mi * DFF * D, DFF, (unsigned char*)(p.ws + WS_WFDN) + (size_t)mi * D * DFF, colmax + mi * D, sdn + mi * D, li, lane); }
    }
}

template <bool PARTS>
__device__ __forceinline__ f32x4 mod_vec(const float* modp, const float* mod, const float* ada_b, int l, int cond, int chunk, int col) {
    if (!PARTS) return *(const f32x4*)(mod + ((size_t)l * 5 + cond) * 6144 + chunk * D + col);
    f32x4 s = *(const f32x4*)(ada_b + (size_t)l * 6144 + chunk * D + col);
#pragma unroll 2
    for (int pt = 0; pt < KP; ++pt) s += *(const f32x4*)(modp + ((size_t)(pt * 4 + l) * 5 + cond) * 6144 + chunk * D + col);
    return s;
}
template <bool ROUTER, bool MOE_IN, bool PARTS, bool Q8>
__device__ __forceinline__ void thin_phase(const Params& p, LAS unsigned char* lds, int G, int wg, int tid, int M, bool has_post, int lpost, int wpost, bool has_pre, int lpre, int wpre,
                                           bool xin32, bool xout32, bool write_x, const bf16_t* y, bf16_t* hout, int lrouter) {
    const int lane = tid & 63, wave = __builtin_amdgcn_readfirstlane(tid >> 6);
    const float* modp = (const float*)(p.ws + WS_MODP);
    const float* modf = (const float*)(p.ws + WS_MOD);
    if (PARTS) {
        float* mo = (float*)(p.ws + WS_MOD);
        for (int i = wg * 512 + tid; i < 4 * 5 * 6144 / 4; i += G * 512) { const int e = i * 4, l = e / (5 * 6144), r = e % (5 * 6144), cnd = r / 6144, n = r % 6144;
            *(f32x4*)(mo + e) = mod_vec<true>(modp, modf, p.ada_b, l, cnd, n >> 10, n & 1023); }
    }
    LAS float* rw = (LAS float*)lds;
    LAS unsigned* lcnt = (LAS unsigned*)(lds + 32768);
    if (ROUTER) {
        const float* rwg = p.router_w + (size_t)lrouter * D * NE;
        for (int i = tid; i < D * NE; i += 512) { const int k = i >> 3, e = i & 7; rw[e * D + k] = rwg[i]; }
        if (tid < 8) lcnt[tid] = 0u;
        __syncthreads();
    }
    const int RPW = (M + G - 1) / G, r0 = wg * RPW, r1 = (r0 + RPW < M) ? r0 + RPW : M;
    int cur_cond = -1;
    f32x4 pa[4], pb[4], pc[4];
    f32x4 xA[4], xB[4], xC[4]; u32x2 rA[4], rB[4], rC[4], yA[4], yB[4], yC[4], zA[4], zB[4], zC[4];
    bf16_t* const xbs = (bf16_t*)(p.ws + WS_XB); float gA1 = 0.f, gA2 = 0.f, gB1 = 0.f, gB2 = 0.f, gC1 = 0.f, gC2 = 0.f;
#define TH_SLOT(row_, sl_, inf_) do { if (MOE_IN) { sl_ = *(const i32x2*)(p.ws + WS_MOE + MO_SLOT + (size_t)(row_) * 8); inf_ = *(const i32x4*)(p.ws + WS_MOE + MO_INFO + (size_t)(row_) * 16); } } while (0)
#define TH_LOAD(row_, xv_, xr2_, ya_, yb_, g1_, g2_, sl_, inf_) do { \
        if (xin32) { const float* xr_ = (row_) < ML ? p.x + (size_t)(row_) * D : p.ctx + (size_t)((row_) - ML) * D; \
            _Pragma("unroll") for (int j = 0; j < 4; ++j) xv_[j] = *(const f32x4*)(xr_ + 4 * lane + 256 * j); } \
        else { const bf16_t* xr_ = xbs + (size_t)(row_) * D; \
            _Pragma("unroll") for (int j = 0; j < 4; ++j) xr2_[j] = *(const u32x2*)(xr_ + 4 * lane + 256 * j); } \
        if (has_post) { \
            if (MOE_IN) { \
                g1_ = __int_as_float(inf_.z); g2_ = __int_as_float(inf_.w); \
                const bf16_t* y1_ = y + (size_t)sl_.x * D; const bf16_t* y2_ = y + (size_t)sl_.y * D; \
                _Pragma("unroll") for (int j = 0; j < 4; ++j) { ya_[j] = *(const u32x2*)(y1_ + 4 * lane + 256 * j); yb_[j] = *(const u32x2*)(y2_ + 4 * lane + 256 * j); } \
            } else { \
                const bf16_t* yr_ = y + (size_t)(row_) * D; \
                _Pragma("unroll") for (int j = 0; j < 4; ++j) ya_[j] = *(const u32x2*)(yr_ + 4 * lane + 256 * j); \
            } } } while (0)
#define TH_PROC(row_, xv, xr2_, ya_, yb_, g1_, g2_) do { \
        const int row = (row_); \
        if (!xin32) { _Pragma("unroll") for (int j = 0; j < 4; ++j) xv[j] = (f32x4){bf_lo(xr2_[j].x), bf_hi(xr2_[j].x), bf_lo(xr2_[j].y), bf_hi(xr2_[j].y)}; } \
        const int cond = row < ML ? (row >> 13) : 4; \
        if (cond != cur_cond) { \
            cur_cond = cond; \
            _Pragma("unroll") for (int j = 0; j < 4; ++j) { const int col = 4 * lane + 256 * j; \
                if (has_post) { const f32x4 gt = mod_vec<PARTS>(modp, modf, p.ada_b, lpost, cond, wpost ? 5 : 2, col); const f32x4 gp = *(const f32x4*)(p.norm_g + ((size_t)lpost * 4 + (wpost ? 3 : 1)) * D + col); pa[j] = gt * gp; } \
                else pa[j] = (f32x4){0.f, 0.f, 0.f, 0.f}; \
                if (has_pre) { const f32x4 sh = mod_vec<PARTS>(modp, modf, p.ada_b, lpre, cond, wpre ? 3 : 0, col), sc = mod_vec<PARTS>(modp, modf, p.ada_b, lpre, cond, wpre ? 4 : 1, col); \
                    const f32x4 gp = *(const f32x4*)(p.norm_g + ((size_t)lpre * 4 + (wpre ? 2 : 0)) * D + col); pb[j] = gp * (sc + 1.0f); pc[j] = sh; } \
                else { pb[j] = (f32x4){0.f, 0.f, 0.f, 0.f}; pc[j] = pb[j]; } \
            } \
        } \
        if (has_post) { \
            f32x4 yv[4]; \
            if (MOE_IN) { \
                _Pragma("unroll") for (int j = 0; j < 4; ++j) { const u32x2 a = ya_[j], b = yb_[j]; \
                    yv[j] = (f32x4){g1_ * bf_lo(a.x) + g2_ * bf_lo(b.x), g1_ * bf_hi(a.x) + g2_ * bf_hi(b.x), g1_ * bf_lo(a.y) + g2_ * bf_lo(b.y), g1_ * bf_hi(a.y) + g2_ * bf_hi(b.y)}; } \
            } else { \
                _Pragma("unroll") for (int j = 0; j < 4; ++j) { const u32x2 a = ya_[j]; yv[j] = (f32x4){bf_lo(a.x), bf_hi(a.x), bf_lo(a.y), bf_hi(a.y)}; } \
            } \
            float ss = 0.f; \
            _Pragma("unroll") for (int j = 0; j < 4; ++j) ss += (yv[j].x * yv[j].x + yv[j].y * yv[j].y) + (yv[j].z * yv[j].z + yv[j].w * yv[j].w); \
            const float rstd = __builtin_amdgcn_rsqf(wave_sum(ss) * (1.0f / D) + NORM_EPS); \
            _Pragma("unroll") for (int j = 0; j < 4; ++j) xv[j] += pa[j] * (yv[j] * rstd); \
            if (write_x) { \
                if (xout32) { float* xw = p.out + (size_t)row * D; \
                    _Pragma("unroll") for (int j = 0; j < 4; ++j) *(f32x4*)(xw + 4 * lane + 256 * j) = xv[j]; } \
                else { bf16_t* xw = xbs + (size_t)row * D; \
                    _Pragma("unroll") for (int j = 0; j < 4; ++j) { u32x2 w; w.x = cvt_pk_bf16(xv[j].x, xv[j].y); w.y = cvt_pk_bf16(xv[j].z, xv[j].w); *(u32x2*)(xw + 4 * lane + 256 * j) = w; \
                        xv[j] = (f32x4){bf_lo(w.x), bf_hi(w.x), bf_lo(w.y), bf_hi(w.y)}; } }     \
            } \
        } \
        if (has_pre) { \
            float ss = 0.f; \
            _Pragma("unroll") for (int j = 0; j < 4; ++j) ss += (xv[j].x * xv[j].x + xv[j].y * xv[j].y) + (xv[j].z * xv[j].z + xv[j].w * xv[j].w); \
            const float rstd = __builtin_amdgcn_rsqf(wave_sum(ss) * (1.0f / D) + NORM_EPS); \
            f32x4 hv[4]; \
            bf16_t* hr = hout + (size_t)row * D; \
            _Pragma("unroll") for (int j = 0; j < 4; ++j) hv[j] = (xv[j] * rstd) * pb[j] + pc[j]; \
            if (Q8) {     \
                float am = 0.f; \
                _Pragma("unroll") for (int j = 0; j < 4; ++j) am = fmaxf(fmaxf(am, fmaxf(fabsf(hv[j].x), fabsf(hv[j].y))), fmaxf(fabsf(hv[j].z), fabsf(hv[j].w))); \
                am = wave_max(am); \
                const float qi_ = am > 0.f ? 127.0f * fast_rcp(am) : 0.f; \
                signed char* hq_ = (signed char*)(p.ws + WS_HQ) + (size_t)row * D; \
                _Pragma("unroll") for (int j = 0; j < 4; ++j) { \
                    const unsigned wd_ = ((unsigned)(int)__builtin_rintf(hv[j].x * qi_) & 0xffu) | (((unsigned)(int)__builtin_rintf(hv[j].y * qi_) & 0xffu) << 8) | (((unsigned)(int)__builtin_rintf(hv[j].z * qi_) & 0xffu) << 16) | (((unsigned)(int)__builtin_rintf(hv[j].w * qi_) & 0xffu) << 24); \
                    *(unsigned*)(hq_ + 4 * lane + 256 * j) = wd_; } \
                if (lane == 0) ((float*)(p.ws + WS_SA))[row] = am * (1.0f / 127.0f); \
            } else { \
                _Pragma("unroll") for (int j = 0; j < 4; ++j) { u32x2 w; w.x = cvt_pk_bf16(hv[j].x, hv[j].y); w.y = cvt_pk_bf16(hv[j].z, hv[j].w); *(u32x2*)(hr + 4 * lane + 256 * j) = w; } \
            } \
            if (ROUTER) { \
                float lg[8]; \
                _Pragma("unroll") for (int e = 0; e < 8; ++e) { float s_ = 0.f; \
                    _Pragma("unroll") for (int j = 0; j < 4; ++j) { const f32x4 w = *(const LAS f32x4*)(rw + e * D + 4 * lane + 256 * j); s_ += (hv[j].x * w.x + hv[j].y * w.y) + (hv[j].z * w.z + hv[j].w * w.w); } \
                    lg[e] = wave_sum(s_) + p.router_b[lrouter * NE + e]; } \
                int e1 = 0; float v1 = lg[0]; \
                _Pragma("unroll") for (int e = 1; e < 8; ++e) if (lg[e] > v1) { v1 = lg[e]; e1 = e; } \
                int e2 = -1; float v2 = -3.0e38f; \
                _Pragma("unroll") for (int e = 0; e < 8; ++e) if (e != e1 && lg[e] > v2) { v2 = lg[e]; e2 = e; } \
                const float g1 = 1.0f / (1.0f + __expf(v2 - v1)), g2 = 1.0f - g1; \
                if (lane == 0) { \
                    const unsigned p1 = atomicAdd((unsigned*)(lcnt + e1), 1u), p2 = atomicAdd((unsigned*)(lcnt + e2), 1u); \
                    i32x4 inf; inf.x = e1 | (e2 << 8); inf.y = (int)(p1 | (p2 << 16)); inf.z = __float_as_int(g1); inf.w = __float_as_int(g2); \
                    *(i32x4*)(p.ws + WS_MOE + MO_INFO + (size_t)row * 16) = inf; \
                } \
            } \
        } } while (0)
    {
        int rcur = r0 + wave;
        i32x2 slA = {0, 0}, slB = {0, 0}, slC = {0, 0}; i32x4 infA = {0, 0, 0, 0}, infB = {0, 0, 0, 0}, infC = {0, 0, 0, 0};
        if (rcur < r1) {
            TH_SLOT(rcur, slA, infA);
            if (rcur + 8 < r1) TH_SLOT(rcur + 8, slB, infB);
            if (rcur + 16 < r1) TH_SLOT(rcur + 16, slC, infC);
            TH_LOAD(rcur, xA, rA, yA, zA, gA1, gA2, slA, infA);
            if (rcur + 8 < r1) TH_LOAD(rcur + 8, xB, rB, yB, zB, gB1, gB2, slB, infB);
            for (;;) {
                if (rcur + 16 < r1) TH_LOAD(rcur + 16, xC, rC, yC, zC, gC1, gC2, slC, infC);
                if (rcur + 24 < r1) TH_SLOT(rcur + 24, slA, infA);
                TH_PROC(rcur, xA, rA, yA, zA, gA1, gA2);
                rcur += 8; if (rcur >= r1) break;
                if (rcur + 16 < r1) TH_LOAD(rcur + 16, xA, rA, yA, zA, gA1, gA2, slA, infA);
                if (rcur + 24 < r1) TH_SLOT(rcur + 24, slB, infB);
                TH_PROC(rcur, xB, rB, yB, zB, gB1, gB2);
                rcur += 8; if (rcur >= r1) break;
                if (rcur + 16 < r1) TH_LOAD(rcur + 16, xB, rB, yB, zB, gB1, gB2, slB, infB);
                if (rcur + 24 < r1) TH_SLOT(rcur + 24, slC, infC);
                TH_PROC(rcur, xC, rC, yC, zC, gC1, gC2);
                rcur += 8; if (rcur >= r1) break;
            }
        }
    }
#undef TH_LOAD
#undef TH_SLOT
#undef TH_PROC
    if (ROUTER) {
        __syncthreads();
        if (tid < 8) ((int*)(p.ws + WS_MOE + MO_WGCNT))[wg * 8 + tid] = (int)lcnt[tid];
    }
}

__device__ __forceinline__ void route_phase(const Params& p, LAS unsigned char* lds, int G, int wg, int tid, int M) {
    LAS int* cnt = (LAS int*)lds;
    LAS int* tab = (LAS int*)(lds + 32768);
    const int* wgcnt = (const int*)(p.ws + WS_MOE + MO_WGCNT);
    for (int i = tid; i < G * 8; i += 512) cnt[i] = wgcnt[i];
    __syncthreads();
    if (tid < 8) { int tot = 0, pre = 0; for (int w = 0; w < G; ++w) { const int c = cnt[w * 8 + tid]; if (w < wg) pre += c; tot += c; } tab[tid] = pre; tab[8 + tid] = tot; }
    __syncthreads();
    if (tid == 0) { int ts = 0; for (int e = 0; e < 8; ++e) { tab[16 + e] = ts; ts += (tab[8 + e] + 255) >> 8; } tab[24] = ts; }
    __syncthreads();
    int* rowidx = (int*)(p.ws + WS_MOE + MO_ROWIDX);
    const int RPW = (M + G - 1) / G, r0 = wg * RPW, r1 = (r0 + RPW < M) ? r0 + RPW : M;
    for (int row = r0 + tid; row < r1; row += 512) {
        const i32x4 inf = *(const i32x4*)(p.ws + WS_MOE + MO_INFO + (size_t)row * 16);
        const int e1 = inf.x & 255, e2 = (inf.x >> 8) & 255, p1 = inf.y & 0xffff, p2 = (inf.y >> 16) & 0xffff;
        const int s1 = tab[16 + e1] * 256 + tab[e1] + p1, s2 = tab[16 + e2] * 256 + tab[e2] + p2;
        rowidx[s1] = row; rowidx[s2] = row;
        { const float sc = ((const float*)(p.ws + WS_SA))[row]; float* sas = (float*)(p.ws + WS_SAS); sas[s1] = sc; sas[s2] = sc; }
        i32x2 sl; sl.x = s1; sl.y = s2; *(i32x2*)(p.ws + WS_MOE + MO_SLOT + (size_t)row * 8) = sl;
    }
    if (wg < 8) { const int e = wg, s0 = tab[16 + e] * 256 + tab[8 + e], s1 = tab[17 + e] * 256; for (int s = s0 + tid; s < s1; s += 512) { rowidx[s] = 0; ((float*)(p.ws + WS_SAS))[s] = 0.f; } }
    if (wg == 0 && tid < 32) ((int*)(p.ws + WS_MOE + MO_TAB))[tid] = (tid < 25) ? tab[tid] : 0;
    __syncthreads();
}

__device__ __forceinline__ void pooldiff_phase(const bf16_t* h, bf16_t* d, int G, int wg, int tid, int M) {
    const int chunk = tid & 127, seg = tid >> 7, hw = 1 << (chunk >> 5);
    const int RPW = (M + G - 1) / G, r0 = wg * RPW, r1 = (r0 + RPW < M) ? r0 + RPW : M;
    const int nseg = (r1 - r0 + 3) >> 2, ra = r0 + seg * nseg, rb = (ra + nseg < r1) ? ra + nseg : r1;
    const bf16_t* hc = h + chunk * 8; bf16_t* dc = d + chunk * 8;
    float S[8] = {0.f, 0.f, 0.f, 0.f, 0.f, 0.f, 0.f, 0.f};
    bool fresh = true;
#define PD_ACC(sgn_, v_) do { S[0] += sgn_ bf_lo(v_.x); S[1] += sgn_ bf_hi(v_.x); S[2] += sgn_ bf_lo(v_.y); S[3] += sgn_ bf_hi(v_.y); S[4] += sgn_ bf_lo(v_.z); S[5] += sgn_ bf_hi(v_.z); S[6] += sgn_ bf_lo(v_.w); S[7] += sgn_ bf_hi(v_.w); } while (0)
#pragma unroll 2
    for (int row = ra; row < rb; ++row) {
        int base, t, T;
        if (row < ML) { base = row & ~(SEQ - 1); t = row & (SEQ - 1); T = SEQ; } else { base = ML + ((row - ML) & ~(CTXL - 1)); t = (row - ML) & (CTXL - 1); T = CTXL; }
        const int lo = (t - hw) > 0 ? (t - hw) : 0, hi = (t + hw) < T ? (t + hw) : T;
        if (fresh || t == 0) {
            fresh = false;
#pragma unroll
            for (int i = 0; i < 8; ++i) S[i] = 0.f;
            for (int j = lo; j < hi; ++j) { const u32x4 v = *(const u32x4*)(hc + (size_t)(base + j) * D); PD_ACC(+, v); }
        } else {
            if (t + hw - 1 < T) { const u32x4 v = *(const u32x4*)(hc + (size_t)(base + t + hw - 1) * D); PD_ACC(+, v); }
            if (t - hw - 1 >= 0) { const u32x4 v = *(const u32x4*)(hc + (size_t)(base + t - hw - 1) * D); PD_ACC(-, v); }
        }
        const float inv = 1.0f / (float)(hi - lo);
        const u32x4 cv = *(const u32x4*)(hc + (size_t)row * D);
        u32x4 o;
        o.x = cvt_pk_bf16(S[0] * inv - bf_lo(cv.x), S[1] * inv - bf_hi(cv.x)); o.y = cvt_pk_bf16(S[2] * inv - bf_lo(cv.y), S[3] * inv - bf_hi(cv.y));
        o.z = cvt_pk_bf16(S[4] * inv - bf_lo(cv.z), S[5] * inv - bf_hi(cv.z)); o.w = cvt_pk_bf16(S[6] * inv - bf_lo(cv.w), S[7] * inv - bf_hi(cv.w));
        *(u32x4*)(dc + (size_t)row * D) = o;
    }
#undef PD_ACC
}

constexpr int AT_TILE = 8192, AT_KOFF = 0, AT_VOFF = 3 * AT_TILE;
constexpr float ATT_THR = 8.0f;
typedef short s16x4 __attribute__((ext_vector_type(4)));
__device__ __forceinline__ float vmax3(float a, float b, float c) { float r; asm("v_max3_f32 %0, %1, %2, %3" : "=v"(r) : "v"(a), "v"(b), "v"(c)); return r; }
__device__ __forceinline__ float xhalf_max(float v) { const u32x2 r = __builtin_amdgcn_permlane32_swap(__float_as_uint(v), __float_as_uint(v), false, false); return vmax3(__uint_as_float(r.x), __uint_as_float(r.y), __uint_as_float(r.y)); }
__device__ __forceinline__ s16x4 lds_tr16(const LAS unsigned char* p) { return __builtin_amdgcn_ds_read_tr16_b64_v4i16((LAS s16x4*)p); }
__device__ __forceinline__ void attn_phase(LAS unsigned char* lds, const bf16_t* Q, const bf16_t* Kg, const bf16_t* Vg, bf16_t* O, const float* sink, int n_units, int G, int wg, int tid) {
    const int wid = __builtin_amdgcn_readfirstlane(tid >> 6), lane = tid & 63, c = lane & 31, hh = lane >> 5;
    const int g = wid >> 1, qhalf = wid & 1;
    const int srow = wid * 8 + (lane >> 3), spos = lane & 7;
    const int skoff = srow * KVD + ((spos ^ ((srow >> 1) & 7)) * 8), svoff = srow * KVD + ((spos ^ (((srow >> 1) & 1) << 2)) * 8);
    const int ksw = (c >> 1) & 7;
    const int trq = (lane & 15) >> 2, trp = lane & 3, trblk = (lane >> 4) & 1;
    const int vtr_off = (4 * hh + trq) * 128 + (((2 * trblk + (trp >> 1)) ^ ((trq >> 1) << 2)) * 16) + 8 * (trp & 1);
    for (int unit = wg; unit < n_units; unit += G) {
        int qrow0, crow0, dlo, nband, hk;
        if (unit < 1024) { const int b = unit >> 8, rem = unit & 255, n = rem >> 2; hk = rem & 3; qrow0 = b * SEQ + n * 128; crow0 = ML + b * CTXL; dlo = (n > 0) ? -1 : 0; const int dhi = (n < 63) ? 1 : 0; nband = 2 * (dhi - dlo + 1); }
        else { const int cu = unit - 1024, b = cu >> 3, rem = cu & 7, n = rem >> 2; hk = rem & 3; crow0 = ML + b * CTXL; qrow0 = crow0 + n * 128; dlo = 0; nband = 0; }
        const int NT = nband + 4, head = hk * 4 + g;
        bf16x8 qf[2][4];
#pragma unroll
        for (int qb = 0; qb < 2; ++qb)
#pragma unroll
            for (int ks = 0; ks < 4; ++ks) qf[qb][ks] = *(const bf16x8*)(Q + (size_t)(qrow0 + qhalf * 64 + qb * 32 + c) * D + head * 64 + ks * 16 + hh * 8);
        const float m0 = sink[head] * LOG2E;
        float mrun0 = m0, mrun1 = m0, lrun0 = (hh == 0) ? 1.0f : 0.0f, lrun1 = lrun0;
        f32x16 o00, o01, o10, o11;
#pragma unroll
        for (int r = 0; r < 16; ++r) { o00[r] = 0.f; o01[r] = 0.f; o10[r] = 0.f; o11[r] = 0.f; }
#define AT_KROW(t_) (((t_) < nband) ? (qrow0 + (dlo + ((t_) >> 1)) * 128 + ((t_) & 1) * 64) : (crow0 + ((t_) - nband) * 64))
#define AT_STAGE(t_) do { const int _kr = AT_KROW(t_); const int _b = (t_) % 3; \
        __builtin_amdgcn_global_load_lds((const unsigned*)(Kg + (size_t)_kr * KVD + hk * 64 + skoff), (LAS unsigned*)(lds + AT_KOFF + _b * AT_TILE + wid * 1024), 16, 0, 0); \
        __builtin_amdgcn_global_load_lds((const unsigned*)(Vg + (size_t)_kr * KVD + hk * 64 + svoff), (LAS unsigned*)(lds + AT_VOFF + _b * AT_TILE + wid * 1024), 16, 0, 0); } while (0)
        AT_STAGE(0); AT_STAGE(1);
        asm volatile("" : "+v"(qf[0][0]), "+v"(qf[0][1]), "+v"(qf[0][2]), "+v"(qf[0][3]), "+v"(qf[1][0]), "+v"(qf[1][1]), "+v"(qf[1][2]), "+v"(qf[1][3]));
        asm volatile("s_waitcnt vmcnt(2)" ::: "memory");
        __builtin_amdgcn_s_barrier();
        for (int t = 0; t < NT; ++t) {
            int kp0 = 0; bool masked = false, skip = false;
            if (t < nband) { const int dl = dlo + (t >> 1), th = t & 1; kp0 = dl * 128 + th * 64; masked = (dl != 0); skip = (dl == -1 && th == 0 && qhalf == 1) || (dl == 1 && th == 1 && qhalf == 0); }
            if (t + 2 < NT) AT_STAGE(t + 2);
            const LAS unsigned char* kbuf = lds + AT_KOFF + (t % 3) * AT_TILE; const LAS unsigned char* vbuf = lds + AT_VOFF + (t % 3) * AT_TILE;
            if (!skip) {
                f32x16 s00, s01, s10, s11;
#pragma unroll
                for (int r = 0; r < 16; ++r) { s00[r] = -mrun0; s10[r] = -mrun0; s01[r] = -mrun1; s11[r] = -mrun1; }
#pragma unroll
                for (int ks = 0; ks < 4; ++ks) {
                    const bf16x8 kf0 = *(const LAS bf16x8*)(kbuf + c * 128 + (((2 * ks + hh) ^ ksw) * 16));
                    const bf16x8 kf1 = *(const LAS bf16x8*)(kbuf + (32 + c) * 128 + (((2 * ks + hh) ^ ksw) * 16));
                    s00 = __builtin_amdgcn_mfma_f32_32x32x16_bf16(kf0, qf[0][ks], s00, 0, 0, 0); s01 = __builtin_amdgcn_mfma_f32_32x32x16_bf16(kf0, qf[1][ks], s01, 0, 0, 0);
                    s10 = __builtin_amdgcn_mfma_f32_32x32x16_bf16(kf1, qf[0][ks], s10, 0, 0, 0); s11 = __builtin_amdgcn_mfma_f32_32x32x16_bf16(kf1, qf[1][ks], s11, 0, 0, 0);
                }
                if (masked) {
                    int bs = kp0 + 4 * hh - (qhalf * 64 + c) + 128;
                    asm volatile("; band mask" : "+v"(bs));
#pragma unroll
                    for (int r = 0; r < 16; ++r) { const int kr = (r & 3) + 8 * (r >> 2);
                        if ((unsigned)(bs + kr) > 256u) s00[r] = -1e30f;
                        if ((unsigned)(bs + kr - 32) > 256u) s01[r] = -1e30f;
                        if ((unsigned)(bs + kr + 32) > 256u) s10[r] = -1e30f;
                        if ((unsigned)(bs + kr) > 256u) s11[r] = -1e30f; }
                    asm volatile("" : "+v"(s00), "+v"(s01), "+v"(s10), "+v"(s11));
                }
                float mx0 = s00[0], mx1 = s01[0];
#pragma unroll
                for (int r = 0; r < 16; ++r) { mx0 = vmax3(mx0, s00[r], s10[r]); mx1 = vmax3(mx1, s01[r], s11[r]); }
                mx0 = xhalf_max(mx0); mx1 = xhalf_max(mx1);
                if (__builtin_amdgcn_ballot_w64(vmax3(mx0, mx1, mx1) > ATT_THR) != 0ull) {
                    float d0 = fmaxf(mx0, 0.f), d1 = fmaxf(mx1, 0.f);
                    asm volatile("; rescale" : "+v"(d0), "+v"(d1));
                    const float al0 = fast_exp2(-d0), al1 = fast_exp2(-d1);
                    mrun0 += d0; mrun1 += d1; lrun0 *= al0; lrun1 *= al1;
#pragma unroll
                    for (int r = 0; r < 16; ++r) { s00[r] -= d0; s10[r] -= d0; s01[r] -= d1; s11[r] -= d1; o00[r] *= al0; o10[r] *= al0; o01[r] *= al1; o11[r] *= al1; }
                    asm volatile("" : "+v"(s00), "+v"(s01), "+v"(s10), "+v"(s11));
                }
                float rs0 = 0.f, rs1 = 0.f;
#pragma unroll
                for (int r = 0; r < 16; ++r) { s00[r] = fast_exp2(s00[r]); s10[r] = fast_exp2(s10[r]); s01[r] = fast_exp2(s01[r]); s11[r] = fast_exp2(s11[r]);
                    rs0 += s00[r] + s10[r]; rs1 += s01[r] + s11[r]; }
                lrun0 += rs0; lrun1 += rs1;
                bf16x8 pf[2][2][2];
#pragma unroll
                for (int s2 = 0; s2 < 2; ++s2) {
                    u32x4 w;
                    w.x = cvt_pk_bf16(s00[8 * s2 + 0], s00[8 * s2 + 1]); w.y = cvt_pk_bf16(s00[8 * s2 + 2], s00[8 * s2 + 3]); w.z = cvt_pk_bf16(s00[8 * s2 + 4], s00[8 * s2 + 5]); w.w = cvt_pk_bf16(s00[8 * s2 + 6], s00[8 * s2 + 7]);
                    pf[0][0][s2] = __builtin_bit_cast(bf16x8, w);
                    w.x = cvt_pk_bf16(s01[8 * s2 + 0], s01[8 * s2 + 1]); w.y = cvt_pk_bf16(s01[8 * s2 + 2], s01[8 * s2 + 3]); w.z = cvt_pk_bf16(s01[8 * s2 + 4], s01[8 * s2 + 5]); w.w = cvt_pk_bf16(s01[8 * s2 + 6], s01[8 * s2 + 7]);
                    pf[0][1][s2] = __builtin_bit_cast(bf16x8, w);
                    w.x = cvt_pk_bf16(s10[8 * s2 + 0], s10[8 * s2 + 1]); w.y = cvt_pk_bf16(s10[8 * s2 + 2], s10[8 * s2 + 3]); w.z = cvt_pk_bf16(s10[8 * s2 + 4], s10[8 * s2 + 5]); w.w = cvt_pk_bf16(s10[8 * s2 + 6], s10[8 * s2 + 7]);
                    pf[1][0][s2] = __builtin_bit_cast(bf16x8, w);
                    w.x = cvt_pk_bf16(s11[8 * s2 + 0], s11[8 * s2 + 1]); w.y = cvt_pk_bf16(s11[8 * s2 + 2], s11[8 * s2 + 3]); w.z = cvt_pk_bf16(s11[8 * s2 + 4], s11[8 * s2 + 5]); w.w = cvt_pk_bf16(s11[8 * s2 + 6], s11[8 * s2 + 7]);
                    pf[1][1][s2] = __builtin_bit_cast(bf16x8, w);
                }
#pragma unroll
                for (int kb = 0; kb < 2; ++kb)
#pragma unroll
                    for (int s2 = 0; s2 < 2; ++s2) {
                        const int vo = vtr_off + (32 * kb + 16 * s2) * 128;
                        const s16x4 a0 = lds_tr16(vbuf + vo), a1 = lds_tr16(vbuf + vo + 8 * 128), b0 = lds_tr16(vbuf + (vo ^ 64)), b1 = lds_tr16(vbuf + (vo ^ 64) + 8 * 128);
                        const bf16x8 vf0 = __builtin_shufflevector(a0, a1, 0, 1, 2, 3, 4, 5, 6, 7), vf1 = __builtin_shufflevector(b0, b1, 0, 1, 2, 3, 4, 5, 6, 7);
                        o00 = __builtin_amdgcn_mfma_f32_32x32x16_bf16(vf0, pf[kb][0][s2], o00, 0, 0, 0); o01 = __builtin_amdgcn_mfma_f32_32x32x16_bf16(vf0, pf[kb][1][s2], o01, 0, 0, 0);
                        o10 = __builtin_amdgcn_mfma_f32_32x32x16_bf16(vf1, pf[kb][0][s2], o10, 0, 0, 0); o11 = __builtin_amdgcn_mfma_f32_32x32x16_bf16(vf1, pf[kb][1][s2], o11, 0, 0, 0);
                    }
            }
            if (t + 2 < NT) asm volatile("s_waitcnt vmcnt(2)" ::: "memory"); else asm volatile("s_waitcnt vmcnt(0)" ::: "memory");
            __builtin_amdgcn_s_barrier();
        }
#undef AT_STAGE
#undef AT_KROW
        const float l0 = lrun0 + __shfl_xor(lrun0, 32), l1 = lrun1 + __shfl_xor(lrun1, 32);
        const float i0 = 1.0f / l0, i1 = 1.0f / l1;
        bf16_t* orow0 = O + (size_t)(qrow0 + qhalf * 64 + c) * D + head * 64 + 4 * hh;
        bf16_t* orow1 = orow0 + (size_t)32 * D;
#pragma unroll
        for (int gq = 0; gq < 4; ++gq) {
            u32x2 w;
            w.x = cvt_pk_bf16(o00[4 * gq] * i0, o00[4 * gq + 1] * i0); w.y = cvt_pk_bf16(o00[4 * gq + 2] * i0, o00[4 * gq + 3] * i0); *(u32x2*)(orow0 + 8 * gq) = w;
            w.x = cvt_pk_bf16(o10[4 * gq] * i0, o10[4 * gq + 1] * i0); w.y = cvt_pk_bf16(o10[4 * gq + 2] * i0, o10[4 * gq + 3] * i0); *(u32x2*)(orow0 + 32 + 8 * gq) = w;
            w.x = cvt_pk_bf16(o01[4 * gq] * i1, o01[4 * gq + 1] * i1); w.y = cvt_pk_bf16(o01[4 * gq + 2] * i1, o01[4 * gq + 3] * i1); *(u32x2*)(orow1 + 8 * gq) = w;
            w.x = cvt_pk_bf16(o11[4 * gq] * i1, o11[4 * gq + 1] * i1); w.y = cvt_pk_bf16(o11[4 * gq + 2] * i1, o11[4 * gq + 3] * i1); *(u32x2*)(orow1 + 32 + 8 * gq) = w;
        }
    }
}

__device__ __forceinline__ int opaque_i(int v) { asm volatile("" : "+v"(v)); return v; }
__device__ __forceinline__ int opaque_s(int v) { asm volatile("" : "+s"(v)); return v; }
#if defined(__HIP_DEVICE_COMPILE__)
typedef const __attribute__((address_space(4))) Params* KargPtr;
#define TID() (wave_s * 64 + (int)__builtin_amdgcn_mbcnt_hi(~0u, __builtin_amdgcn_mbcnt_lo(~0u, (unsigned)opaque_i(0))))
#define LOADP() KargPtr kp_ = (KargPtr)__builtin_amdgcn_kernarg_segment_ptr(); asm volatile("" : "+s"(kp_)); const Params p = *kp_; unsigned char* const ws = p.ws; (void)ws
#define B_H   ((bf16_t*)(ws + WS_H))
#define B_Q   ((bf16_t*)(ws + WS_Q))
#define B_K   ((bf16_t*)(ws + WS_K))
#define B_V   ((bf16_t*)(ws + WS_V))
#define B_Y   ((bf16_t*)(ws + WS_Y))
#define B_ACT ((bf16_t*)(ws + WS_ACT))
#define B_XC  ((float*)(ws + WS_XC))
#define GRID_BAR() do { LOADP(); XcdBarrier b_; b_.bar = (unsigned*)(ws + WS_CTL) + CW_BAR; b_.x = xb_xcc_id(); b_.st = (volatile LAS unsigned*)(lds + LDSCTL_OFF); xcd_barrier(b_); } while (0)
template <int LP> __device__ __forceinline__ void layer_pair(LAS unsigned char* lds, const int G, const int wg, const int wave_s) {
    constexpr int lp = LP;
        const int LA = 2 * lp, LB = 2 * lp + 1;
        const int Mrows = (lp == 0) ? MT : ML;
        { LOADP(); pg8::Gemm g{opaque_s(D / 2), opaque_s(D / 2), opaque_s(D / 2)}; pg8::DenseOrder S; S.init(MT / 256, NQKV / 256, G, wg, ws + WS_HQ, ws + WS_WQKV + (size_t)lp * NQKV * D, D / 2, D / 2, 0);
          pg8::EpiQKVQ E{B_Q, B_K, B_V, (const float*)(ws + WS_ROPE), (const float*)(ws + WS_SA), (const float*)(ws + WS_SW) + SWQ_OFF + lp * NQKV};
          pg8::gemm_phase<pg8::EpiQKVQ, pg8::DenseOrder, false, 1>(lds, g, S, E, TID()); }
        GRID_BAR();
        { LOADP(); attn_phase(lds, B_Q, B_K, B_V, B_H, p.sink + lp * 16, (lp == 0) ? 1024 + 32 : 1024, G, wg, TID()); }
        GRID_BAR();
        { LOADP(); pg8::Gemm g{opaque_s(D), opaque_s(D), opaque_s(D)}; pg8::DenseOrder S; S.init(Mrows / 256, D / 256, G, wg, B_H, (const bf16_t*)(ws + WS_WO) + (size_t)lp * D * D, D, D, 0);
          pg8::EpiPlain E{B_Y, D};
          pg8::gemm_phase<pg8::EpiPlain, pg8::DenseOrder, false>(lds, g, S, E, TID()); }
        GRID_BAR();
        { LOADP(); thin_phase<false, false, false, true>(p, lds, G, wg, TID(), Mrows, true, LA, 0, true, LA, 1, lp == 0, false, true, B_Y, B_H, 0); }
        GRID_BAR();
        { LOADP(); pg8::Gemm g{opaque_s(D / 2), opaque_s(D / 2), opaque_s(D / 2)}; pg8::DenseOrder S; S.init(Mrows / 256, 2 * DFF / 256, G, wg, ws + WS_HQ, ws + WS_WFGU + (size_t)lp * 2 * DFF * D, D / 2, D / 2, 0);
          pg8::EpiSwigluQ E{(unsigned char*)(ws + WS_ACT), DFF, (const float*)(ws + WS_SA), (const float*)(ws + WS_SW) + lp * 2 * DFF, 0};
          pg8::gemm_phase<pg8::EpiSwigluQ, pg8::DenseOrder, false, 1>(lds, g, S, E, TID()); }
        GRID_BAR();
        { LOADP(); pg8::Gemm g{opaque_s(DFF / 2), opaque_s(DFF / 2), opaque_s(DFF / 2)}; pg8::DenseOrder S; S.init(Mrows / 256, D / 256, G, wg, ws + WS_ACT, ws + WS_WFDN + (size_t)lp * D * DFF, DFF / 2, DFF / 2, 0);
          pg8::EpiPlainS E{B_Y, D, (const float*)(ws + WS_SDN) + lp * D, 0};
          pg8::gemm_phase<pg8::EpiPlainS, pg8::DenseOrder, false, 2>(lds, g, S, E, TID()); }
        GRID_BAR();
        { LOADP(); thin_phase<false, false, false, false>(p, lds, G, wg, TID(), Mrows, true, LA, 1, true, LB, 0, false, false, true, B_Y, B_H, 0); }
        GRID_BAR();
        { LOADP(); pooldiff_phase(B_H, B_Q, G, wg, TID(), Mrows); }
        GRID_BAR();
        { LOADP(); pg8::Gemm g{opaque_s(D), opaque_s(256), opaque_s(256)}; pg8::DenseOrder S; S.init(Mrows / 256, 4, G, wg, B_Q, (const bf16_t*)(ws + WS_WPOOL) + (size_t)lp * 4 * 256 * 256, D, 256, 512);
          pg8::EpiPool E{B_Y, p.pool_b + lp * D, p.pool_scale + lp * D};
          pg8::gemm_phase<pg8::EpiPool, pg8::DenseOrder, false>(lds, g, S, E, TID()); }
        GRID_BAR();
        { LOADP(); thin_phase<true, false, false, true>(p, lds, G, wg, TID(), Mrows, true, LB, 0, true, LB, 1, false, false, true, B_Y, B_H, lp); }
        GRID_BAR();
        { LOADP(); route_phase(p, lds, G, wg, TID(), Mrows); }
        GRID_BAR();
        { LOADP();
          const int* tab = (const int*)(ws + WS_MOE + MO_TAB);
          pg8::MoeOrder S; S.nM = tab[24]; S.G = G; S.c = wg; S.rowidx = (const int*)(ws + WS_MOE + MO_ROWIDX);
          S.t1 = tab[17]; S.t2 = tab[18]; S.t3 = tab[19]; S.t4 = tab[20]; S.t5 = tab[21]; S.t6 = tab[22]; S.t7 = tab[23];
          S.nN = 2 * DFE / 256; S.nwg = S.nM * S.nN; S.A = (const char*)(ws + WS_HQ); S.B = (const char*)(ws + WS_WMGU + (size_t)lp * NE * 2 * DFE * D); S.tstepA = 256u * D; S.tstepB = 256u * D;
          S.estride = 2u * DFE * D; S.gather = 1;
          pg8::Gemm g{opaque_s(D / 2), opaque_s(D / 2), opaque_s(D / 2)}; pg8::EpiSwigluQ E{(unsigned char*)(ws + WS_ACT), DFE, (const float*)(ws + WS_SAS), (const float*)(ws + WS_SW) + 2 * 2 * DFF + lp * NE * 2 * DFE, 2 * DFE};
          pg8::gemm_phase<pg8::EpiSwigluQ, pg8::MoeOrder, true, 1>(lds, g, S, E, TID()); }
        GRID_BAR();
        { LOADP();
          const int* tab = (const int*)(ws + WS_MOE + MO_TAB);
          pg8::MoeOrder S; S.nM = tab[24]; S.G = G; S.c = wg; S.rowidx = (const int*)(ws + WS_MOE + MO_ROWIDX);
          S.t1 = tab[17]; S.t2 = tab[18]; S.t3 = tab[19]; S.t4 = tab[20]; S.t5 = tab[21]; S.t6 = tab[22]; S.t7 = tab[23];
          S.nN = D / 256; S.nwg = S.nM * S.nN; S.A = (const char*)(ws + WS_ACT); S.B = (const char*)(ws + WS_WMDN + (size_t)lp * NE * D * DFE); S.tstepA = 256u * DFE; S.tstepB = 256u * DFE;
          S.estride = (unsigned)D * DFE; S.gather = 0;
          pg8::Gemm g{opaque_s(DFE / 2), opaque_s(DFE / 2), opaque_s(DFE / 2)}; pg8::EpiPlainS E{B_Y, D, (const float*)(ws + WS_SDN) + (2 + lp * NE) * D, D};
          pg8::gemm_phase<pg8::EpiPlainS, pg8::MoeOrder, false, 2>(lds, g, S, E, TID()); }
        GRID_BAR();
        { LOADP(); thin_phase<false, true, false, true>(p, lds, G, wg, TID(), Mrows, true, LB, 1, lp == 0, LB + 1, 0, false, lp == 1, true, B_Y, B_H, 0); }
        if (lp == 0) GRID_BAR();
    }
#endif
__global__ void __launch_bounds__(512, 2) fwd_kernel(Params p_arg) {
#if defined(__HIP_DEVICE_COMPILE__)
    extern __shared__ __attribute__((aligned(16))) unsigned char lds_raw[];
    LAS unsigned char* lds = (LAS unsigned char*)lds_raw;
    const int G = gridDim.x, wg = blockIdx.x;
    asm volatile("s_setreg_imm32_b32 hwreg(HW_REG_MODE, 23, 1), 1");
    const int wave_s = __builtin_amdgcn_readfirstlane((int)threadIdx.x >> 6);
    { const int tid = TID();
      for (int u = tid; u < (LDS_BYTES - LDSCTL_OFF) / 4; u += 512) ((LAS unsigned*)(lds + LDSCTL_OFF))[u] = 0u; }
    __syncthreads();
    { LOADP(); (void)xcd_barrier_post((unsigned*)(ws + WS_CTL) + CW_BAR, (volatile LAS unsigned*)(lds + LDSCTL_OFF)); }

    { LOADP(); prologue(p, lds, G, wg, TID()); }
    GRID_BAR();
    { LOADP(); thin_phase<false, false, true, true>(p, lds, G, wg, TID(), MT, false, 0, 0, true, 0, 0, true, false, false, nullptr, B_H, 0); }
    { LOADP(); prologue_down_quant(p, G, wg, TID()); }
    GRID_BAR();

    layer_pair<0>(lds, G, wg, wave_s);
    layer_pair<1>(lds, G, wg, wave_s);
#endif
}

extern "C" void kernel_launch(void* const* d_in, const int* in_sizes, int n_in, void* d_out, int out_size, void* d_ws, size_t ws_size, hipStream_t stream) {
    static int grid = 0;
    if (grid == 0) {
        if (n_in != 19 || out_size != ML * D || ws_size < WS_END) { fprintf(stderr, "kernel_launch: unexpected problem (n_in %d, out %d, ws %zu < %zu)\n", n_in, out_size, ws_size, (size_t)WS_END); grid = -1; return; }
        int dev = 0, cus = 0, per_cu = 0;
        if (hipGetDevice(&dev) != hipSuccess || hipDeviceGetAttribute(&cus, hipDeviceAttributeMultiprocessorCount, dev) != hipSuccess) { grid = -1; return; }
        if (hipFuncSetAttribute((const void*)fwd_kernel, hipFuncAttributeMaxDynamicSharedMemorySize, LDS_BYTES) != hipSuccess) { fprintf(stderr, "kernel_launch: hipFuncSetAttribute failed\n"); grid = -1; return; }
        if (hipOccupancyMaxActiveBlocksPerMultiprocessor(&per_cu, (const void*)fwd_kernel, 512, LDS_BYTES) != hipSuccess || per_cu < 1) fprintf(stderr, "kernel_launch: occupancy query reports %d\n", per_cu);
        (void)hipGetLastError();
        grid = cus;
        if (grid > 1024) grid = 1024;
    }
    if (grid < 0) return;
    (void)in_sizes;
    (void)hipMemsetAsync((char*)d_ws + WS_CTL, 0, CTL_ZERO_BYTES, stream);
    Params p{};
    p.x = (const float*)d_in[0]; p.c = (const float*)d_in[1]; p.ctx = (const float*)d_in[2]; p.c_ctx = (const float*)d_in[3]; p.ada_w = (const float*)d_in[4]; p.ada_b = (const float*)d_in[5];
    p.norm_g = (const float*)d_in[6]; p.w_qkv = (const float*)d_in[7]; p.w_o = (const float*)d_in[8]; p.sink = (const float*)d_in[9]; p.pool_w = (const float*)d_in[10]; p.pool_b = (const float*)d_in[11];
    p.pool_scale = (const float*)d_in[12]; p.ffn_gu = (const float*)d_in[13]; p.ffn_dn = (const float*)d_in[14]; p.router_w = (const float*)d_in[15]; p.router_b = (const float*)d_in[16];
    p.moe_gu = (const float*)d_in[17]; p.moe_dn = (const float*)d_in[18];
    p.out = (float*)d_out; p.ws = (unsigned char*)d_ws;
    hipLaunchKernelGGL(fwd_kernel, dim3(grid), dim3(512), LDS_BYTES, stream, p);
}
```

```cpp
#include <hip/hip_runtime.h>
#include <cstdio>

#define GAS __attribute__((address_space(1)))
#define LAS __attribute__((address_space(3)))
typedef unsigned short bf16_t;
typedef short bf16x8 __attribute__((ext_vector_type(8)));
typedef float f32x4 __attribute__((ext_vector_type(4)));
typedef float f32x16 __attribute__((ext_vector_type(16)));
typedef unsigned u32x4 __attribute__((ext_vector_type(4)));
typedef unsigned u32x2 __attribute__((ext_vector_type(2)));
typedef int i32x4 __attribute__((ext_vector_type(4)));
typedef int i32x2 __attribute__((ext_vector_type(2)));
typedef int i32x8 __attribute__((ext_vector_type(8)));
template <bool I8> struct AccSel { typedef f32x4 T; };
template <> struct AccSel<true> { typedef i32x4 T; };

constexpr int D = 1024, NBATCH = 4, SEQ = 8192, CTXL = 256;
constexpr int ML = NBATCH * SEQ;
constexpr int MC = NBATCH * CTXL;
constexpr int MT = ML + MC;
constexpr int NQKV = 1536, KVD = 256;
constexpr int DFF = 2816, NE = 8, DFE = 3584;
constexpr int SLOTS = 69632;
constexpr int SWQ_OFF = 2 * 2 * 2816 + 16 * 2 * 3584;
constexpr int KP = 8;
constexpr float LOG2E = 1.4426950408889634f;
constexpr float NORM_EPS = 1e-6f;

constexpr size_t MiB = 1u << 20;
constexpr size_t WS_CTL = 0, CTL_ZERO_BYTES = 1 * MiB;
constexpr size_t WS_MODP = 1 * MiB;
constexpr size_t WS_ROPE = 5 * MiB;
constexpr size_t WS_MOD = 5 * MiB + 65536;
constexpr size_t WS_MOE = 6 * MiB;
constexpr size_t WS_XC = 8 * MiB;
constexpr size_t WS_WQKV = 12 * MiB;
constexpr size_t WS_WO = 18 * MiB;
constexpr size_t WS_WPOOL = 22 * MiB;
constexpr size_t WS_WFGU = 23 * MiB;
constexpr size_t WS_WFDN = 45 * MiB;
constexpr size_t WS_WMGU = 56 * MiB;
constexpr size_t WS_WMDN = 280 * MiB;
constexpr size_t WS_H = 392 * MiB;
constexpr size_t WS_Q = 458 * MiB;
constexpr size_t WS_K = 524 * MiB;
constexpr size_t WS_V = 541 * MiB;
constexpr size_t WS_Y = 558 * MiB;
constexpr size_t WS_ACT = 694 * MiB;
constexpr size_t WS_SA = 1170 * MiB;
constexpr size_t WS_SAS = 1170 * MiB + 512 * 1024;
constexpr size_t WS_SDN = 1170 * MiB + 800 * 1024;
constexpr size_t CTL_COLMAX = 128 * 1024;
constexpr size_t WS_XB = 1204 * MiB;
constexpr size_t WS_HQ = 1171 * MiB;
constexpr size_t WS_SW = 7 * MiB + 512 * 1024;
constexpr size_t WS_END = 1270 * MiB;
constexpr size_t MO_INFO = 0;
constexpr size_t MO_SLOT = 640 * 1024;
constexpr size_t MO_ROWIDX = 1024 * 1024;
constexpr size_t MO_WGCNT = 1024 * 1024 + 320 * 1024;
constexpr size_t MO_TAB = 1024 * 1024 + 384 * 1024;
constexpr int CW_BAR = 4096;
constexpr int CW_QITEM = 16384;

constexpr int RING_BYTES = 131072;
constexpr int LDSCTL_OFF = RING_BYTES;
constexpr int EPI_SCR_OFF = LDSCTL_OFF + 256;
constexpr int IDX_SCR_OFF = EPI_SCR_OFF + 4096;
constexpr int LDS_BYTES = 147456;

__device__ __forceinline__ unsigned cvt_pk_bf16(float lo, float hi) { unsigned r; asm("v_cvt_pk_bf16_f32 %0, %1, %2" : "=v"(r) : "v"(lo), "v"(hi)); return r; }
__device__ __forceinline__ float bf_lo(unsigned w) { return __uint_as_float(w << 16); }
__device__ __forceinline__ float bf_hi(unsigned w) { return __uint_as_float(w & 0xffff0000u); }
template <int CTRL> __device__ __forceinline__ float dpp_f(float v) { return __int_as_float(__builtin_amdgcn_update_dpp(0, __float_as_int(v), CTRL, 0xf, 0xf, true)); }
__device__ __forceinline__ float wave_sum(float v) {
    v += dpp_f<0x121>(v); v += dpp_f<0x122>(v); v += dpp_f<0x124>(v); v += dpp_f<0x128>(v);
    { const u32x2 r = __builtin_amdgcn_permlane16_swap(__float_as_uint(v), __float_as_uint(v), false, false); v = __uint_as_float(r.x) + __uint_as_float(r.y); }
    { const u32x2 r = __builtin_amdgcn_permlane32_swap(__float_as_uint(v), __float_as_uint(v), false, false); v = __uint_as_float(r.x) + __uint_as_float(r.y); }
    return v;
}
__device__ __forceinline__ float wave_max(float v) {
    v = fmaxf(v, dpp_f<0x121>(v)); v = fmaxf(v, dpp_f<0x122>(v)); v = fmaxf(v, dpp_f<0x124>(v)); v = fmaxf(v, dpp_f<0x128>(v));
    { const u32x2 r = __builtin_amdgcn_permlane16_swap(__float_as_uint(v), __float_as_uint(v), false, false); v = fmaxf(__uint_as_float(r.x), __uint_as_float(r.y)); }
    { const u32x2 r = __builtin_amdgcn_permlane32_swap(__float_as_uint(v), __float_as_uint(v), false, false); v = fmaxf(__uint_as_float(r.x), __uint_as_float(r.y)); }
    return v;
}
__device__ __forceinline__ float fast_exp2(float x) { return __builtin_amdgcn_exp2f(x); }
__device__ __forceinline__ float fast_rcp(float x) { return __builtin_amdgcn_rcpf(x); }
__device__ __forceinline__ float clamp448(float x) { return __builtin_amdgcn_fmed3f(x, -448.0f, 448.0f); }
__device__ __forceinline__ unsigned pk4_fp8(float a, float b, float c, float d) {
    unsigned w = 0u; w = (unsigned)__builtin_amdgcn_cvt_pk_fp8_f32(clamp448(a), clamp448(b), (int)w, false); w = (unsigned)__builtin_amdgcn_cvt_pk_fp8_f32(clamp448(c), clamp448(d), (int)w, true); return w; }

__device__ __forceinline__ unsigned pk4_fp8_sat(float a, float b, float c, float d) {
    unsigned w = 0u; w = (unsigned)__builtin_amdgcn_cvt_pk_fp8_f32(a, b, (int)w, false); w = (unsigned)__builtin_amdgcn_cvt_pk_fp8_f32(c, d, (int)w, true); return w; }
#define XB_TMO      128
#define XB_XCNT(j)  (256  + 64 * (j))
#define XB_XSUB(j)  (1280 + 64 * (j))
#define XB_XGEN(j)  (2304 + 64 * (j))
#define XB_FLAG     3328
#define XCD_BAR_WORDS 3456
#define XB_SPIN_CAP (1u << 18)
__device__ __forceinline__ unsigned xb_ld(unsigned* p)              { return __hip_atomic_load(p, __ATOMIC_RELAXED, __HIP_MEMORY_SCOPE_AGENT); }
__device__ __forceinline__ unsigned xb_add(unsigned* p, unsigned v) { return __hip_atomic_fetch_add(p, v, __ATOMIC_RELAXED, __HIP_MEMORY_SCOPE_AGENT); }
__device__ __forceinline__ unsigned xb_xcc_id() { return (unsigned)__builtin_amdgcn_s_getreg((3 << 11) | 20) & 0xFu; }
#define XB_SPIN(cond, bar) do { unsigned _sp = 0; while (cond) { __builtin_amdgcn_s_sleep(1); \
    if ((++_sp & 255u) == 0u) { if (xb_ld(&(bar)[XB_TMO])) break; if (_sp > XB_SPIN_CAP) { atomicAdd(&(bar)[XB_TMO], 1u); break; } } } } while (0)
struct XcdBarrier { unsigned* bar; unsigned x; volatile LAS unsigned* st; };
__device__ __forceinline__ XcdBarrier xcd_barrier_post(unsigned* bar, volatile LAS unsigned* st) {
    XcdBarrier b; b.bar = bar; b.x = xb_xcc_id(); b.st = st;
    if (threadIdx.x == 0) (void)xb_add(&bar[XB_XCNT(b.x)], 1u);
    return b;
}
__device__ __forceinline__ void xcd_barrier_complete(unsigned* bar, unsigned x, unsigned& nloc, unsigned& mask) {
    const unsigned G = gridDim.x * gridDim.y * gridDim.z;
    unsigned sum, msk, mine, sp = 0u;
    for (;;) {
        sum = 0u; msk = 0u; mine = 0u;
#pragma unroll
        for (unsigned j = 0; j < 16; ++j) { const unsigned c = xb_ld(&bar[XB_XCNT(j)]); sum += c; msk |= (c > 0u) ? (1u << j) : 0u; mine = (j == x) ? c : mine; }
        if (sum == G) break;
        __builtin_amdgcn_s_sleep(1);
        if ((++sp & 255u) == 0u) { if (xb_ld(&bar[XB_TMO])) break; if (sp > XB_SPIN_CAP) { atomicAdd(&bar[XB_TMO], 1u); break; } }
    }
    nloc = mine > 0u ? mine : 1u; mask = msk;
}
__device__ __forceinline__ u32x4 xb_ld4(const unsigned* p) { u32x4 v; asm volatile("global_load_dwordx4 %0, %1, off sc1\n\ts_waitcnt vmcnt(0)" : "=v"(v) : "v"(p) : "memory"); return v; }
__device__ __forceinline__ void xcd_barrier(const XcdBarrier& b) {
    asm volatile("s_waitcnt vmcnt(0)" ::: "memory");
    __syncthreads();
    if (threadIdx.x == 0) {
        unsigned* bar = b.bar;
        __builtin_amdgcn_s_waitcnt(0);
        unsigned nloc = b.st[0], mask = b.st[1];
        if (nloc == 0u) { xcd_barrier_complete(bar, b.x, nloc, mask); b.st[0] = nloc; b.st[1] = mask; }
        const unsigned old = xb_add(&bar[XB_XSUB(b.x)], 1u);
        const unsigned gen = old / nloc, tgt = gen + 1u;
        if (old + 1u == tgt * nloc) {
            __builtin_amdgcn_fence(__ATOMIC_RELEASE, "agent");
            asm volatile("s_waitcnt vmcnt(0)" ::: "memory");
            __hip_atomic_store(&bar[XB_FLAG + b.x], tgt, __ATOMIC_RELAXED, __HIP_MEMORY_SCOPE_AGENT);
        }
        unsigned sp = 0u;
        for (;;) {
            unsigned late = 0u;
#pragma unroll
            for (unsigned q = 0; q < 4; ++q) { const u32x4 v = xb_ld4(&bar[XB_FLAG + 4 * q]);
#pragma unroll
                for (unsigned j = 0; j < 4; ++j) late |= ((int)(v[j] - tgt) < 0) ? (1u << (4 * q + j)) : 0u; }
            if ((late & mask) == 0u) break;
            __builtin_amdgcn_s_sleep(1);
            if ((++sp & 255u) == 0u) { if (xb_ld(&bar[XB_TMO])) break; if (sp > XB_SPIN_CAP) { atomicAdd(&bar[XB_TMO], 1u); break; } }
        }
        __builtin_amdgcn_fence(__ATOMIC_ACQUIRE, "agent");
        asm volatile("s_waitcnt vmcnt(0)" ::: "memory");
    }
    __syncthreads();
}

namespace pg8 {
constexpr int BM = 256, BK = 64, HALF = 128, HTB = HALF * BK * 2, STAGE_BYTES = 8 * HTB, NXCD = 8, WGM = 8;
__device__ __forceinline__ int lds_byte(int r, int c) { const int st = (r >> 4) * 2 + (c >> 5), rr = r & 15, cc = c & 31, ob = rr * 64 + cc * 2; return st * 1024 + (ob ^ (((ob >> 9) & 1) << 5)); }
__device__ __forceinline__ void stage_rc(int b, int& R, int& C) { const int st = b / 1024, sb = b % 1024, swz = sb ^ (((sb >> 9) & 1) << 5); R = (st >> 1) * 16 + swz / 64; C = (st & 1) * 32 + (swz % 64) / 2; }
__device__ __forceinline__ int perm32(int rho) { const int n = rho >> 4, i = rho & 15; return 8 * (i >> 2) + 4 * n + (i & 3); }

struct Unit { int pm, pn, e, r0, nai; const char* a; const char* b; };
__device__ __forceinline__ f32x4 mma16(bf16x8 a, bf16x8 b, f32x4 c) { return __builtin_amdgcn_mfma_f32_16x16x32_bf16(a, b, c, 0, 0, 0); }
struct Frag16 { bf16x8 k[2]; };
struct Frag32 { i32x8 v; };
template <int MODE> struct FragSel { typedef Frag16 T; };
template <> struct FragSel<2> { typedef Frag32 T; };
__device__ __forceinline__ void load_frag(Frag16& f, const LAS unsigned char* p) { f.k[0] = *(const LAS bf16x8*)p; f.k[1] = *(const LAS bf16x8*)(p + 1024); }
__device__ __forceinline__ void load_frag(Frag32& f, const LAS unsigned char* p) { const i32x4 lo = *(const LAS i32x4*)p, hi = *(const LAS i32x4*)(p + 1024); f.v = __builtin_shufflevector(lo, hi, 0, 1, 2, 3, 4, 5, 6, 7); }
__device__ __forceinline__ f32x4 mma_frag(const Frag32& a, const Frag32& b, f32x4 c) {
    asm("v_mfma_f32_16x16x128_f8f6f4 %0, %1, %2, %0" : "+v"(c) : "v"(a.v), "v"(b.v));
    return c; }
__device__ __forceinline__ i32x4 mma16(bf16x8 a, bf16x8 b, i32x4 c) { return __builtin_amdgcn_mfma_i32_16x16x64_i8(__builtin_bit_cast(i32x4, a), __builtin_bit_cast(i32x4, b), c, 0, 0, 0); }
__device__ __forceinline__ f32x4 mma_frag_z(const Frag32& a, const Frag32& b, f32x4) {
    f32x4 c;
    asm("v_mfma_f32_16x16x128_f8f6f4 %0, %1, %2, 0" : "=&v"(c) : "v"(a.v), "v"(b.v));
    return c; }
__device__ __forceinline__ f32x4 mma_frag_z(const Frag16& a, const Frag16& b, f32x4) { const f32x4 c = mma16(a.k[0], b.k[0], (f32x4){0.f, 0.f, 0.f, 0.f}); return mma16(a.k[1], b.k[1], c); }
__device__ __forceinline__ i32x4 mma_frag_z(const Frag16& a, const Frag16& b, i32x4) { i32x4 c; asm("v_mfma_i32_16x16x64_i8 %0, %1, %2, 0" : "=&v"(c) : "v"(a.k[0]), "v"(b.k[0])); return mma16(a.k[1], b.k[1], c); }
__device__ __forceinline__ f32x4 mma_frag(const Frag16& a, const Frag16& b, f32x4 c) { c = mma16(a.k[0], b.k[0], c); return mma16(a.k[1], b.k[1], c); }
__device__ __forceinline__ i32x4 mma_frag(const Frag16& a, const Frag16& b, i32x4 c) { c = mma16(a.k[0], b.k[0], c); return mma16(a.k[1], b.k[1], c); }
struct Gemm { int lda, ldb, K; };

template <class Epi, class Sched, bool GATHER, int MODE = 0>
__device__ __forceinline__ void gemm_phase(LAS unsigned char* lds, const Gemm g, const Sched& S, const Epi& E, int tid) {
    const int wid = __builtin_amdgcn_readfirstlane(tid >> 6), lane = tid & 63, wr = wid >> 2, wc = wid & 3, fr = lane & 15, fq = lane >> 4;
    const int K = g.K, nt = K / BK;
    LAS unsigned char* const lds_ctl = lds;
    int R0, C0; stage_rc(tid * 16, R0, C0);
    const int Rb0 = (R0 & ~31) + perm32(R0 & 31);
    const unsigned voffA = (unsigned)(R0 * g.lda + C0) * 2u, voffB = (unsigned)(Rb0 * g.ldb + C0) * 2u;
    const unsigned dA64 = (unsigned)(64 * g.lda) * 2u, dB64 = (unsigned)(64 * g.ldb) * 2u;
    const size_t kstep = (size_t)(BK * 2);
    const size_t hstepA = (size_t)HALF * g.lda * 2, hstepB = (size_t)HALF * g.ldb * 2;
    const unsigned ldsw = (unsigned)wid * 1024u;
    const int aoff = lds_byte(wr * 64 + fr, fq * 8), boff = lds_byte(wc * 32 + fr, fq * 8);
    unsigned vo[4];
#define PG8_SA(b, h) (((b) * 2 + (h)) * HTB)
#define PG8_SB(b, h) ((4 + (b) * 2 + (h)) * HTB)
    const __amdgpu_buffer_rsrc_t rsA = __builtin_amdgcn_make_buffer_rsrc((void*)S.A, 0, -1, 0x00020000), rsB = __builtin_amdgcn_make_buffer_rsrc((void*)S.B, 0, -1, 0x00020000);
#define PG8_STAGE2(bufoff, rs_, base_, gbase, v0_, v1_, d1_) do { const unsigned so_ = (unsigned)((const char*)(gbase) - (const char*)(base_)); \
        __builtin_amdgcn_raw_ptr_buffer_load_lds(rs_, (LAS void*)(lds + (bufoff) + ldsw), 16, (int)(v0_), (int)so_, 0, 0); \
        __builtin_amdgcn_raw_ptr_buffer_load_lds(rs_, (LAS void*)(lds + (bufoff) + ldsw + 8192), 16, (int)(v1_), (int)(so_ + (unsigned)(d1_)), 0, 0); } while (0)
#define PG8_STAGE(bufoff, gbase, voff) PG8_STAGE2(bufoff, rsB, S.B, gbase, voffB, voffB, dB64)
#define PG8_STGA(bufoff, ptr, h, nx) do { if constexpr (GATHER) { PG8_STAGE2(bufoff, rsA, S.A, ptr, vo[2 * (h)], vo[2 * (h) + 1], 0u); } \
        else { PG8_STAGE2(bufoff, rsA, S.A, (ptr) + (h) * hstepA, voffA, voffA, dA64); } } while (0)
#define PG8_LDA(dst, b, h) do { _Pragma("unroll") for (int m = 0; m < 4; ++m) load_frag(dst[m], lds + PG8_SA(b, h) + aoff + m * 2048); } while (0)
#define PG8_LDB(dst, b, h) do { _Pragma("unroll") for (int n = 0; n < 2; ++n) load_frag(dst[n], lds + PG8_SB(b, h) + boff + n * 2048); } while (0)
#define PG8_MMA(ai, bj, At, Bt) do { __builtin_amdgcn_s_setprio(1); _Pragma("unroll") for (int m = 0; m < 4; ++m) _Pragma("unroll") for (int n = 0; n < 2; ++n) \
        acc[ai][bj][m][n] = mma_frag(Bt[n], At[m], acc[ai][bj][m][n]); __builtin_amdgcn_s_setprio(0); } while (0)
#define PG8_MMAZ(ai, bj, At, Bt) do { __builtin_amdgcn_s_setprio(1); _Pragma("unroll") for (int m = 0; m < 4; ++m) _Pragma("unroll") for (int n = 0; n < 2; ++n) \
        acc[ai][bj][m][n] = mma_frag_z(Bt[n], At[m], acc[ai][bj][m][n]); __builtin_amdgcn_s_setprio(0); } while (0)
#define PG8_WAIT_V(n) asm volatile("s_waitcnt vmcnt(" #n ")" ::: "memory")
#define PG8_WAIT_L(n) asm volatile("s_waitcnt lgkmcnt(" #n ")" ::: "memory")
#define PG8_BAR __builtin_amdgcn_s_barrier()
#define PG8_SCHED __builtin_amdgcn_sched_barrier(0)
    Unit cur, nxt; int ui = 0;
    if (!S.next(0, cur)) return;
#define PG8_PREF(u_, ui_) do { if constexpr (Epi::PREF) { const float* _pp = E.pref_ptr(u_, wid, lane); \
        if (_pp) __builtin_amdgcn_global_load_lds((const unsigned*)_pp, (LAS unsigned*)(lds_ctl + EPI_SCR_OFF + ((ui_) & 1) * 2048 + wid * 256), 4, 0, 0); } } while (0)
    PG8_PREF(cur, 0);
    if constexpr (GATHER) {
#pragma unroll
        for (int h = 0; h < 2; ++h) { vo[2 * h] = ((unsigned)S.row(cur, h * HALF + R0) * (unsigned)g.lda + (unsigned)C0) * 2u; vo[2 * h + 1] = ((unsigned)S.row(cur, h * HALF + R0 + 64) * (unsigned)g.lda + (unsigned)C0) * 2u; }
    }
    typedef typename AccSel<MODE == 1>::T AccT;
    AccT acc[2][2][4][2];
#define PG8_ZERO() do { if constexpr (false) { _Pragma("unroll") for (int a = 0; a < 2; ++a) _Pragma("unroll") for (int b = 0; b < 2; ++b) _Pragma("unroll") for (int m = 0; m < 4; ++m) _Pragma("unroll") for (int n = 0; n < 2; ++n) acc[a][b][m][n] = (AccT){0, 0, 0, 0}; } } while (0)
    PG8_ZERO();
    typedef typename FragSel<MODE>::T FragT;
    FragT At[4], B0[2], B1[2];
    const char* cA = cur.a; const char* cB = cur.b;
    PG8_STAGE(PG8_SB(0, 0), cB, voffB); PG8_STAGE(PG8_SB(0, 1), cB + hstepB, voffB); PG8_STGA(PG8_SA(0, 0), cA, 0, false); PG8_STGA(PG8_SA(0, 1), cA, 1, false);
    if (wr == 1) PG8_BAR;
    PG8_WAIT_V(2); PG8_BAR;
    PG8_STAGE(PG8_SB(1, 0), cB + kstep, voffB); PG8_STGA(PG8_SA(1, 0), cA + kstep, 0, false); PG8_STAGE(PG8_SB(1, 1), cB + hstepB + kstep, voffB);
    PG8_WAIT_V(6); PG8_BAR;
    for (;;) {
        const bool has_next = S.next(ui + 1, nxt);
        if constexpr (GATHER) {
            if (has_next) { if (wid < 4) __builtin_amdgcn_global_load_lds((const unsigned*)S.row_ptr(nxt, wid * 64 + lane), (LAS unsigned*)(lds_ctl + IDX_SCR_OFF + ((ui + 1) & 1) * 1024 + wid * 256), 4, 0, 0); }
        }
        const char* nA = has_next ? nxt.a : cA; const char* nB = has_next ? nxt.b : cB;
        for (int t = 0; t < nt; t += 2) {
            const bool last = (t == nt - 2);
            const char* a1 = cA + (size_t)(t + 1) * kstep;
            const char* a2 = last ? nA : cA + (size_t)(t + 2) * kstep; const char* b2 = last ? nB : cB + (size_t)(t + 2) * kstep;
            const char* a3 = a2 + kstep; const char* b3 = b2 + kstep;
            PG8_LDB(B0, 0, 0); PG8_LDB(B1, 0, 1); PG8_SCHED; PG8_LDA(At, 0, 0); PG8_STGA(PG8_SA(1, 1), a1, 1, false);
            if constexpr (GATHER) { if (last && has_next) {
                const LAS unsigned* it_ = (const LAS unsigned*)(lds_ctl + IDX_SCR_OFF + ((ui + 1) & 1) * 1024);
#pragma unroll
                for (int h = 0; h < 2; ++h) { vo[2 * h] = (it_[h * HALF + R0] * (unsigned)g.lda + (unsigned)C0) * 2u; vo[2 * h + 1] = (it_[h * HALF + R0 + 64] * (unsigned)g.lda + (unsigned)C0) * 2u; } } }
            PG8_WAIT_V(8); PG8_WAIT_L(0); PG8_BAR; if (t == 0) { PG8_MMAZ(0, 0, At, B0); PG8_MMAZ(0, 1, At, B1); } else { PG8_MMA(0, 0, At, B0); PG8_MMA(0, 1, At, B1); } PG8_BAR; PG8_SCHED;
            PG8_LDA(At, 0, 1); PG8_STAGE(PG8_SB(0, 0), b2, voffB); PG8_STAGE(PG8_SB(0, 1), b2 + hstepB, voffB); PG8_STGA(PG8_SA(0, 0), a2, 0, last);
            PG8_WAIT_V(8); PG8_WAIT_L(0); PG8_BAR; if (GATHER || cur.nai == 2) { if (t == 0) { PG8_MMAZ(1, 0, At, B0); PG8_MMAZ(1, 1, At, B1); } else { PG8_MMA(1, 0, At, B0); PG8_MMA(1, 1, At, B1); } } PG8_BAR; PG8_SCHED;
            PG8_LDB(B0, 1, 0); PG8_LDB(B1, 1, 1); PG8_SCHED; PG8_LDA(At, 1, 0); PG8_STGA(PG8_SA(0, 1), a2, 1, last);
            PG8_WAIT_V(8); PG8_WAIT_L(0); PG8_BAR; PG8_MMA(0, 0, At, B0); PG8_MMA(0, 1, At, B1); PG8_BAR; PG8_SCHED;
            PG8_LDA(At, 1, 1); PG8_STAGE(PG8_SB(1, 0), b3, voffB); PG8_STAGE(PG8_SB(1, 1), b3 + hstepB, voffB); PG8_STGA(PG8_SA(1, 0), a3, 0, last);
            PG8_WAIT_V(8); PG8_WAIT_L(0); PG8_BAR; if (GATHER || cur.nai == 2) { PG8_MMA(1, 0, At, B0); PG8_MMA(1, 1, At, B1); } PG8_BAR; PG8_SCHED;
        }
        if (wr == 0) PG8_BAR;
        if constexpr (MODE == 2) asm volatile("s_nop 15\n\ts_nop 7" ::: "memory");
        if constexpr (Epi::PREF) E(acc, cur, wr, wc, fr, fq, (const LAS float*)(lds_ctl + EPI_SCR_OFF + (ui & 1) * 2048));
        else E(acc, cur, wr, wc, fr, fq);
        if (!has_next) break;
        PG8_ZERO();
        cur = nxt; cA = nA; cB = nB; ++ui;
        PG8_PREF(cur, ui);
        if (wr == 1) PG8_BAR;
    }
    PG8_WAIT_V(0);
    PG8_BAR;
#undef PG8_PREF
#undef PG8_SA
#undef PG8_SB
#undef PG8_STAGE
#undef PG8_STAGE2
#undef PG8_STGA
#undef PG8_LDA
#undef PG8_LDB
#undef PG8_MMA
#undef PG8_MMAZ
#undef PG8_ZERO
#undef PG8_WAIT_V
#undef PG8_WAIT_L
#undef PG8_BAR
#undef PG8_SCHED
}

struct DenseOrder {
    int nM, nN, nwg, G, c; const char* A; const char* B; unsigned tstepA, tstepB, acolstep;
    __device__ __forceinline__ void init(int nM_, int nN_, int G_, int c_, const void* A_, const void* B_, int lda, int ldb, size_t acolstep_) {
        nM = nM_; nN = nN_; nwg = nM * nN; G = G_; c = c_; A = (const char*)A_; B = (const char*)B_; tstepA = (unsigned)(BM * lda * 2); tstepB = (unsigned)(BM * ldb * 2); acolstep = (unsigned)acolstep_; }
    __device__ __forceinline__ bool next(int i, Unit& u) const {
        const int nfull = (nwg / G) * G, R = nwg - nfull; const bool hs = R > 0 && 2 * R <= G;
        const long L = (long)i * G + c; if (L >= (hs ? nfull + 2 * R : nwg)) return false;
        int wgid = (int)L, sub = 0; u.nai = 2;
        if (hs && wgid >= nfull) { const int j = wgid - nfull; wgid = nfull + (j >> 1); sub = j & 1; u.nai = 1; }
        { const int q = nwg / NXCD, r = nwg % NXCD, xcd = wgid % NXCD, off = wgid / NXCD; wgid = (xcd < r ? xcd * (q + 1) : r * (q + 1) + (xcd - r) * q) + off; }
        const int nig = WGM * nN, gid = wgid / nig, fm = gid * WGM, gsz = (nM - fm) < WGM ? (nM - fm) : WGM;
        u.pm = fm + ((wgid % nig) % gsz); u.pn = (wgid % nig) / gsz; u.r0 = u.pm * BM + sub * HALF;
        u.e = 0; u.a = A + (size_t)u.pm * tstepA + (size_t)sub * (tstepA >> 1) + (size_t)u.pn * acolstep; u.b = B + (size_t)u.pn * tstepB; return true;
    }
    __device__ __forceinline__ int row(const Unit&, int) const { return 0; }
    __device__ __forceinline__ const int* row_ptr(const Unit&, int) const { return nullptr; }
};
struct MoeOrder {
    int nM, nN, nwg, G, c; const char* A; const char* B; unsigned tstepA, tstepB, estride; const int* rowidx; int gather;
    int t1, t2, t3, t4, t5, t6, t7;
    __device__ __forceinline__ bool next(int i, Unit& u) const {
        const int nfull = (nwg / G) * G, R = nwg - nfull; const bool hs = !gather && R > 0 && 2 * R <= G;
        const long L = (long)i * G + c; if (L >= (hs ? nfull + 2 * R : nwg)) return false;
        int wgid = (int)L, sub = 0; u.nai = 2;
        if (hs && wgid >= nfull) { const int j = wgid - nfull; wgid = nfull + (j >> 1); sub = j & 1; u.nai = 1; }
        { const int q = nwg / NXCD, r = nwg % NXCD, xcd = wgid % NXCD, off = wgid / NXCD; wgid = (xcd < r ? xcd * (q + 1) : r * (q + 1) + (xcd - r) * q) + off; }
        const int nig = WGM * nN, gid = wgid / nig, fm = gid * WGM, gsz = (nM - fm) < WGM ? (nM - fm) : WGM;
        u.pm = fm + ((wgid % nig) % gsz); u.pn = (wgid % nig) / gsz; u.r0 = u.pm * BM + sub * HALF;
        const int pm = u.pm;
        const int e = (pm >= t1) + (pm >= t2) + (pm >= t3) + (pm >= t4) + (pm >= t5) + (pm >= t6) + (pm >= t7);
        u.e = e; u.a = gather ? A : A + (size_t)pm * tstepA + (size_t)sub * (tstepA >> 1); u.b = B + (size_t)e * estride + (size_t)u.pn * tstepB; return true;
    }
    __device__ __forceinline__ int row(const Unit& u, int r) const { return rowidx[u.pm * BM + r]; }
    __device__ __forceinline__ const int* row_ptr(const Unit& u, int r) const { return rowidx + u.pm * BM + r; }
};

typedef const f32x4 (&AccRef)[2][2][4][2];
struct EpiPlain {
    static constexpr bool PREF = false;
    bf16_t* O; int ldc;
    __device__ __forceinline__ void operator()(AccRef acc, const Unit& u, int wr, int wc, int fr, int fq) const {
        const int row0 = u.r0 + wr * 64 + fr, col0 = u.pn * BM + wc * 32 + 8 * fq;
#pragma unroll
        for (int ai = 0; ai < 2; ++ai) if (ai < u.nai)
#pragma unroll
            for (int m = 0; m < 4; ++m) { bf16_t* rowp = O + (size_t)(row0 + ai * HALF + m * 16) * ldc + col0;
#pragma unroll
                for (int bj = 0; bj < 2; ++bj) { const f32x4 v0 = acc[ai][bj][m][0], v1 = acc[ai][bj][m][1];
                    u32x4 w; w.x = cvt_pk_bf16(v0[0], v0[1]); w.y = cvt_pk_bf16(v0[2], v0[3]); w.z = cvt_pk_bf16(v1[0], v1[1]); w.w = cvt_pk_bf16(v1[2], v1[3]);
                    *(u32x4*)(rowp + bj * HALF) = w; } }
    }
};
struct EpiPool {
    static constexpr bool PREF = false;
    bf16_t* O; const float* bias; const float* scale;
    __device__ __forceinline__ void operator()(AccRef acc, const Unit& u, int wr, int wc, int fr, int fq) const {
        const int row0 = u.r0 + wr * 64 + fr, col0 = u.pn * BM + wc * 32 + 8 * fq;
#pragma unroll
        for (int bj = 0; bj < 2; ++bj) {
            const f32x4 b0 = *(const f32x4*)(bias + col0 + bj * HALF), b1 = *(const f32x4*)(bias + col0 + bj * HALF + 4);
            const f32x4 s0 = *(const f32x4*)(scale + col0 + bj * HALF), s1 = *(const f32x4*)(scale + col0 + bj * HALF + 4);
#pragma unroll
            for (int ai = 0; ai < 2; ++ai) if (ai < u.nai)
#pragma unroll
                for (int m = 0; m < 4; ++m) { bf16_t* rowp = O + (size_t)(row0 + ai * HALF + m * 16) * D + col0;
                    const f32x4 v0 = (acc[ai][bj][m][0] + b0) * s0, v1 = (acc[ai][bj][m][1] + b1) * s1;
                    u32x4 w; w.x = cvt_pk_bf16(v0[0], v0[1]); w.y = cvt_pk_bf16(v0[2], v0[3]); w.z = cvt_pk_bf16(v1[0], v1[1]); w.w = cvt_pk_bf16(v1[2], v1[3]);
                    *(u32x4*)(rowp + bj * HALF) = w; }
        }
    }
};
struct EpiSwiglu {
    static constexpr bool PREF = false;
    bf16_t* O; int ldc;
    __device__ __forceinline__ void operator()(AccRef acc, const Unit& u, int wr, int wc, int fr, int fq) const {
        const int row0 = u.r0 + wr * 64 + fr, col0 = u.pn * HALF + wc * 32 + 8 * fq;
#pragma unroll
        for (int ai = 0; ai < 2; ++ai) if (ai < u.nai)
#pragma unroll
            for (int m = 0; m < 4; ++m) { bf16_t* rowp = O + (size_t)(row0 + ai * HALF + m * 16) * ldc + col0;
                float o[8];
#pragma unroll
                for (int n = 0; n < 2; ++n)
#pragma unroll
                    for (int j = 0; j < 4; ++j) { const float gv = acc[ai][0][m][n][j], uv = acc[ai][1][m][n][j];
                        o[4 * n + j] = gv * fast_rcp(1.0f + fast_exp2(-gv * LOG2E)) * uv; }
                u32x4 w; w.x = cvt_pk_bf16(o[0], o[1]); w.y = cvt_pk_bf16(o[2], o[3]); w.z = cvt_pk_bf16(o[4], o[5]); w.w = cvt_pk_bf16(o[6], o[7]);
                *(u32x4*)rowp = w; }
    }
};
typedef const i32x4 (&AccRefI)[2][2][4][2];
struct EpiSwigluQ {
    static constexpr bool PREF = true;
    unsigned char* O; int ldc; const float* sa; const float* sw; int swe;
    __device__ __forceinline__ const float* pref_ptr(const Unit& u, int wid, int lane) const {
        return wid < 4 ? sa + (size_t)u.r0 + wid * 64 + lane : sw + (size_t)u.e * swe + u.pn * BM + (wid - 4) * 64 + lane; }
    __device__ __forceinline__ void operator()(AccRefI acc, const Unit& u, int wr, int wc, int fr, int fq, const LAS float* scr) const {
        typedef float f32x2 __attribute__((ext_vector_type(2)));
        const int row0 = u.r0 + wr * 64 + fr, col0 = u.pn * HALF + wc * 32 + 8 * fq;
        const LAS float* swp = scr + 256 + wc * 32 + 8 * fq;
        f32x2 wl[4], wp[4];
#pragma unroll
        for (int q = 0; q < 4; ++q) { const f32x2 g2 = *(const LAS f32x2*)(swp + 2 * q), u2 = *(const LAS f32x2*)(swp + HALF + 2 * q); wl[q] = g2 * (-LOG2E); wp[q] = g2 * u2; }
#pragma unroll
        for (int ai = 0; ai < 2; ++ai) if (ai < u.nai)
#pragma unroll
            for (int m = 0; m < 4; ++m) { const int row = row0 + ai * HALF + m * 16; unsigned char* rowp = O + (size_t)row * ldc + col0;
                const float sr = scr[ai * HALF + wr * 64 + m * 16 + fr], sr2 = sr * sr;
                f32x2 o2[4];
#pragma unroll
                for (int q = 0; q < 4; ++q) { const int n = q >> 1, j = 2 * (q & 1);
                    const f32x2 G2 = {(float)acc[ai][0][m][n][j], (float)acc[ai][0][m][n][j + 1]}, U2 = {(float)acc[ai][1][m][n][j], (float)acc[ai][1][m][n][j + 1]};
                    const f32x2 t2 = (G2 * wl[q]) * sr;
                    f32x2 d2; d2.x = fast_exp2(t2.x); d2.y = fast_exp2(t2.y); d2 = d2 + 1.0f;
                    f32x2 r2; r2.x = fast_rcp(d2.x); r2.y = fast_rcp(d2.y);
                    o2[q] = ((G2 * U2) * wp[q]) * (r2 * sr2); }
                u32x2 w; w.x = pk4_fp8_sat(o2[0].x, o2[0].y, o2[1].x, o2[1].y); w.y = pk4_fp8_sat(o2[2].x, o2[2].y, o2[3].x, o2[3].y);
                *(u32x2*)rowp = w; }
    }
};
struct EpiPlainS {
    static constexpr bool PREF = true;
    bf16_t* O; int ldc; const float* cs; int cse;
    __device__ __forceinline__ const float* pref_ptr(const Unit& u, int wid, int lane) const {
        return wid < 4 ? (const float*)nullptr : cs + (size_t)u.e * cse + u.pn * BM + (wid - 4) * 64 + lane; }
    __device__ __forceinline__ void operator()(AccRef acc, const Unit& u, int wr, int wc, int fr, int fq, const LAS float* scr) const {
        const int row0 = u.r0 + wr * 64 + fr, col0 = u.pn * BM + wc * 32 + 8 * fq;
        const LAS float* cp = scr + 256 + wc * 32 + 8 * fq;
#pragma unroll
        for (int bj = 0; bj < 2; ++bj) {
            const f32x4 s0 = *(const LAS f32x4*)(cp + bj * HALF), s1 = *(const LAS f32x4*)(cp + bj * HALF + 4);
#pragma unroll
            for (int ai = 0; ai < 2; ++ai) if (ai < u.nai)
#pragma unroll
                for (int m = 0; m < 4; ++m) { bf16_t* rowp = O + (size_t)(row0 + ai * HALF + m * 16) * ldc + col0;
                    const f32x4 v0 = acc[ai][bj][m][0] * s0, v1 = acc[ai][bj][m][1] * s1;
                    u32x4 w; w.x = cvt_pk_bf16(v0[0], v0[1]); w.y = cvt_pk_bf16(v0[2], v0[3]); w.z = cvt_pk_bf16(v1[0], v1[1]); w.w = cvt_pk_bf16(v1[2], v1[3]);
                    *(u32x4*)(rowp + bj * HALF) = w; }
        }
    }
};
struct EpiQKVQ {
    static constexpr bool PREF = true;
    bf16_t *Q, *Kb, *V; const float* rope; const float* sa; const float* sw;
    __device__ __forceinline__ const float* pref_ptr(const Unit& u, int wid, int lane) const {
        return wid < 4 ? sa + (size_t)u.r0 + wid * 64 + lane : sw + u.pn * BM + (wid - 4) * 64 + lane; }
    __device__ __forceinline__ void operator()(AccRefI acc, const Unit& u, int wr, int wc, int fr, int fq, const LAS float* scr) const {
        const int row0 = u.r0 + wr * 64 + fr, pn = u.pn;
        bf16_t* base; int ldc, colt;
        if (pn < 4) { base = Q; ldc = D; colt = pn * BM; } else if (pn == 4) { base = Kb; ldc = KVD; colt = 0; } else { base = V; ldc = KVD; colt = 0; }
        const bool rope_on = (pn < 5) && (u.pm < ML / BM);
        const float qs = (pn < 4) ? 0.125f * LOG2E : 1.0f;
        const int axis = wc & 1, col0 = colt + wc * 32 + 8 * fq;
        const LAS float* cp = scr + 256 + wc * 32 + 8 * fq;
        const f32x4 wv[2][2] = {{*(const LAS f32x4*)cp, *(const LAS f32x4*)(cp + 4)}, {*(const LAS f32x4*)(cp + HALF), *(const LAS f32x4*)(cp + HALF + 4)}};
#pragma unroll
        for (int ai = 0; ai < 2; ++ai) if (ai < u.nai) {
            f32x4 c4[4], s4[4];
#pragma unroll
            for (int m = 0; m < 4; ++m) { c4[m] = (f32x4){1.f, 1.f, 1.f, 1.f}; s4[m] = (f32x4){0.f, 0.f, 0.f, 0.f}; }
            if (rope_on) {
#pragma unroll
                for (int m = 0; m < 4; ++m) { const int row = row0 + ai * HALF + m * 16, t = row & (SEQ - 1), pos = axis ? (t & 63) : (t >> 6);
                    c4[m] = *(const f32x4*)(rope + pos * 16 + 4 * fq); s4[m] = *(const f32x4*)(rope + 2048 + pos * 16 + 4 * fq); }
            }
#pragma unroll
            for (int m = 0; m < 4; ++m) { const int row = row0 + ai * HALF + m * 16; bf16_t* rowp = base + (size_t)row * ldc + col0;
                const float sr = scr[ai * HALF + wr * 64 + m * 16 + fr] * qs;
                const f32x4 cc = c4[m] * sr, ss = s4[m] * sr;
#pragma unroll
                for (int bj = 0; bj < 2; ++bj) {
                    const i32x4 a0 = acc[ai][bj][m][0], a1 = acc[ai][bj][m][1];
                    const f32x4 v0 = (f32x4){(float)a0[0], (float)a0[1], (float)a0[2], (float)a0[3]} * wv[bj][0], v1 = (f32x4){(float)a1[0], (float)a1[1], (float)a1[2], (float)a1[3]} * wv[bj][1];
                    u32x4 w;
                    w.x = cvt_pk_bf16(v0[0] * cc[0] - v0[1] * ss[0], v0[1] * cc[0] + v0[0] * ss[0]);
                    w.y = cvt_pk_bf16(v0[2] * cc[1] - v0[3] * ss[1], v0[3] * cc[1] + v0[2] * ss[1]);
                    w.z = cvt_pk_bf16(v1[0] * cc[2] - v1[1] * ss[2], v1[1] * cc[2] + v1[0] * ss[2]);
                    w.w = cvt_pk_bf16(v1[2] * cc[3] - v1[3] * ss[3], v1[3] * cc[3] + v1[2] * ss[3]);
                    *(u32x4*)(rowp + bj * HALF) = w; }
            }
        }
    }
};
struct EpiQKV {
    static constexpr bool PREF = false;
    bf16_t *Q, *Kb, *V; const float* rope;
    __device__ __forceinline__ void operator()(AccRef acc, const Unit& u, int wr, int wc, int fr, int fq) const {
        const int row0 = u.r0 + wr * 64 + fr, pn = u.pn;
        bf16_t* base; int ldc, colt;
        if (pn < 4) { base = Q; ldc = D; colt = pn * BM; } else if (pn == 4) { base = Kb; ldc = KVD; colt = 0; } else { base = V; ldc = KVD; colt = 0; }
        const bool rope_on = (pn < 5) && (u.pm < ML / BM);
        const float qs = (pn < 4) ? 0.125f * LOG2E : 1.0f;
        const int axis = wc & 1, col0 = colt + wc * 32 + 8 * fq;
#pragma unroll
        for (int ai = 0; ai < 2; ++ai) if (ai < u.nai)
#pragma unroll
            for (int m = 0; m < 4; ++m) { const int row = row0 + ai * HALF + m * 16; bf16_t* rowp = base + (size_t)row * ldc + col0;
                f32x4 c4 = (f32x4){1.f, 1.f, 1.f, 1.f}, s4 = (f32x4){0.f, 0.f, 0.f, 0.f};
                if (rope_on) { const int t = row & (SEQ - 1), pos = axis ? (t & 63) : (t >> 6); c4 = *(const f32x4*)(rope + pos * 16 + 4 * fq); s4 = *(const f32x4*)(rope + 2048 + pos * 16 + 4 * fq); }
                c4 *= qs; s4 *= qs;
#pragma unroll
                for (int bj = 0; bj < 2; ++bj) { const f32x4 v0 = acc[ai][bj][m][0], v1 = acc[ai][bj][m][1];
                    u32x4 w;
                    w.x = cvt_pk_bf16(v0[0] * c4[0] - v0[1] * s4[0], v0[1] * c4[0] + v0[0] * s4[0]);
                    w.y = cvt_pk_bf16(v0[2] * c4[1] - v0[3] * s4[1], v0[3] * c4[1] + v0[2] * s4[1]);
                    w.z = cvt_pk_bf16(v1[0] * c4[2] - v1[1] * s4[2], v1[1] * c4[2] + v1[0] * s4[2]);
                    w.w = cvt_pk_bf16(v1[2] * c4[3] - v1[3] * s4[3], v1[3] * c4[3] + v1[2] * s4[3]);
                    *(u32x4*)(rowp + bj * HALF) = w; } }
    }
};
}

struct Params {
    const float *x, *c, *ctx, *c_ctx, *ada_w, *ada_b, *norm_g, *w_qkv, *w_o, *sink, *pool_w, *pool_b, *pool_scale, *ffn_gu, *ffn_dn, *router_w, *router_b, *moe_gu, *moe_dn;
    float* out; unsigned char* ws;
};

__device__ __forceinline__ int src_col(int n, int mode, int F) {
    if (mode == 1) { if (n >= 1280) return n; const int dn = n & 63, i = dn >> 1, s = dn & 1; return (n & ~63) + (i & 15) + 32 * (i >> 4) + 16 * s; }
    if (mode == 2) { const int pn = n >> 8, bj = (n >> 7) & 1, jj = n & 127; return bj * F + 128 * pn + jj; }
    return n;
}
__device__ __forceinline__ void transpose_item(const float* W, int Nsrc, int K, bf16_t* Bt, int item, int nblk, int mode, int F, int lane) {
    const int kb = item / nblk, nb = item % nblk, k0 = kb * 64, n = nb * 64 + lane;
    const float* src = W + (size_t)k0 * Nsrc + src_col(n, mode, F);
    float v[64];
#pragma unroll
    for (int i = 0; i < 64; ++i) v[i] = src[(size_t)i * Nsrc];
    bf16_t* dst = Bt + (size_t)n * K + k0;
#pragma unroll
    for (int j = 0; j < 8; ++j) { u32x4 w; w.x = cvt_pk_bf16(v[8 * j], v[8 * j + 1]); w.y = cvt_pk_bf16(v[8 * j + 2], v[8 * j + 3]); w.z = cvt_pk_bf16(v[8 * j + 4], v[8 * j + 5]); w.w = cvt_pk_bf16(v[8 * j + 6], v[8 * j + 7]);
        *(u32x4*)(dst + 8 * j) = w; }
}
__device__ __forceinline__ void colmax_item(const float* W, unsigned* colmax, int item, int lane, int kb_mid) {
    const int kb = (item >> 4) ? kb_mid : 0, nb = item & 15, n = nb * 64 + lane;
    const float* src = W + (size_t)(kb * 64) * D + n;
    float v[64]; float mx = 0.f;
#pragma unroll
    for (int i = 0; i < 64; ++i) v[i] = src[(size_t)i * D];
#pragma unroll
    for (int i = 0; i < 64; ++i) mx = fmaxf(mx, fabsf(v[i]));
    atomicMax(colmax + n, __float_as_uint(mx));
}
__device__ __forceinline__ void fp8_item(const float* W, int K, unsigned char* Bq, const unsigned* colmax, float* sdn, int item, int lane) {
    const int kb = item >> 4, nb = item & 15, n = nb * 64 + lane;
    const float* src = W + (size_t)(kb * 64) * D + n;
    float v[64];
#pragma unroll
    for (int i = 0; i < 64; ++i) v[i] = src[(size_t)i * D];
    const float cm = __uint_as_float(colmax[n]), sc = cm > 0.f ? 128.0f / cm : 0.f;
    if (kb == 0) sdn[n] = cm * (1.0f / 128.0f);
    unsigned char* dst = Bq + (size_t)n * K + kb * 64;
#pragma unroll
    for (int c = 0; c < 4; ++c) { u32x4 w4;
#pragma unroll
        for (int q = 0; q < 4; ++q) w4[q] = pk4_fp8(v[16 * c + 4 * q] * sc, v[16 * c + 4 * q + 1] * sc, v[16 * c + 4 * q + 2] * sc, v[16 * c + 4 * q + 3] * sc);
        *(u32x4*)(dst + 16 * c) = w4; }
}
__device__ __forceinline__ void quant_item(const float* W, int Nsrc, signed char* Bq, float* sw, int nb, int mode, int F, LAS float* pmax, int wave, int lane) {
    const int n = nb * 64 + lane;
    const float* src = W + (size_t)(wave * 128) * Nsrc + src_col(n, mode, F);
    float v[128]; float mx = 0.f;
#pragma unroll
    for (int i = 0; i < 128; ++i) v[i] = src[(size_t)i * Nsrc];
#pragma unroll
    for (int i = 0; i < 128; ++i) mx = fmaxf(mx, fabsf(v[i]));
    pmax[wave * 64 + lane] = mx;
    __syncthreads();
    float cm = pmax[lane];
#pragma unroll
    for (int w = 1; w < 8; ++w) cm = fmaxf(cm, pmax[w * 64 + lane]);
    const float inv = cm > 0.f ? 127.0f / cm : 0.f;
    if (wave == 0) sw[n] = cm * (1.0f / 127.0f);
    signed char* dst = Bq + (size_t)n * D + wave * 128;
#pragma unroll
    for (int c = 0; c < 8; ++c) { u32x4 w4;
#pragma unroll
        for (int q = 0; q < 4; ++q) { unsigned wd = 0u;
#pragma unroll
            for (int b = 0; b < 4; ++b) { const int qi = (int)__builtin_rintf(v[16 * c + 4 * q + b] * inv); wd |= ((unsigned)qi & 0xffu) << (8 * b); }
            w4[q] = wd; }
        *(u32x4*)(dst + 16 * c) = w4; }
}
__device__ __forceinline__ void prologue(const Params& p, LAS unsigned char* lds, int G, int wg, int tid) {
    const int lane = tid & 63, wave = __builtin_amdgcn_readfirstlane(tid >> 6);
    LAS float* scond = (LAS float*)lds;
    for (int i = tid; i < 5 * D; i += 512) { const int cnd = i >> 10, k = i & 1023; const float v = cnd < 4 ? p.c[cnd * D + k] : p.c_ctx[k]; scond[i] = v / (1.0f + __expf(-v)); }
    __syncthreads();
    const int gw = wg * 8 + wave, NGW = G * 8;
    if (wg == G - 1) {
        float* rope = (float*)(p.ws + WS_ROPE);
        for (int i = tid; i < 2048; i += 512) { const int pos = i >> 4, f = i & 15;
            const int fq4 = f & 3, fd = f >> 2;
            double inv = fq4 == 0 ? 1.0 : (fq4 == 1 ? 0.5623413251903491 : (fq4 == 2 ? 0.31622776601683794 : 0.1778279410038923));
            inv *= fd == 0 ? 1.0 : (fd == 1 ? 0.1 : (fd == 2 ? 0.01 : 0.001));
            const double ang = (double)pos * inv, kq = __builtin_rint(ang * 0.6366197723675814);
            double r = __builtin_fma(-kq, 1.5707963267948966, ang); r = __builtin_fma(-kq, 6.123233995736766e-17, r);
            const double r2 = r * r;
            const double sr = r * (1.0 + r2 * (-1.0 / 6 + r2 * (1.0 / 120 + r2 * (-1.0 / 5040 + r2 * (1.0 / 362880 + r2 * (-1.0 / 39916800 + r2 * (1.0 / 6227020800.0)))))));
            const double cr = 1.0 + r2 * (-0.5 + r2 * (1.0 / 24 + r2 * (-1.0 / 720 + r2 * (1.0 / 40320 + r2 * (-1.0 / 3628800 + r2 * (1.0 / 479001600 + r2 * (-1.0 / 87178291200.0)))))));
            const int qd = (int)kq & 3;
            const double cs = qd == 0 ? cr : (qd == 1 ? -sr : (qd == 2 ? -cr : sr)), sn = qd == 0 ? sr : (qd == 1 ? cr : (qd == 2 ? -sr : -cr));
            rope[i] = (float)cs; rope[2048 + i] = (float)sn; }
    }
    {
        float* modp = (float*)(p.ws + WS_MODP);
        for (int it = gw; it < KP * 4 * 24; it += NGW) {
            const int part = it / 96, rem = it % 96, l = rem / 24, cb = rem % 24, n = cb * 256 + 4 * lane, k0 = part * (D / KP);
            const float* w = p.ada_w + ((size_t)l * D + k0) * 6144 + n;
            f32x4 a0 = {0.f, 0.f, 0.f, 0.f}, a1 = a0, a2 = a0, a3 = a0, a4 = a0;
#pragma unroll 8
            for (int k = 0; k < D / KP; ++k) { const f32x4 wv = *(const f32x4*)(w + (size_t)k * 6144);
                a0 += wv * scond[0 * D + k0 + k]; a1 += wv * scond[1 * D + k0 + k]; a2 += wv * scond[2 * D + k0 + k]; a3 += wv * scond[3 * D + k0 + k]; a4 += wv * scond[4 * D + k0 + k]; }
            float* o = modp + ((size_t)(part * 4 + l) * 5) * 6144 + n;
            *(f32x4*)(o + 0 * 6144) = a0; *(f32x4*)(o + 1 * 6144) = a1; *(f32x4*)(o + 2 * 6144) = a2; *(f32x4*)(o + 3 * 6144) = a3; *(f32x4*)(o + 4 * 6144) = a4;
        }
    }
    {
        LAS float* pmax = (LAS float*)(lds + 32768);
        float* swb = (float*)(p.ws + WS_SW);
        unsigned* qctr = (unsigned*)(p.ws + WS_CTL) + CW_QITEM;
        LAS int* qit = (LAS int*)(lds + 32768 + 8192);
        int nxt_it = 0;
        if (tid == 0) nxt_it = (int)atomicAdd(qctr, 1u);
        int par = 0;
        for (;; par ^= 1) {
            if (tid == 0) *qit = nxt_it;
            __syncthreads();
            const int it = *qit;
            if (it >= 2 * 88 + 16 * 112 + 2 * 24) break;
            if (tid == 0) nxt_it = (int)atomicAdd(qctr, 1u);
            if (it >= 2 * 88 + 16 * 112) { const int r = it - (2 * 88 + 16 * 112), mi = r / 24, nb = r % 24;
                quant_item(p.w_qkv + (size_t)mi * D * NQKV, NQKV, (signed char*)(p.ws + WS_WQKV) + (size_t)mi * NQKV * D, swb + SWQ_OFF + mi * NQKV, nb, 1, 0, pmax + par * 512, wave, lane); continue; }
            if (it < 2 * 88) { const int mi = it / 88, nb = it % 88; quant_item(p.ffn_gu + (size_t)mi * D * 2 * DFF, 2 * DFF, (signed char*)(p.ws + WS_WFGU) + (size_t)mi * 2 * DFF * D, swb + mi * 2 * DFF, nb, 2, DFF, pmax + par * 512, wave, lane); }
            else { const int r = it - 2 * 88, mi = r / 112, nb = r % 112; quant_item(p.moe_gu + (size_t)mi * D * 2 * DFE, 2 * DFE, (signed char*)(p.ws + WS_WMGU) + (size_t)mi * 2 * DFE * D, swb + 2 * 2 * DFF + mi * 2 * DFE, nb, 2, DFE, pmax + par * 512, wave, lane); }
        }
    }
    constexpr int I1 = 2 * 256, I2 = I1 + 8 * 16, I3 = I2 + 2 * 32, I4 = I3 + 16 * 32;
    unsigned* colmax = (unsigned*)(p.ws + WS_CTL + CTL_COLMAX);
    for (int it = gw; it < I4; it += NGW) {
        if (it >= I3) { const int r = it - I3, mi = r / 32, li = r % 32; colmax_item(p.moe_dn + (size_t)mi * DFE * D, colmax + (2 + mi) * D, li, lane, DFE / 128); }
        else if (it >= I2) { const int r = it - I2, mi = r / 32, li = r % 32; colmax_item(p.ffn_dn + (size_t)mi * DFF * D, colmax + mi * D, li, lane, DFF / 128); }
        else if (it >= I1) { const int r = it - I1, mi = r / 16, li = r % 16; transpose_item(p.pool_w + (size_t)mi * 256 * 256, 256, 256, (bf16_t*)(p.ws + WS_WPOOL) + (size_t)mi * 256 * 256, li, 4, 0, 0, lane); }
        else { const int mi = it / 256, li = it % 256; transpose_item(p.w_o + (size_t)mi * D * D, D, D, (bf16_t*)(p.ws + WS_WO) + (size_t)mi * D * D, li, 16, 0, 0, lane); }
    }
}
__device__ __forceinline__ void prologue_down_quant(const Params& p, int G, int wg, int tid) {
    const int lane = tid & 63, wave = __builtin_amdgcn_readfirstlane(tid >> 6), gw = wg * 8 + wave, NGW = G * 8;
    const unsigned* colmax = (const unsigned*)(p.ws + WS_CTL + CTL_COLMAX);
    float* sdn = (float*)(p.ws + WS_SDN);
    constexpr int J0 = 2 * 704, J1 = J0 + 16 * 896;
    for (int it = gw; it < J1; it += NGW) {
        if (it >= J0) { const int r = it - J0, mi = r / 896, li = r % 896; fp8_item(p.moe_dn + (size_t)mi * DFE * D, DFE, (unsigned char*)(p.ws + WS_WMDN) + (size_t)mi * D * DFE, colmax + (2 + mi) * D, sdn + (2 + mi) * D, li, lane); }
        else { const int mi = it / 704, li = it % 704; fp8_item(p.ffn_dn + (size_t)mi * DFF * D, DFF, (unsigned char*)(p.ws + WS_WFDN) + (size_t)mi * D * DFF, colmax + mi * D, sdn + mi * D, li, lane); }
    }
}

template <bool PARTS>
__device__ __forceinline__ f32x4 mod_vec(const float* modp, const float* mod, const float* ada_b, int l, int cond, int chunk, int col) {
    if (!PARTS) return *(const f32x4*)(mod + ((size_t)l * 5 + cond) * 6144 + chunk * D + col);
    f32x4 s = *(const f32x4*)(ada_b + (size_t)l * 6144 + chunk * D + col);
#pragma unroll 2
    for (int pt = 0; pt < KP; ++pt) s += *(const f32x4*)(modp + ((size_t)(pt * 4 + l) * 5 + cond) * 6144 + chunk * D + col);
    return s;
}
template <bool ROUTER, bool MOE_IN, bool PARTS, bool Q8>
__device__ __forceinline__ void thin_phase(const Params& p, LAS unsigned char* lds, int G, int wg, int tid, int M, bool has_post, int lpost, int wpost, bool has_pre, int lpre, int wpre,
                                           bool xin32, bool xout32, bool write_x, const bf16_t* y, bf16_t* hout, int lrouter) {
    const int lane = tid & 63, wave = __builtin_amdgcn_readfirstlane(tid >> 6);
    const float* modp = (const float*)(p.ws + WS_MODP);
    const float* modf = (const float*)(p.ws + WS_MOD);
    if (PARTS) {
        float* mo = (float*)(p.ws + WS_MOD);
        for (int i = wg * 512 + tid; i < 4 * 5 * 6144 / 4; i += G * 512) { const int e = i * 4, l = e / (5 * 6144), r = e % (5 * 6144), cnd = r / 6144, n = r % 6144;
            *(f32x4*)(mo + e) = mod_vec<true>(modp, modf, p.ada_b, l, cnd, n >> 10, n & 1023); }
    }
    LAS float* rw = (LAS float*)lds;
    LAS unsigned* lcnt = (LAS unsigned*)(lds + 32768);
    if (ROUTER) {
        const float* rwg = p.router_w + (size_t)lrouter * D * NE;
        for (int i = tid; i < D * NE; i += 512) { const int k = i >> 3, e = i & 7; rw[e * D + k] = rwg[i]; }
        if (tid < 8) lcnt[tid] = 0u;
        __syncthreads();
    }
    const int RPW = (M + G - 1) / G, r0 = wg * RPW, r1 = (r0 + RPW < M) ? r0 + RPW : M;
    int cur_cond = -1;
    f32x4 pa[4], pb[4], pc[4];
    f32x4 xA[4], xB[4], xC[4]; u32x2 rA[4], rB[4], rC[4], yA[4], yB[4], yC[4], zA[4], zB[4], zC[4];
    bf16_t* const xbs = (bf16_t*)(p.ws + WS_XB); float gA1 = 0.f, gA2 = 0.f, gB1 = 0.f, gB2 = 0.f, gC1 = 0.f, gC2 = 0.f;
#define TH_SLOT(row_, sl_, inf_) do { if (MOE_IN) { sl_ = *(const i32x2*)(p.ws + WS_MOE + MO_SLOT + (size_t)(row_) * 8); inf_ = *(const i32x4*)(p.ws + WS_MOE + MO_INFO + (size_t)(row_) * 16); } } while (0)
#define TH_LOAD(row_, xv_, xr2_, ya_, yb_, g1_, g2_, sl_, inf_) do { \
        if (xin32) { const float* xr_ = (row_) < ML ? p.x + (size_t)(row_) * D : p.ctx + (size_t)((row_) - ML) * D; \
            _Pragma("unroll") for (int j = 0; j < 4; ++j) xv_[j] = *(const f32x4*)(xr_ + 4 * lane + 256 * j); } \
        else { const bf16_t* xr_ = xbs + (size_t)(row_) * D; \
            _Pragma("unroll") for (int j = 0; j < 4; ++j) xr2_[j] = *(const u32x2*)(xr_ + 4 * lane + 256 * j); } \
        if (has_post) { \
            if (MOE_IN) { \
                g1_ = __int_as_float(inf_.z); g2_ = __int_as_float(inf_.w); \
                const bf16_t* y1_ = y + (size_t)sl_.x * D; const bf16_t* y2_ = y + (size_t)sl_.y * D; \
                _Pragma("unroll") for (int j = 0; j < 4; ++j) { ya_[j] = *(const u32x2*)(y1_ + 4 * lane + 256 * j); yb_[j] = *(const u32x2*)(y2_ + 4 * lane + 256 * j); } \
            } else { \
                const bf16_t* yr_ = y + (size_t)(row_) * D; \
                _Pragma("unroll") for (int j = 0; j < 4; ++j) ya_[j] = *(const u32x2*)(yr_ + 4 * lane + 256 * j); \
            } } } while (0)
#define TH_PROC(row_, xv, xr2_, ya_, yb_, g1_, g2_) do { \
        const int row = (row_); \
        if (!xin32) { _Pragma("unroll") for (int j = 0; j < 4; ++j) xv[j] = (f32x4){bf_lo(xr2_[j].x), bf_hi(xr2_[j].x), bf_lo(xr2_[j].y), bf_hi(xr2_[j].y)}; } \
        const int cond = row < ML ? (row >> 13) : 4; \
        if (cond != cur_cond) { \
            cur_cond = cond; \
            _Pragma("unroll") for (int j = 0; j < 4; ++j) { const int col = 4 * lane + 256 * j; \
                if (has_post) { const f32x4 gt = mod_vec<PARTS>(modp, modf, p.ada_b, lpost, cond, wpost ? 5 : 2, col); const f32x4 gp = *(const f32x4*)(p.norm_g + ((size_t)lpost * 4 + (wpost ? 3 : 1)) * D + col); pa[j] = gt * gp; } \
                else pa[j] = (f32x4){0.f, 0.f, 0.f, 0.f}; \
                if (has_pre) { const f32x4 sh = mod_vec<PARTS>(modp, modf, p.ada_b, lpre, cond, wpre ? 3 : 0, col), sc = mod_vec<PARTS>(modp, modf, p.ada_b, lpre, cond, wpre ? 4 : 1, col); \
                    const f32x4 gp = *(const f32x4*)(p.norm_g + ((size_t)lpre * 4 + (wpre ? 2 : 0)) * D + col); pb[j] = gp * (sc + 1.0f); pc[j] = sh; } \
                else { pb[j] = (f32x4){0.f, 0.f, 0.f, 0.f}; pc[j] = pb[j]; } \
            } \
        } \
        if (has_post) { \
            f32x4 yv[4]; \
            if (MOE_IN) { \
                _Pragma("unroll") for (int j = 0; j < 4; ++j) { const u32x2 a = ya_[j], b = yb_[j]; \
                    yv[j] = (f32x4){g1_ * bf_lo(a.x) + g2_ * bf_lo(b.x), g1_ * bf_hi(a.x) + g2_ * bf_hi(b.x), g1_ * bf_lo(a.y) + g2_ * bf_lo(b.y), g1_ * bf_hi(a.y) + g2_ * bf_hi(b.y)}; } \
            } else { \
                _Pragma("unroll") for (int j = 0; j < 4; ++j) { const u32x2 a = ya_[j]; yv[j] = (f32x4){bf_lo(a.x), bf_hi(a.x), bf_lo(a.y), bf_hi(a.y)}; } \
            } \
            float ss = 0.f; \
            _Pragma("unroll") for (int j = 0; j < 4; ++j) ss += (yv[j].x * yv[j].x + yv[j].y * yv[j].y) + (yv[j].z * yv[j].z + yv[j].w * yv[j].w); \
            const float rstd = __builtin_amdgcn_rsqf(wave_sum(ss) * (1.0f / D) + NORM_EPS); \
            _Pragma("unroll") for (int j = 0; j < 4; ++j) xv[j] += pa[j] * (yv[j] * rstd); \
            if (write_x) { \
                if (xout32) { float* xw = p.out + (size_t)row * D; \
                    _Pragma("unroll") for (int j = 0; j < 4; ++j) *(f32x4*)(xw + 4 * lane + 256 * j) = xv[j]; } \
                else { bf16_t* xw = xbs + (size_t)row * D; \
                    _Pragma("unroll") for (int j = 0; j < 4; ++j) { u32x2 w; w.x = cvt_pk_bf16(xv[j].x, xv[j].y); w.y = cvt_pk_bf16(xv[j].z, xv[j].w); *(u32x2*)(xw + 4 * lane + 256 * j) = w; \
                        xv[j] = (f32x4){bf_lo(w.x), bf_hi(w.x), bf_lo(w.y), bf_hi(w.y)}; } }     \
            } \
        } \
        if (has_pre) { \
            float ss = 0.f; \
            _Pragma("unroll") for (int j = 0; j < 4; ++j) ss += (xv[j].x * xv[j].x + xv[j].y * xv[j].y) + (xv[j].z * xv[j].z + xv[j].w * xv[j].w); \
            const float rstd = __builtin_amdgcn_rsqf(wave_sum(ss) * (1.0f / D) + NORM_EPS); \
            f32x4 hv[4]; \
            bf16_t* hr = hout + (size_t)row * D; \
            _Pragma("unroll") for (int j = 0; j < 4; ++j) hv[j] = (xv[j] * rstd) * pb[j] + pc[j]; \
            if (Q8) {     \
                float am = 0.f; \
                _Pragma("unroll") for (int j = 0; j < 4; ++j) am = fmaxf(fmaxf(am, fmaxf(fabsf(hv[j].x), fabsf(hv[j].y))), fmaxf(fabsf(hv[j].z), fabsf(hv[j].w))); \
                am = wave_max(am); \
                const float qi_ = am > 0.f ? 127.0f * fast_rcp(am) : 0.f; \
                signed char* hq_ = (signed char*)(p.ws + WS_HQ) + (size_t)row * D; \
                _Pragma("unroll") for (int j = 0; j < 4; ++j) { \
                    const unsigned wd_ = ((unsigned)(int)__builtin_rintf(hv[j].x * qi_) & 0xffu) | (((unsigned)(int)__builtin_rintf(hv[j].y * qi_) & 0xffu) << 8) | (((unsigned)(int)__builtin_rintf(hv[j].z * qi_) & 0xffu) << 16) | (((unsigned)(int)__builtin_rintf(hv[j].w * qi_) & 0xffu) << 24); \
                    *(unsigned*)(hq_ + 4 * lane + 256 * j) = wd_; } \
                if (lane == 0) ((float*)(p.ws + WS_SA))[row] = am * (1.0f / 127.0f); \
            } else { \
                _Pragma("unroll") for (int j = 0; j < 4; ++j) { u32x2 w; w.x = cvt_pk_bf16(hv[j].x, hv[j].y); w.y = cvt_pk_bf16(hv[j].z, hv[j].w); *(u32x2*)(hr + 4 * lane + 256 * j) = w; } \
            } \
            if (ROUTER) { \
                float lg[8]; \
                _Pragma("unroll") for (int e = 0; e < 8; ++e) { float s_ = 0.f; \
                    _Pragma("unroll") for (int j = 0; j < 4; ++j) { const f32x4 w = *(const LAS f32x4*)(rw + e * D + 4 * lane + 256 * j); s_ += (hv[j].x * w.x + hv[j].y * w.y) + (hv[j].z * w.z + hv[j].w * w.w); } \
                    lg[e] = wave_sum(s_) + p.router_b[lrouter * NE + e]; } \
                int e1 = 0; float v1 = lg[0]; \
                _Pragma("unroll") for (int e = 1; e < 8; ++e) if (lg[e] > v1) { v1 = lg[e]; e1 = e; } \
                int e2 = -1; float v2 = -3.0e38f; \
                _Pragma("unroll") for (int e = 0; e < 8; ++e) if (e != e1 && lg[e] > v2) { v2 = lg[e]; e2 = e; } \
                const float g1 = fast_rcp(1.0f + fast_exp2((v2 - v1) * LOG2E)), g2 = 1.0f - g1; \
                if (lane == 0) { \
                    const unsigned p1 = atomicAdd((unsigned*)(lcnt + e1), 1u), p2 = atomicAdd((unsigned*)(lcnt + e2), 1u); \
                    i32x4 inf; inf.x = e1 | (e2 << 8); inf.y = (int)(p1 | (p2 << 16)); inf.z = __float_as_int(g1); inf.w = __float_as_int(g2); \
                    *(i32x4*)(p.ws + WS_MOE + MO_INFO + (size_t)row * 16) = inf; \
                } \
            } \
        } } while (0)
    {
        int rcur = r0 + wave;
        i32x2 slA = {0, 0}, slB = {0, 0}, slC = {0, 0}; i32x4 infA = {0, 0, 0, 0}, infB = {0, 0, 0, 0}, infC = {0, 0, 0, 0};
        if (rcur < r1) {
            TH_SLOT(rcur, slA, infA);
            if (rcur + 8 < r1) TH_SLOT(rcur + 8, slB, infB);
            if (rcur + 16 < r1) TH_SLOT(rcur + 16, slC, infC);
            TH_LOAD(rcur, xA, rA, yA, zA, gA1, gA2, slA, infA);
            if (rcur + 8 < r1) TH_LOAD(rcur + 8, xB, rB, yB, zB, gB1, gB2, slB, infB);
            for (;;) {
                if (rcur + 16 < r1) TH_LOAD(rcur + 16, xC, rC, yC, zC, gC1, gC2, slC, infC);
                if (rcur + 24 < r1) TH_SLOT(rcur + 24, slA, infA);
                TH_PROC(rcur, xA, rA, yA, zA, gA1, gA2);
                rcur += 8; if (rcur >= r1) break;
                if (rcur + 16 < r1) TH_LOAD(rcur + 16, xA, rA, yA, zA, gA1, gA2, slA, infA);
                if (rcur + 24 < r1) TH_SLOT(rcur + 24, slB, infB);
                TH_PROC(rcur, xB, rB, yB, zB, gB1, gB2);
                rcur += 8; if (rcur >= r1) break;
                if (rcur + 16 < r1) TH_LOAD(rcur + 16, xB, rB, yB, zB, gB1, gB2, slB, infB);
                if (rcur + 24 < r1) TH_SLOT(rcur + 24, slC, infC);
                TH_PROC(rcur, xC, rC, yC, zC, gC1, gC2);
                rcur += 8; if (rcur >= r1) break;
            }
        }
    }
#undef TH_LOAD
#undef TH_SLOT
#undef TH_PROC
    if (ROUTER) {
        __syncthreads();
        if (tid < 8) ((int*)(p.ws + WS_MOE + MO_WGCNT))[wg * 8 + tid] = (int)lcnt[tid];
    }
}

__device__ __forceinline__ void route_phase(const Params& p, LAS unsigned char* lds, int G, int wg, int tid, int M) {
    LAS int* cnt = (LAS int*)lds;
    LAS int* tab = (LAS int*)(lds + 32768);
    const int* wgcnt = (const int*)(p.ws + WS_MOE + MO_WGCNT);
    for (int i = tid; i < G * 8; i += 512) cnt[i] = wgcnt[i];
    __syncthreads();
    if (tid < 8) { int tot = 0, pre = 0; for (int w = 0; w < G; ++w) { const int c = cnt[w * 8 + tid]; if (w < wg) pre += c; tot += c; } tab[tid] = pre; tab[8 + tid] = tot; }
    __syncthreads();
    if (tid == 0) { int ts = 0; for (int e = 0; e < 8; ++e) { tab[16 + e] = ts; ts += (tab[8 + e] + 255) >> 8; } tab[24] = ts; }
    __syncthreads();
    int* rowidx = (int*)(p.ws + WS_MOE + MO_ROWIDX);
    const int RPW = (M + G - 1) / G, r0 = wg * RPW, r1 = (r0 + RPW < M) ? r0 + RPW : M;
    for (int row = r0 + tid; row < r1; row += 512) {
        const i32x4 inf = *(const i32x4*)(p.ws + WS_MOE + MO_INFO + (size_t)row * 16);
        const int e1 = inf.x & 255, e2 = (inf.x >> 8) & 255, p1 = inf.y & 0xffff, p2 = (inf.y >> 16) & 0xffff;
        const int s1 = tab[16 + e1] * 256 + tab[e1] + p1, s2 = tab[16 + e2] * 256 + tab[e2] + p2;
        rowidx[s1] = row; rowidx[s2] = row;
        { const float sc = ((const float*)(p.ws + WS_SA))[row]; float* sas = (float*)(p.ws + WS_SAS); sas[s1] = sc; sas[s2] = sc; }
        i32x2 sl; sl.x = s1; sl.y = s2; *(i32x2*)(p.ws + WS_MOE + MO_SLOT + (size_t)row * 8) = sl;
    }
    if (wg < 8) { const int e = wg, s0 = tab[16 + e] * 256 + tab[8 + e], s1 = tab[17 + e] * 256; for (int s = s0 + tid; s < s1; s += 512) { rowidx[s] = 0; ((float*)(p.ws + WS_SAS))[s] = 0.f; } }
    if (wg == 0 && tid < 32) ((int*)(p.ws + WS_MOE + MO_TAB))[tid] = (tid < 25) ? tab[tid] : 0;
    __syncthreads();
}

__device__ __forceinline__ void pooldiff_phase(const bf16_t* h, bf16_t* d, int G, int wg, int tid, int M) {
    const int chunk = tid & 127, seg = tid >> 7, hw = 1 << (chunk >> 5);
    const int RPW = (M + G - 1) / G, r0 = wg * RPW, r1 = (r0 + RPW < M) ? r0 + RPW : M;
    const int nseg = (r1 - r0 + 3) >> 2, ra = r0 + seg * nseg, rb = (ra + nseg < r1) ? ra + nseg : r1;
    const bf16_t* hc = h + chunk * 8; bf16_t* dc = d + chunk * 8;
    float S[8] = {0.f, 0.f, 0.f, 0.f, 0.f, 0.f, 0.f, 0.f};
    bool fresh = true;
#define PD_ACC(sgn_, v_) do { S[0] += sgn_ bf_lo(v_.x); S[1] += sgn_ bf_hi(v_.x); S[2] += sgn_ bf_lo(v_.y); S[3] += sgn_ bf_hi(v_.y); S[4] += sgn_ bf_lo(v_.z); S[5] += sgn_ bf_hi(v_.z); S[6] += sgn_ bf_lo(v_.w); S[7] += sgn_ bf_hi(v_.w); } while (0)
#pragma unroll 2
    for (int row = ra; row < rb; ++row) {
        int base, t, T;
        if (row < ML) { base = row & ~(SEQ - 1); t = row & (SEQ - 1); T = SEQ; } else { base = ML + ((row - ML) & ~(CTXL - 1)); t = (row - ML) & (CTXL - 1); T = CTXL; }
        const int lo = (t - hw) > 0 ? (t - hw) : 0, hi = (t + hw) < T ? (t + hw) : T;
        if (fresh || t == 0) {
            fresh = false;
#pragma unroll
            for (int i = 0; i < 8; ++i) S[i] = 0.f;
            for (int j = lo; j < hi; ++j) { const u32x4 v = *(const u32x4*)(hc + (size_t)(base + j) * D); PD_ACC(+, v); }
        } else {
            if (t + hw - 1 < T) { const u32x4 v = *(const u32x4*)(hc + (size_t)(base + t + hw - 1) * D); PD_ACC(+, v); }
            if (t - hw - 1 >= 0) { const u32x4 v = *(const u32x4*)(hc + (size_t)(base + t - hw - 1) * D); PD_ACC(-, v); }
        }
        const float inv = fast_rcp((float)(hi - lo));
        const u32x4 cv = *(const u32x4*)(hc + (size_t)row * D);
        u32x4 o;
        o.x = cvt_pk_bf16(S[0] * inv - bf_lo(cv.x), S[1] * inv - bf_hi(cv.x)); o.y = cvt_pk_bf16(S[2] * inv - bf_lo(cv.y), S[3] * inv - bf_hi(cv.y));
        o.z = cvt_pk_bf16(S[4] * inv - bf_lo(cv.z), S[5] * inv - bf_hi(cv.z)); o.w = cvt_pk_bf16(S[6] * inv - bf_lo(cv.w), S[7] * inv - bf_hi(cv.w));
        *(u32x4*)(dc + (size_t)row * D) = o;
    }
#undef PD_ACC
}

constexpr int AT_TILE = 8192, AT_KOFF = 0, AT_VOFF = 3 * AT_TILE;
constexpr float ATT_THR = 8.0f;
typedef short s16x4 __attribute__((ext_vector_type(4)));
__device__ __forceinline__ float vmax3(float a, float b, float c) { float r; asm("v_max3_f32 %0, %1, %2, %3" : "=v"(r) : "v"(a), "v"(b), "v"(c)); return r; }
__device__ __forceinline__ float xhalf_max(float v) { const u32x2 r = __builtin_amdgcn_permlane32_swap(__float_as_uint(v), __float_as_uint(v), false, false); return vmax3(__uint_as_float(r.x), __uint_as_float(r.y), __uint_as_float(r.y)); }
__device__ __forceinline__ s16x4 lds_tr16(const LAS unsigned char* p) { return __builtin_amdgcn_ds_read_tr16_b64_v4i16((LAS s16x4*)p); }
__device__ __forceinline__ void attn_phase(LAS unsigned char* lds, const bf16_t* Q, const bf16_t* Kg, const bf16_t* Vg, bf16_t* O, const float* sink, int n_units, int G, int wg, int tid) {
    const int wid = __builtin_amdgcn_readfirstlane(tid >> 6), lane = tid & 63, c = lane & 31, hh = lane >> 5;
    const int g = wid >> 1, qhalf = wid & 1;
    const int srow = wid * 8 + (lane >> 3), spos = lane & 7;
    const int skoff = srow * KVD + ((spos ^ ((srow >> 1) & 7)) * 8), svoff = srow * KVD + ((spos ^ (((srow >> 1) & 1) << 2)) * 8);
    const int ksw = (c >> 1) & 7;
    const int trq = (lane & 15) >> 2, trp = lane & 3, trblk = (lane >> 4) & 1;
    const int vtr_off = (4 * hh + trq) * 128 + (((2 * trblk + (trp >> 1)) ^ ((trq >> 1) << 2)) * 16) + 8 * (trp & 1);
    for (int unit = wg; unit < n_units; unit += G) {
        int qrow0, crow0, dlo, nband, hk;
        if (unit < 1024) { const int b = unit >> 8, rem = unit & 255, n = rem >> 2; hk = rem & 3; qrow0 = b * SEQ + n * 128; crow0 = ML + b * CTXL; dlo = (n > 0) ? -1 : 0; const int dhi = (n < 63) ? 1 : 0; nband = 2 * (dhi - dlo + 1); }
        else { const int cu = unit - 1024, b = cu >> 3, rem = cu & 7, n = rem >> 2; hk = rem & 3; crow0 = ML + b * CTXL; qrow0 = crow0 + n * 128; dlo = 0; nband = 0; }
        const int NT = nband + 4, head = hk * 4 + g;
        bf16x8 qf[2][4];
#pragma unroll
        for (int qb = 0; qb < 2; ++qb)
#pragma unroll
            for (int ks = 0; ks < 4; ++ks) qf[qb][ks] = *(const bf16x8*)(Q + (size_t)(qrow0 + qhalf * 64 + qb * 32 + c) * D + head * 64 + ks * 16 + hh * 8);
        const float m0 = sink[head] * LOG2E;
        float mrun0 = m0, mrun1 = m0, lrun0 = (hh == 0) ? 1.0f : 0.0f, lrun1 = lrun0;
        f32x16 o00, o01, o10, o11;
#pragma unroll
        for (int r = 0; r < 16; ++r) { o00[r] = 0.f; o01[r] = 0.f; o10[r] = 0.f; o11[r] = 0.f; }
#define AT_KROW(t_) (((t_) < nband) ? (qrow0 + (dlo + ((t_) >> 1)) * 128 + ((t_) & 1) * 64) : (crow0 + ((t_) - nband) * 64))
#define AT_STAGE(t_) do { const int _kr = AT_KROW(t_); const int _b = (t_) % 3; \
        __builtin_amdgcn_global_load_lds((const unsigned*)(Kg + (size_t)_kr * KVD + hk * 64 + skoff), (LAS unsigned*)(lds + AT_KOFF + _b * AT_TILE + wid * 1024), 16, 0, 0); \
        __builtin_amdgcn_global_load_lds((const unsigned*)(Vg + (size_t)_kr * KVD + hk * 64 + svoff), (LAS unsigned*)(lds + AT_VOFF + _b * AT_TILE + wid * 1024), 16, 0, 0); } while (0)
        AT_STAGE(0); AT_STAGE(1);
        asm volatile("" : "+v"(qf[0][0]), "+v"(qf[0][1]), "+v"(qf[0][2]), "+v"(qf[0][3]), "+v"(qf[1][0]), "+v"(qf[1][1]), "+v"(qf[1][2]), "+v"(qf[1][3]));
        asm volatile("s_waitcnt vmcnt(2)" ::: "memory");
        __builtin_amdgcn_s_barrier();
        for (int t = 0; t < NT; ++t) {
            int kp0 = 0; bool masked = false, skip = false;
            if (t < nband) { const int dl = dlo + (t >> 1), th = t & 1; kp0 = dl * 128 + th * 64; masked = (dl != 0); skip = (dl == -1 && th == 0 && qhalf == 1) || (dl == 1 && th == 1 && qhalf == 0); }
            if (t + 2 < NT) AT_STAGE(t + 2);
            const LAS unsigned char* kbuf = lds + AT_KOFF + (t % 3) * AT_TILE; const LAS unsigned char* vbuf = lds + AT_VOFF + (t % 3) * AT_TILE;
            if (!skip) {
                f32x16 s00, s01, s10, s11;
#pragma unroll
                for (int r = 0; r < 16; ++r) { s00[r] = -mrun0; s10[r] = -mrun0; s01[r] = -mrun1; s11[r] = -mrun1; }
#pragma unroll
                for (int ks = 0; ks < 4; ++ks) {
                    const bf16x8 kf0 = *(const LAS bf16x8*)(kbuf + c * 128 + (((2 * ks + hh) ^ ksw) * 16));
                    const bf16x8 kf1 = *(const LAS bf16x8*)(kbuf + (32 + c) * 128 + (((2 * ks + hh) ^ ksw) * 16));
                    s00 = __builtin_amdgcn_mfma_f32_32x32x16_bf16(kf0, qf[0][ks], s00, 0, 0, 0); s01 = __builtin_amdgcn_mfma_f32_32x32x16_bf16(kf0, qf[1][ks], s01, 0, 0, 0);
                    s10 = __builtin_amdgcn_mfma_f32_32x32x16_bf16(kf1, qf[0][ks], s10, 0, 0, 0); s11 = __builtin_amdgcn_mfma_f32_32x32x16_bf16(kf1, qf[1][ks], s11, 0, 0, 0);
                }
                if (masked) {
                    int bs = kp0 + 4 * hh - (qhalf * 64 + c) + 128;
                    asm volatile("; band mask" : "+v"(bs));
#pragma unroll
                    for (int r = 0; r < 16; ++r) { const int kr = (r & 3) + 8 * (r >> 2);
                        if ((unsigned)(bs + kr) > 256u) s00[r] = -1e30f;
                        if ((unsigned)(bs + kr - 32) > 256u) s01[r] = -1e30f;
                        if ((unsigned)(bs + kr + 32) > 256u) s10[r] = -1e30f;
                        if ((unsigned)(bs + kr) > 256u) s11[r] = -1e30f; }
                    asm volatile("" : "+v"(s00), "+v"(s01), "+v"(s10), "+v"(s11));
                }
                float mx0 = s00[0], mx1 = s01[0];
#pragma unroll
                for (int r = 0; r < 16; ++r) { mx0 = vmax3(mx0, s00[r], s10[r]); mx1 = vmax3(mx1, s01[r], s11[r]); }
                mx0 = xhalf_max(mx0); mx1 = xhalf_max(mx1);
                if (__builtin_amdgcn_ballot_w64(vmax3(mx0, mx1, mx1) > ATT_THR) != 0ull) {
                    float d0 = fmaxf(mx0, 0.f), d1 = fmaxf(mx1, 0.f);
                    asm volatile("; rescale" : "+v"(d0), "+v"(d1));
                    const float al0 = fast_exp2(-d0), al1 = fast_exp2(-d1);
                    mrun0 += d0; mrun1 += d1; lrun0 *= al0; lrun1 *= al1;
#pragma unroll
                    for (int r = 0; r < 16; ++r) { s00[r] -= d0; s10[r] -= d0; s01[r] -= d1; s11[r] -= d1; o00[r] *= al0; o10[r] *= al0; o01[r] *= al1; o11[r] *= al1; }
                    asm volatile("" : "+v"(s00), "+v"(s01), "+v"(s10), "+v"(s11));
                }
                float rs0 = 0.f, rs1 = 0.f;
#pragma unroll
                for (int r = 0; r < 16; ++r) { s00[r] = fast_exp2(s00[r]); s10[r] = fast_exp2(s10[r]); s01[r] = fast_exp2(s01[r]); s11[r] = fast_exp2(s11[r]);
                    rs0 += s00[r] + s10[r]; rs1 += s01[r] + s11[r]; }
                lrun0 += rs0; lrun1 += rs1;
                bf16x8 pf[2][2][2];
#pragma unroll
                for (int s2 = 0; s2 < 2; ++s2) {
                    u32x4 w;
                    w.x = cvt_pk_bf16(s00[8 * s2 + 0], s00[8 * s2 + 1]); w.y = cvt_pk_bf16(s00[8 * s2 + 2], s00[8 * s2 + 3]); w.z = cvt_pk_bf16(s00[8 * s2 + 4], s00[8 * s2 + 5]); w.w = cvt_pk_bf16(s00[8 * s2 + 6], s00[8 * s2 + 7]);
                    pf[0][0][s2] = __builtin_bit_cast(bf16x8, w);
                    w.x = cvt_pk_bf16(s01[8 * s2 + 0], s01[8 * s2 + 1]); w.y = cvt_pk_bf16(s01[8 * s2 + 2], s01[8 * s2 + 3]); w.z = cvt_pk_bf16(s01[8 * s2 + 4], s01[8 * s2 + 5]); w.w = cvt_pk_bf16(s01[8 * s2 + 6], s01[8 * s2 + 7]);
                    pf[0][1][s2] = __builtin_bit_cast(bf16x8, w);
                    w.x = cvt_pk_bf16(s10[8 * s2 + 0], s10[8 * s2 + 1]); w.y = cvt_pk_bf16(s10[8 * s2 + 2], s10[8 * s2 + 3]); w.z = cvt_pk_bf16(s10[8 * s2 + 4], s10[8 * s2 + 5]); w.w = cvt_pk_bf16(s10[8 * s2 + 6], s10[8 * s2 + 7]);
                    pf[1][0][s2] = __builtin_bit_cast(bf16x8, w);
                    w.x = cvt_pk_bf16(s11[8 * s2 + 0], s11[8 * s2 + 1]); w.y = cvt_pk_bf16(s11[8 * s2 + 2], s11[8 * s2 + 3]); w.z = cvt_pk_bf16(s11[8 * s2 + 4], s11[8 * s2 + 5]); w.w = cvt_pk_bf16(s11[8 * s2 + 6], s11[8 * s2 + 7]);
                    pf[1][1][s2] = __builtin_bit_cast(bf16x8, w);
                }
#pragma unroll
                for (int kb = 0; kb < 2; ++kb)
#pragma unroll
                    for (int s2 = 0; s2 < 2; ++s2) {
                        const int vo = vtr_off + (32 * kb + 16 * s2) * 128;
                        const s16x4 a0 = lds_tr16(vbuf + vo), a1 = lds_tr16(vbuf + vo + 8 * 128), b0 = lds_tr16(vbuf + (vo ^ 64)), b1 = lds_tr16(vbuf + (vo ^ 64) + 8 * 128);
                        const bf16x8 vf0 = __builtin_shufflevector(a0, a1, 0, 1, 2, 3, 4, 5, 6, 7), vf1 = __builtin_shufflevector(b0, b1, 0, 1, 2, 3, 4, 5, 6, 7);
                        o00 = __builtin_amdgcn_mfma_f32_32x32x16_bf16(vf0, pf[kb][0][s2], o00, 0, 0, 0); o01 = __builtin_amdgcn_mfma_f32_32x32x16_bf16(vf0, pf[kb][1][s2], o01, 0, 0, 0);
                        o10 = __builtin_amdgcn_mfma_f32_32x32x16_bf16(vf1, pf[kb][0][s2], o10, 0, 0, 0); o11 = __builtin_amdgcn_mfma_f32_32x32x16_bf16(vf1, pf[kb][1][s2], o11, 0, 0, 0);
                    }
            }
            if (t + 2 < NT) asm volatile("s_waitcnt vmcnt(2)" ::: "memory"); else asm volatile("s_waitcnt vmcnt(0)" ::: "memory");
            __builtin_amdgcn_s_barrier();
        }
#undef AT_STAGE
#undef AT_KROW
        const float l0 = lrun0 + __shfl_xor(lrun0, 32), l1 = lrun1 + __shfl_xor(lrun1, 32);
        const float i0 = 1.0f / l0, i1 = 1.0f / l1;
        bf16_t* orow0 = O + (size_t)(qrow0 + qhalf * 64 + c) * D + head * 64 + 4 * hh;
        bf16_t* orow1 = orow0 + (size_t)32 * D;
#pragma unroll
        for (int gq = 0; gq < 4; ++gq) {
            u32x2 w;
            w.x = cvt_pk_bf16(o00[4 * gq] * i0, o00[4 * gq + 1] * i0); w.y = cvt_pk_bf16(o00[4 * gq + 2] * i0, o00[4 * gq + 3] * i0); *(u32x2*)(orow0 + 8 * gq) = w;
            w.x = cvt_pk_bf16(o10[4 * gq] * i0, o10[4 * gq + 1] * i0); w.y = cvt_pk_bf16(o10[4 * gq + 2] * i0, o10[4 * gq + 3] * i0); *(u32x2*)(orow0 + 32 + 8 * gq) = w;
            w.x = cvt_pk_bf16(o01[4 * gq] * i1, o01[4 * gq + 1] * i1); w.y = cvt_pk_bf16(o01[4 * gq + 2] * i1, o01[4 * gq + 3] * i1); *(u32x2*)(orow1 + 8 * gq) = w;
            w.x = cvt_pk_bf16(o11[4 * gq] * i1, o11[4 * gq + 1] * i1); w.y = cvt_pk_bf16(o11[4 * gq + 2] * i1, o11[4 * gq + 3] * i1); *(u32x2*)(orow1 + 32 + 8 * gq) = w;
        }
    }
}

__device__ __forceinline__ int opaque_i(int v) { asm volatile("" : "+v"(v)); return v; }
__device__ __forceinline__ int opaque_s(int v) { asm volatile("" : "+s"(v)); return v; }
#if defined(__HIP_DEVICE_COMPILE__)
typedef const __attribute__((address_space(4))) Params* KargPtr;
#define TID() (wave_s * 64 + (int)__builtin_amdgcn_mbcnt_hi(~0u, __builtin_amdgcn_mbcnt_lo(~0u, (unsigned)opaque_i(0))))
#define LOADP() KargPtr kp_ = (KargPtr)__builtin_amdgcn_kernarg_segment_ptr(); asm volatile("" : "+s"(kp_)); const Params p = *kp_; unsigned char* const ws = p.ws; (void)ws
#define B_H   ((bf16_t*)(ws + WS_H))
#define B_Q   ((bf16_t*)(ws + WS_Q))
#define B_K   ((bf16_t*)(ws + WS_K))
#define B_V   ((bf16_t*)(ws + WS_V))
#define B_Y   ((bf16_t*)(ws + WS_Y))
#define B_ACT ((bf16_t*)(ws + WS_ACT))
#define B_XC  ((float*)(ws + WS_XC))
#define GRID_BAR() do { LOADP(); XcdBarrier b_; b_.bar = (unsigned*)(ws + WS_CTL) + CW_BAR; b_.x = xb_xcc_id(); b_.st = (volatile LAS unsigned*)(lds + LDSCTL_OFF); xcd_barrier(b_); } while (0)
template <int LP> __device__ __forceinline__ void layer_pair(LAS unsigned char* lds, const int G, const int wg, const int wave_s) {
    constexpr int lp = LP;
        const int LA = 2 * lp, LB = 2 * lp + 1;
        const int Mrows = (lp == 0) ? MT : ML;
        { LOADP(); pg8::Gemm g{opaque_s(D / 2), opaque_s(D / 2), opaque_s(D / 2)}; pg8::DenseOrder S; S.init(MT / 256, NQKV / 256, G, wg, ws + WS_HQ, ws + WS_WQKV + (size_t)lp * NQKV * D, D / 2, D / 2, 0);
          pg8::EpiQKVQ E{B_Q, B_K, B_V, (const float*)(ws + WS_ROPE), (const float*)(ws + WS_SA), (const float*)(ws + WS_SW) + SWQ_OFF + lp * NQKV};
          pg8::gemm_phase<pg8::EpiQKVQ, pg8::DenseOrder, false, 1>(lds, g, S, E, TID()); }
        GRID_BAR();
        { LOADP(); attn_phase(lds, B_Q, B_K, B_V, B_H, p.sink + lp * 16, (lp == 0) ? 1024 + 32 : 1024, G, wg, TID()); }
        GRID_BAR();
        { LOADP(); pg8::Gemm g{opaque_s(D), opaque_s(D), opaque_s(D)}; pg8::DenseOrder S; S.init(Mrows / 256, D / 256, G, wg, B_H, (const bf16_t*)(ws + WS_WO) + (size_t)lp * D * D, D, D, 0);
          pg8::EpiPlain E{B_Y, D};
          pg8::gemm_phase<pg8::EpiPlain, pg8::DenseOrder, false>(lds, g, S, E, TID()); }
        GRID_BAR();
        { LOADP(); thin_phase<false, false, false, true>(p, lds, G, wg, TID(), Mrows, true, LA, 0, true, LA, 1, lp == 0, false, true, B_Y, B_H, 0); }
        GRID_BAR();
        { LOADP(); pg8::Gemm g{opaque_s(D / 2), opaque_s(D / 2), opaque_s(D / 2)}; pg8::DenseOrder S; S.init(Mrows / 256, 2 * DFF / 256, G, wg, ws + WS_HQ, ws + WS_WFGU + (size_t)lp * 2 * DFF * D, D / 2, D / 2, 0);
          pg8::EpiSwigluQ E{(unsigned char*)(ws + WS_ACT), DFF, (const float*)(ws + WS_SA), (const float*)(ws + WS_SW) + lp * 2 * DFF, 0};
          pg8::gemm_phase<pg8::EpiSwigluQ, pg8::DenseOrder, false, 1>(lds, g, S, E, TID()); }
        GRID_BAR();
        { LOADP(); pg8::Gemm g{opaque_s(DFF / 2), opaque_s(DFF / 2), opaque_s(DFF / 2)}; pg8::DenseOrder S; S.init(Mrows / 256, D / 256, G, wg, ws + WS_ACT, ws + WS_WFDN + (size_t)lp * D * DFF, DFF / 2, DFF / 2, 0);
          pg8::EpiPlainS E{B_Y, D, (const float*)(ws + WS_SDN) + lp * D, 0};
          pg8::gemm_phase<pg8::EpiPlainS, pg8::DenseOrder, false, 2>(lds, g, S, E, TID()); }
        GRID_BAR();
        { LOADP(); thin_phase<false, false, false, false>(p, lds, G, wg, TID(), Mrows, true, LA, 1, true, LB, 0, false, false, true, B_Y, B_H, 0); }
        GRID_BAR();
        { LOADP(); pooldiff_phase(B_H, B_Q, G, wg, TID(), Mrows); }
        GRID_BAR();
        { LOADP(); pg8::Gemm g{opaque_s(D), opaque_s(256), opaque_s(256)}; pg8::DenseOrder S; S.init(Mrows / 256, 4, G, wg, B_Q, (const bf16_t*)(ws + WS_WPOOL) + (size_t)lp * 4 * 256 * 256, D, 256, 512);
          pg8::EpiPool E{B_Y, p.pool_b + lp * D, p.pool_scale + lp * D};
          pg8::gemm_phase<pg8::EpiPool, pg8::DenseOrder, false>(lds, g, S, E, TID()); }
        GRID_BAR();
        { LOADP(); thin_phase<true, false, false, true>(p, lds, G, wg, TID(), Mrows, true, LB, 0, true, LB, 1, false, false, true, B_Y, B_H, lp); }
        GRID_BAR();
        { LOADP(); route_phase(p, lds, G, wg, TID(), Mrows); }
        GRID_BAR();
        { LOADP();
          const int* tab = (const int*)(ws + WS_MOE + MO_TAB);
          pg8::MoeOrder S; S.nM = tab[24]; S.G = G; S.c = wg; S.rowidx = (const int*)(ws + WS_MOE + MO_ROWIDX);
          S.t1 = tab[17]; S.t2 = tab[18]; S.t3 = tab[19]; S.t4 = tab[20]; S.t5 = tab[21]; S.t6 = tab[22]; S.t7 = tab[23];
          S.nN = 2 * DFE / 256; S.nwg = S.nM * S.nN; S.A = (const char*)(ws + WS_HQ); S.B = (const char*)(ws + WS_WMGU + (size_t)lp * NE * 2 * DFE * D); S.tstepA = 256u * D; S.tstepB = 256u * D;
          S.estride = 2u * DFE * D; S.gather = 1;
          pg8::Gemm g{opaque_s(D / 2), opaque_s(D / 2), opaque_s(D / 2)}; pg8::EpiSwigluQ E{(unsigned char*)(ws + WS_ACT), DFE, (const float*)(ws + WS_SAS), (const float*)(ws + WS_SW) + 2 * 2 * DFF + lp * NE * 2 * DFE, 2 * DFE};
          pg8::gemm_phase<pg8::EpiSwigluQ, pg8::MoeOrder, true, 1>(lds, g, S, E, TID()); }
        GRID_BAR();
        { LOADP();
          const int* tab = (const int*)(ws + WS_MOE + MO_TAB);
          pg8::MoeOrder S; S.nM = tab[24]; S.G = G; S.c = wg; S.rowidx = (const int*)(ws + WS_MOE + MO_ROWIDX);
          S.t1 = tab[17]; S.t2 = tab[18]; S.t3 = tab[19]; S.t4 = tab[20]; S.t5 = tab[21]; S.t6 = tab[22]; S.t7 = tab[23];
          S.nN = D / 256; S.nwg = S.nM * S.nN; S.A = (const char*)(ws + WS_ACT); S.B = (const char*)(ws + WS_WMDN + (size_t)lp * NE * D * DFE); S.tstepA = 256u * DFE; S.tstepB = 256u * DFE;
          S.estride = (unsigned)D * DFE; S.gather = 0;
          pg8::Gemm g{opaque_s(DFE / 2), opaque_s(DFE / 2), opaque_s(DFE / 2)}; pg8::EpiPlainS E{B_Y, D, (const float*)(ws + WS_SDN) + (2 + lp * NE) * D, D};
          pg8::gemm_phase<pg8::EpiPlainS, pg8::MoeOrder, false, 2>(lds, g, S, E, TID()); }
        GRID_BAR();
        { LOADP(); thin_phase<false, true, false, true>(p, lds, G, wg, TID(), Mrows, true, LB, 1, lp == 0, LB + 1, 0, false, lp == 1, true, B_Y, B_H, 0); }
        if (lp == 0) GRID_BAR();
    }
#endif
__global__ void __launch_bounds__(512, 2) fwd_kernel(Params p_arg) {
#if defined(__HIP_DEVICE_COMPILE__)
    extern __shared__ __attribute__((aligned(16))) unsigned char lds_raw[];
    LAS unsigned char* lds = (LAS unsigned char*)lds_raw;
    const int G = gridDim.x, wg = blockIdx.x;
    asm volatile("s_setreg_imm32_b32 hwreg(HW_REG_MODE, 23, 1), 1");
    const int wave_s = __builtin_amdgcn_readfirstlane((int)threadIdx.x >> 6);
    { const int tid = TID();
      for (int u = tid; u < (LDS_BYTES - LDSCTL_OFF) / 4; u += 512) ((LAS unsigned*)(lds + LDSCTL_OFF))[u] = 0u; }
    __syncthreads();
    { LOADP(); (void)xcd_barrier_post((unsigned*)(ws + WS_CTL) + CW_BAR, (volatile LAS unsigned*)(lds + LDSCTL_OFF)); }

    { LOADP(); prologue(p, lds, G, wg, TID()); }
    GRID_BAR();
    { LOADP(); thin_phase<false, false, true, true>(p, lds, G, wg, TID(), MT, false, 0, 0, true, 0, 0, true, false, false, nullptr, B_H, 0); }
    { LOADP(); prologue_down_quant(p, G, wg, TID()); }
    GRID_BAR();

    layer_pair<0>(lds, G, wg, wave_s);
    layer_pair<1>(lds, G, wg, wave_s);
#endif
}

extern "C" void kernel_launch(void* const* d_in, const int* in_sizes, int n_in, void* d_out, int out_size, void* d_ws, size_t ws_size, hipStream_t stream) {
    static int grid = 0;
    if (grid == 0) {
        if (n_in != 19 || out_size != ML * D || ws_size < WS_END) { fprintf(stderr, "kernel_launch: unexpected problem (n_in %d, out %d, ws %zu < %zu)\n", n_in, out_size, ws_size, (size_t)WS_END); grid = -1; return; }
        int dev = 0, cus = 0, per_cu = 0;
        if (hipGetDevice(&dev) != hipSuccess || hipDeviceGetAttribute(&cus, hipDeviceAttributeMultiprocessorCount, dev) != hipSuccess) { grid = -1; return; }
        if (hipFuncSetAttribute((const void*)fwd_kernel, hipFuncAttributeMaxDynamicSharedMemorySize, LDS_BYTES) != hipSuccess) { fprintf(stderr, "kernel_launch: hipFuncSetAttribute failed\n"); grid = -1; return; }
        if (hipOccupancyMaxActiveBlocksPerMultiprocessor(&per_cu, (const void*)fwd_kernel, 512, LDS_BYTES) != hipSuccess || per_cu < 1) fprintf(stderr, "kernel_launch: occupancy query reports %d\n", per_cu);
        (void)hipGetLastError();
        grid = cus;
        if (grid > 1024) grid = 1024;
    }
    if (grid < 0) return;
    (void)in_sizes;
    (void)hipMemsetAsync((char*)d_ws + WS_CTL, 0, CTL_ZERO_BYTES, stream);
    Params p{};
    p.x = (const float*)d_in[0]; p.c = (const float*)d_in[1]; p.ctx = (const float*)d_in[2]; p.c_ctx = (const float*)d_in[3]; p.ada_w = (const float*)d_in[4]; p.ada_b = (const float*)d_in[5];
    p.norm_g = (const float*)d_in[6]; p.w_qkv = (const float*)d_in[7]; p.w_o = (const float*)d_in[8]; p.sink = (const float*)d_in[9]; p.pool_w = (const float*)d_in[10]; p.pool_b = (const float*)d_in[11];
    p.pool_scale = (const float*)d_in[12]; p.ffn_gu = (const float*)d_in[13]; p.ffn_dn = (const float*)d_in[14]; p.router_w = (const float*)d_in[15]; p.router_b = (const float*)d_in[16];
    p.moe_gu = (const float*)d_in[17]; p.moe_dn = (const float*)d_in[18];
    p.out = (float*)d_out; p.ws = (unsigned char*)d_ws;
    hipLaunchKernelGGL(fwd_kernel, dim3(grid), dim3(512), LDS_BYTES, stream, p);
}
```
